# Optimizing an MI355X kernel written in HIP

```python
import math
import jax, jax.numpy as jnp
from jax import lax
import numpy as np


D_MODEL = 1024
BATCH = 2
SEQ = 16384
DEPTH = 4

CHUNK = 64
QBLOCK = 128
MIX_WIDTH = D_MODEL
HEAD_DIM = 64
CONV_WIDTH = MIX_WIDTH // 4
CONV_K = 3
ATT_WIDTH = (MIX_WIDTH - CONV_WIDTH) // 2
DSA_HEADS = ATT_WIDTH // HEAD_DIM
CHK_HEADS = ATT_WIDTH // HEAD_DIM
ROPE_DIM = HEAD_DIM // 4
ROPE_THETA = 500000.0
IDX_HEADS = 8
IDX_DIM = 32
IDX_ROPE_DIM = IDX_DIM // 4
TOPK_MAX = 256
BAND_CHUNKS = 8
REL_CLIP = 128
REL_SIZE = (CHUNK - 1) + REL_CLIP + 1
MEM_LEN = 256
MEM_HEADS = 4
MEM_HEAD_DIM = D_MODEL // MEM_HEADS
D_FF = 4 * D_MODEL
LN_EPS = 1e-5
ALPHA = (2.0 * DEPTH) ** 0.25
BETA = (8.0 * DEPTH) ** -0.25
IN_SIZES = (CONV_WIDTH, CONV_WIDTH, CONV_WIDTH,
            DSA_HEADS * HEAD_DIM, HEAD_DIM, HEAD_DIM,
            IDX_HEADS * IDX_DIM, IDX_DIM, IDX_HEADS,
            CHK_HEADS * HEAD_DIM, CHK_HEADS * HEAD_DIM, CHK_HEADS * HEAD_DIM)
IN_WIDTH = sum(IN_SIZES)

kernel_name = 'hybrid_conv_dsa_chunkband_deepnorm'


def layer_norm(x, g, b):
    xf = x.astype(jnp.float32)
    mu = jnp.mean(xf, axis=-1, keepdims=True)
    var = jnp.mean(jnp.square(xf - mu), axis=-1, keepdims=True)
    y = (xf - mu) * lax.rsqrt(var + LN_EPS) * g.astype(jnp.float32) + b.astype(jnp.float32)
    return y.astype(x.dtype)


def partial_rope(x, positions, rot_dim):
    half = rot_dim // 2
    inv_freq = jnp.power(jnp.float32(ROPE_THETA), -jnp.arange(half, dtype=jnp.float32) / half)
    ang = positions.astype(jnp.float32)[..., None] * inv_freq
    cos = jnp.cos(ang)[:, :, None, :]
    sin = jnp.sin(ang)[:, :, None, :]
    x1 = x[..., :half].astype(jnp.float32)
    x2 = x[..., half:rot_dim].astype(jnp.float32)
    rot = jnp.concatenate([x1 * cos - x2 * sin, x2 * cos + x1 * sin], axis=-1)
    return jnp.concatenate([rot.astype(x.dtype), x[..., rot_dim:]], axis=-1)


def short_conv_mixer(gate_b, gate_c, h, conv_w):
    u = gate_c * h
    S = u.shape[1]
    u_pad = jnp.pad(u, ((0, 0), (CONV_K - 1, 0), (0, 0)))
    y = conv_w[0] * u_pad[:, 0:S]
    for j in range(1, CONV_K):
        y = y + conv_w[j] * u_pad[:, j:j + S]
    return gate_b * y


def dsa_attention(q, k, v, iq, ik, iw):
    B_, S, H, Dh = q.shape
    nb = S // QBLOCK
    topk = min(TOPK_MAX, S // 4)
    scale = Dh ** -0.5
    key_chunk = jnp.arange(S) // CHUNK
    iw = iw * (IDX_HEADS ** -0.5)

    def to_blocks(a):
        return jnp.moveaxis(a.reshape((B_, nb, QBLOCK) + a.shape[2:]), 1, 0)

    def one_block(args):
        bi, qb, iqb, iwb = args
        q_chunk = (bi * QBLOCK + jnp.arange(QBLOCK)) // CHUNK
        logits = jnp.einsum('bqhd,bsd->bqhs', iqb, ik)
        score = jnp.einsum('bqh,bqhs->bqs', iwb, jax.nn.relu(logits)).astype(jnp.float32)
        admissible = key_chunk[None, :] <= q_chunk[:, None]
        score = jnp.where(admissible[None], score, -jnp.inf)
        _, idx = lax.top_k(score, topk)
        valid = (idx // CHUNK) <= q_chunk[None, :, None]
        k_sel = jax.vmap(lambda a, ii: a[ii])(k, idx)
        v_sel = jax.vmap(lambda a, ii: a[ii])(v, idx)
        s = jnp.einsum('bqhd,bqkd->bhqk', qb, k_sel).astype(jnp.float32) * scale
        s = jnp.where(valid[:, None], s, -jnp.inf)
        p = jax.nn.softmax(s, axis=-1)
        return jnp.einsum('bhqk,bqkd->bqhd', p.astype(v_sel.dtype), v_sel)

    out = lax.map(one_block, (jnp.arange(nb), to_blocks(q), to_blocks(iq), to_blocks(iw)))
    return jnp.moveaxis(out, 0, 1).reshape(B_, S, H * Dh)


def chunk_band_attention(q, k, v, rel_bias):
    B_, S, H, Dh = q.shape
    nc = S // CHUNK
    band = (BAND_CHUNKS + 1) * CHUNK
    pad = BAND_CHUNKS * CHUNK
    scale = Dh ** -0.5
    k_pad = jnp.pad(k, ((0, 0), (pad, 0), (0, 0), (0, 0)))
    v_pad = jnp.pad(v, ((0, 0), (pad, 0), (0, 0), (0, 0)))
    i = jnp.arange(CHUNK)[:, None]
    j = jnp.arange(band)[None, :]
    rel = i - j + pad
    rel_idx = jnp.clip(rel, -(CHUNK - 1), REL_CLIP) + (CHUNK - 1)
    bias = rel_bias[:, rel_idx].astype(jnp.float32)
    q_chunks = jnp.moveaxis(q.reshape(B_, nc, CHUNK, H, Dh), 1, 0)

    def one_chunk(args):
        c, qc = args
        start = c * CHUNK
        kc = lax.dynamic_slice_in_dim(k_pad, start, band, axis=1)
        vc = lax.dynamic_slice_in_dim(v_pad, start, band, axis=1)
        s = jnp.einsum('bqhd,bkhd->bhqk', qc, kc).astype(jnp.float32) * scale + bias
        valid = jnp.arange(band) >= (pad - start)
        s = jnp.where(valid, s, -jnp.inf)
        p = jax.nn.softmax(s, axis=-1)
        return jnp.einsum('bhqk,bkhd->bqhd', p.astype(vc.dtype), vc)

    out = lax.map(one_chunk, (jnp.arange(nc), q_chunks))
    return jnp.moveaxis(out, 0, 1).reshape(B_, S, H * Dh)


def hybrid_mixer(x, positions, w_in, conv_w, rel_bias, w_out):
    B_, S, _ = x.shape
    proj = jnp.einsum('bsd,dp->bsp', x, w_in)
    offs = np.cumsum(np.array(IN_SIZES))[:-1].tolist()
    (cb, cc, ch, dq, dk, dv, iq, ik, iw, cq, ck, cv) = jnp.split(proj, offs, axis=-1)
    y_conv = short_conv_mixer(cb, cc, ch, conv_w)
    dq = partial_rope(dq.reshape(B_, S, DSA_HEADS, HEAD_DIM), positions, ROPE_DIM)
    dk = partial_rope(dk.reshape(B_, S, 1, HEAD_DIM), positions, ROPE_DIM)[:, :, 0]
    iq = partial_rope(iq.reshape(B_, S, IDX_HEADS, IDX_DIM), positions, IDX_ROPE_DIM)
    ik = partial_rope(ik.reshape(B_, S, 1, IDX_DIM), positions, IDX_ROPE_DIM)[:, :, 0]
    y_dsa = dsa_attention(dq, dk, dv, iq, ik, iw)
    cq = cq.reshape(B_, S, CHK_HEADS, HEAD_DIM)
    ck = ck.reshape(B_, S, CHK_HEADS, HEAD_DIM)
    cv = cv.reshape(B_, S, CHK_HEADS, HEAD_DIM)
    y_chk = chunk_band_attention(cq, ck, cv, rel_bias)
    y = jnp.concatenate([y_conv, y_dsa, y_chk], axis=-1)
    return jnp.einsum('bsm,md->bsd', y, w_out)


def memory_cross_attention(x, mem, w_q, w_kv, w_o):
    B_, S, _ = x.shape
    M = mem.shape[1]
    q = jnp.einsum('bsd,de->bse', x, w_q).reshape(B_, S, MEM_HEADS, MEM_HEAD_DIM)
    k, v = jnp.split(jnp.einsum('bmd,de->bme', mem, w_kv), 2, axis=-1)
    k = k.reshape(B_, M, MEM_HEADS, MEM_HEAD_DIM)
    v = v.reshape(B_, M, MEM_HEADS, MEM_HEAD_DIM)
    s = jnp.einsum('bshd,bmhd->bhsm', q, k).astype(jnp.float32) * (MEM_HEAD_DIM ** -0.5)
    p = jax.nn.softmax(s, axis=-1)
    o = jnp.einsum('bhsm,bmhd->bshd', p.astype(v.dtype), v).reshape(B_, S, D_MODEL)
    return jnp.einsum('bse,ed->bsd', o, w_o)


def squared_relu_mlp(x, w1, w2):
    h = jnp.square(jax.nn.relu(jnp.einsum('bsd,df->bsf', x, w1)))
    return jnp.einsum('bsf,fd->bsd', h, w2)


def setup_inputs(seed: int = 0) -> dict:
    key = jax.random.key(seed)
    ks = jax.random.split(key, 20)
    f32 = jnp.float32
    nrm = lambda k, shape, s: jax.random.normal(k, shape, f32) * s
    x = nrm(ks[0], (BATCH, SEQ, D_MODEL), 1.0)
    mem = nrm(ks[1], (BATCH, MEM_LEN, D_MODEL), 1.0)
    offset = jax.random.randint(ks[2], (BATCH,), 0, 4096, dtype=jnp.int32)
    positions = (offset[:, None] + jnp.arange(SEQ, dtype=jnp.int32)[None, :]).astype(jnp.int32)
    return {
        'x': x,
        'mem': mem,
        'positions': positions,
        'w_in': nrm(ks[3], (DEPTH, D_MODEL, IN_WIDTH), D_MODEL ** -0.5),
        'conv_w': nrm(ks[4], (DEPTH, CONV_K, CONV_WIDTH), CONV_K ** -0.5),
        'rel_bias': nrm(ks[5], (DEPTH, CHK_HEADS, REL_SIZE), 0.5),
        'w_mix_out': nrm(ks[6], (DEPTH, MIX_WIDTH, D_MODEL), BETA * MIX_WIDTH ** -0.5),
        'ln1_g': 1.0 + nrm(ks[7], (DEPTH, D_MODEL), 0.02),
        'ln1_b': nrm(ks[8], (DEPTH, D_MODEL), 0.02),
        'w_mq': nrm(ks[9], (DEPTH, D_MODEL, D_MODEL), D_MODEL ** -0.5),
        'w_mkv': nrm(ks[10], (DEPTH, D_MODEL, 2 * D_MODEL), D_MODEL ** -0.5),
        'w_mo': nrm(ks[11], (DEPTH, D_MODEL, D_MODEL), BETA * D_MODEL ** -0.5),
        'ln2_g': 1.0 + nrm(ks[12], (DEPTH, D_MODEL), 0.02),
        'ln2_b': nrm(ks[13], (DEPTH, D_MODEL), 0.02),
        'w_ff1': nrm(ks[14], (DEPTH, D_MODEL, D_FF), D_MODEL ** -0.5),
        'w_ff2': nrm(ks[15], (DEPTH, D_FF, D_MODEL), BETA * D_FF ** -0.5),
        'ln3_g': 1.0 + nrm(ks[16], (DEPTH, D_MODEL), 0.02),
        'ln3_b': nrm(ks[17], (DEPTH, D_MODEL), 0.02),
    }


def reference(x, mem, positions, w_in, conv_w, rel_bias, w_mix_out, ln1_g, ln1_b,
              w_mq, w_mkv, w_mo, ln2_g, ln2_b, w_ff1, w_ff2, ln3_g, ln3_b):
    for l in range(DEPTH):
        mix = hybrid_mixer(x, positions, w_in[l], conv_w[l], rel_bias[l], w_mix_out[l])
        x = layer_norm(ALPHA * x + mix, ln1_g[l], ln1_b[l])
        cross = memory_cross_attention(x, mem, w_mq[l], w_mkv[l], w_mo[l])
        x = layer_norm(ALPHA * x + cross, ln2_g[l], ln2_b[l])
        ff = squared_relu_mlp(x, w_ff1[l], w_ff2[l])
        x = layer_norm(ALPHA * x + ff, ln3_g[l], ln3_b[l])
    return x
```

```cpp
#include <hip/hip_runtime.h>
#include <hip/hip_cooperative_groups.h>
#include <cstdio>
#include <cmath>
namespace cg = cooperative_groups;

#define DEVI __device__ __forceinline__
typedef unsigned short u16;
using bf16x8 = __attribute__((ext_vector_type(8))) short;
using f32x4 = __attribute__((ext_vector_type(4))) float;
using f32x16 = __attribute__((ext_vector_type(16))) float;
typedef __bf16 bf2_t __attribute__((ext_vector_type(2)));
typedef float fl2_t __attribute__((ext_vector_type(2)));

constexpr int T_ = 32768, S_ = 16384, D_ = 1024, NL_ = 4, PW = 2560;
constexpr int C_CB = 0, C_CC = 256, C_CH = 512, C_DQ = 768, C_DK = 1152, C_DV = 1216, C_IQ = 1280, C_IK = 1536,
              C_IW = 1568, C_CQ = 1600, C_CK = 1984;
constexpr float ALPHA_ = 1.6817928305074290f;
constexpr float LOG2E_ = 1.4426950408889634f;
constexpr size_t MiB = 1u << 20;
constexpr size_t WS_CTL = 0, WS_X = 1 * MiB, WS_WT = WS_X + 64 * MiB, WS_MB = WS_WT + 32 * MiB, WS_KM = WS_MB + MiB,
                 WS_VTM = WS_KM + MiB, WS_ROPED = WS_VTM + MiB, WS_ROPEI = WS_ROPED + 2 * MiB, WS_Z = WS_ROPEI + MiB,
                 WS_VT = WS_Z + 160 * MiB, WS_Y = WS_Z + 192 * MiB, WS_Q = WS_Z, WS_P = WS_Z + 64 * MiB,
                 WS_O = WS_Z + 128 * MiB, WS_H = WS_Z, WS_END = WS_Z + 256 * MiB;
constexpr size_t WT_IN = 0, WT_OUT = 3072 * 1024, WT_MQ = WT_OUT + 1024 * 1024, WT_KV = WT_MQ + 1024 * 1024,
                 WT_MO = WT_KV + 2048 * 1024, WT_FF1 = WT_MO + 1024 * 1024, WT_FF2 = WT_FF1 + 4096 * 1024;
constexpr int LDS_BYTES = 147456;
constexpr int OFF_RB = 131072, OFF_CNT = OFF_RB + 4608, OFF_IW = OFF_CNT + 256, OFF_MISC = OFF_IW + 512,
              OFF_RED = OFF_MISC + 16;
constexpr int CAND_CAP = 512;

struct Params {
  const float* in[18];
  float* out;
  unsigned char* ws;
};
__constant__ const float INV8_[8] = {1.0f, 0.19392274f, 0.03760603f, 0.0072926646f, 0.0014142136f, 0.0002742482f, 5.3182957e-05f, 1.0313385e-05f};
__constant__ const float INV4_[4] = {1.0f, 0.03760603f, 0.0014142136f, 5.3182957e-05f};

DEVI int opaque_v(int x) { asm volatile("" : "+v"(x)); return x; }
DEVI int opaque_s(int x) { asm volatile("" : "+s"(x)); return x; }
template <class Tp> DEVI Tp* opaque_p(Tp* x) { asm volatile("" : "+s"(x)); return x; }
#define TIDX opaque_v((int)threadIdx.x)
#define BIDX opaque_s((int)blockIdx.x)
DEVI unsigned pack2(float a, float b) {
  fl2_t x = {a, b};
  bf2_t y = __builtin_convertvector(x, bf2_t);
  return __builtin_bit_cast(unsigned, y);
}
DEVI u16 f2bf(float a) { return (u16)(pack2(a, 0.f) & 0xffffu); }
DEVI float bf2f(u16 h) { return __uint_as_float(((unsigned)h) << 16); }
DEVI float bflo(unsigned w) { return __uint_as_float(w << 16); }
DEVI float bfhi(unsigned w) { return __uint_as_float(w & 0xffff0000u); }
DEVI bf16x8 ld8(const u16* p) { return __builtin_bit_cast(bf16x8, *(const uint4*)p); }
DEVI bf16x8 mk8(unsigned a, unsigned b, unsigned c, unsigned d) {
  uint4 v = make_uint4(a, b, c, d);
  return __builtin_bit_cast(bf16x8, v);
}

#define LAS __attribute__((address_space(3)))
typedef unsigned u32x4 __attribute__((ext_vector_type(4)));
constexpr int BK = 64, HALF = 128, HTB = HALF * BK * 2;
DEVI int lds_byte(int r, int c) {
  const int st = (r >> 4) * 2 + (c >> 5), rr = r & 15, cc = c & 31, ob = rr * 64 + cc * 2;
  return st * 1024 + (ob ^ (((ob >> 9) & 1) << 5));
}
DEVI void stage_rc(int b, int& R, int& C) {
  const int st = b / 1024, sb = b % 1024, swz = sb ^ (((sb >> 9) & 1) << 5);
  R = (st >> 1) * 16 + swz / 64;
  C = (st & 1) * 32 + (swz % 64) / 2;
}
DEVI int perm32(int rho) {
  const int n = rho >> 4, i = rho & 15;
  return 8 * (i >> 2) + 4 * n + (i & 3);
}
DEVI void tile_coord(int v, int nM, int nN, int& pm, int& pn) {
  const int nwg = nM * nN;
  const int q = nwg / 8, r = nwg % 8, xcd = v % 8, off = v / 8;
  const int w = (xcd < r ? xcd * (q + 1) : r * (q + 1) + (xcd - r) * q) + off;
  const int nig = 8 * nN, gid = w / nig, fm = gid * 8, gsz = min(nM - fm, 8);
  pm = fm + ((w % nig) % gsz);
  pn = (w % nig) / gsz;
}
struct GUnit { const char* a; const char* b; int pm, pn; };
struct Sched {
  const char* A; const char* B;
  size_t aStepM, aStepN, bStepN, bStepB;
  int nM, nN, G, c;
  DEVI bool next(int i, GUnit& u) const {
    const int L = i * G + c;
    if (L >= nM * nN) return false;
    int pm, pn;
    tile_coord(L, nM, nN, pm, pn);
    u.pm = pm; u.pn = pn;
    u.a = A + (size_t)pm * aStepM + (size_t)pn * aStepN;
    u.b = B + (size_t)pn * bStepN + (size_t)(pm >> 6) * bStepB;
    return true;
  }
};

template <int ACT>
struct EpiStore16 {
  static constexpr bool PERM = true;
  u16* C; int ldc;
  DEVI void operator()(f32x4 (&acc)[2][2][4][2], const GUnit& u, int wr, int wc, int fr, int fq) const {
    const int row0 = u.pm * 256 + wr * 64 + fr, col0 = u.pn * 256 + wc * 32 + 8 * fq;
#pragma unroll
    for (int ai = 0; ai < 2; ++ai)
#pragma unroll
      for (int m = 0; m < 4; ++m) {
        u16* rowp = C + (size_t)(row0 + ai * HALF + m * 16) * ldc + col0;
#pragma unroll
        for (int bj = 0; bj < 2; ++bj) {
          f32x4 v0 = acc[ai][bj][m][0], v1 = acc[ai][bj][m][1];
          if (ACT == 1) {
#pragma unroll
            for (int j = 0; j < 4; ++j) {
              const float a = fmaxf(v0[j], 0.f), b = fmaxf(v1[j], 0.f);
              v0[j] = a * a;
              v1[j] = b * b;
            }
          }
          u32x4 w;
          w.x = pack2(v0[0], v0[1]); w.y = pack2(v0[2], v0[3]); w.z = pack2(v1[0], v1[1]); w.w = pack2(v1[2], v1[3]);
          *(u32x4*)(rowp + bj * HALF) = w;
        }
      }
  }
};
struct EpiProj {
  static constexpr bool PERM = true;
  u16* C; const float* ropeD; const float* ropeI;
  DEVI void operator()(f32x4 (&acc)[2][2][4][2], const GUnit& u, int wr, int wc, int fr, int fq) const {
    const int row0 = u.pm * 256 + wr * 64 + fr, col0 = u.pn * 256 + wc * 32 + 8 * fq;
#pragma unroll
    for (int ai = 0; ai < 2; ++ai)
#pragma unroll
      for (int m = 0; m < 4; ++m) {
        const int row = row0 + ai * HALF + m * 16;
        u16* rowp = C + (size_t)row * PW + col0;
#pragma unroll
        for (int bj = 0; bj < 2; ++bj) {
          f32x4 v0 = acc[ai][bj][m][0], v1 = acc[ai][bj][m][1];
          const int gg = u.pn * 256 + bj * HALF + wc * 32;
          if (gg >= C_DQ && gg < C_DV && (gg & 63) == 0) {
            const f32x4 c0 = *(const f32x4*)(ropeD + (size_t)row * 16), c1 = *(const f32x4*)(ropeD + (size_t)row * 16 + 4);
            const f32x4 s0 = *(const f32x4*)(ropeD + (size_t)row * 16 + 8), s1 = *(const f32x4*)(ropeD + (size_t)row * 16 + 12);
#pragma unroll
            for (int j = 0; j < 4; ++j) {
              const float p0 = __shfl_xor(v0[j], 16), p1 = __shfl_xor(v1[j], 16);
              const float a0 = (fq == 0) ? (v0[j] * c0[j] - p0 * s0[j]) : (v0[j] * c0[j] + p0 * s0[j]);
              const float a1 = (fq == 0) ? (v1[j] * c1[j] - p1 * s1[j]) : (v1[j] * c1[j] + p1 * s1[j]);
              v0[j] = (fq < 2) ? a0 : v0[j];
              v1[j] = (fq < 2) ? a1 : v1[j];
            }
          } else if (gg >= C_IQ && gg < C_IW) {
            const f32x4 cs = *(const f32x4*)(ropeI + (size_t)row * 8), sn = *(const f32x4*)(ropeI + (size_t)row * 8 + 4);
#pragma unroll
            for (int j = 0; j < 4; ++j) {
              const float x1 = v0[j], x2 = v1[j];
              v0[j] = (fq == 0) ? (x1 * cs[j] - x2 * sn[j]) : x1;
              v1[j] = (fq == 0) ? (x2 * cs[j] + x1 * sn[j]) : x2;
            }
          }
          u32x4 w;
          w.x = pack2(v0[0], v0[1]); w.y = pack2(v0[2], v0[3]); w.z = pack2(v1[0], v1[1]); w.w = pack2(v1[2], v1[3]);
          *(u32x4*)(rowp + bj * HALF) = w;
        }
      }
  }
};
struct EpiRes {
  static constexpr bool PERM = false;
  float* R;
  DEVI void operator()(f32x4 (&acc)[2][2][4][2], const GUnit& u, int wr, int wc, int fr, int fq) const {
    const int row0 = u.pm * 256 + wr * 64 + fr, col0 = u.pn * 256 + wc * 32 + 4 * fq;
#pragma unroll
    for (int ai = 0; ai < 2; ++ai)
#pragma unroll
      for (int m = 0; m < 4; ++m) {
        float* rowp = R + (size_t)(row0 + ai * HALF + m * 16) * 1024 + col0;
#pragma unroll
        for (int bj = 0; bj < 2; ++bj)
#pragma unroll
          for (int n = 0; n < 2; ++n) {
            f32x4* q = (f32x4*)(rowp + bj * HALF + n * 16);
            const f32x4 old = *q;
            *q = old * ALPHA_ + acc[ai][bj][m][n];
          }
      }
  }
};
struct EpiSoftmax {
  static constexpr bool PERM = true;
  u16* C;
  DEVI void operator()(f32x4 (&acc)[2][2][4][2], const GUnit& u, int wr, int wc, int fr, int fq) const {
    extern __shared__ __attribute__((aligned(16))) unsigned char smem[];
    float* red = (float*)(smem + OFF_RED);
    const float sc2 = 0.0625f * LOG2E_;
#pragma unroll
    for (int ai = 0; ai < 2; ++ai)
#pragma unroll
      for (int m = 0; m < 4; ++m) {
        float mx = -__builtin_inff();
#pragma unroll
        for (int bj = 0; bj < 2; ++bj)
#pragma unroll
          for (int n = 0; n < 2; ++n)
#pragma unroll
            for (int j = 0; j < 4; ++j) mx = fmaxf(mx, acc[ai][bj][m][n][j]);
        mx = fmaxf(mx, __shfl_xor(mx, 16));
        mx = fmaxf(mx, __shfl_xor(mx, 32));
        float sum = 0.f;
#pragma unroll
        for (int bj = 0; bj < 2; ++bj)
#pragma unroll
          for (int n = 0; n < 2; ++n)
#pragma unroll
            for (int j = 0; j < 4; ++j) sum += __builtin_amdgcn_exp2f((acc[ai][bj][m][n][j] - mx) * sc2);
        sum += __shfl_xor(sum, 16);
        sum += __shfl_xor(sum, 32);
        if (fq == 0) *(float2*)(red + ((ai * HALF + wr * 64 + m * 16 + fr) * 4 + wc) * 2) = make_float2(mx, sum);
        __builtin_amdgcn_sched_barrier(0);
      }
    __syncthreads();
    u16* cbase = C + (size_t)(u.pm * 256 + wr * 64 + fr) * 1024 + u.pn * 256 + wc * 32 + 8 * fq;
#pragma unroll
    for (int ai = 0; ai < 2; ++ai)
#pragma unroll
      for (int m = 0; m < 4; ++m) {
        const int rl = ai * HALF + wr * 64 + m * 16 + fr;
        const f32x4 ra = *(const f32x4*)(red + rl * 8), rb = *(const f32x4*)(red + rl * 8 + 4);
        const float mx = fmaxf(fmaxf(ra[0], ra[2]), fmaxf(rb[0], rb[2]));
        const float L = ra[1] * __builtin_amdgcn_exp2f((ra[0] - mx) * sc2) + ra[3] * __builtin_amdgcn_exp2f((ra[2] - mx) * sc2) +
                        rb[1] * __builtin_amdgcn_exp2f((rb[0] - mx) * sc2) + rb[3] * __builtin_amdgcn_exp2f((rb[2] - mx) * sc2);
        const float inv = 1.f / L;
        u16* rowp = cbase + (size_t)(ai * HALF + m * 16) * 1024;
#pragma unroll
        for (int bj = 0; bj < 2; ++bj) {
          f32x4 v0 = acc[ai][bj][m][0], v1 = acc[ai][bj][m][1];
#pragma unroll
          for (int j = 0; j < 4; ++j) {
            v0[j] = __builtin_amdgcn_exp2f((v0[j] - mx) * sc2) * inv;
            v1[j] = __builtin_amdgcn_exp2f((v1[j] - mx) * sc2) * inv;
          }
          u32x4 w;
          w.x = pack2(v0[0], v0[1]); w.y = pack2(v0[2], v0[3]); w.z = pack2(v1[0], v1[1]); w.w = pack2(v1[2], v1[3]);
          *(u32x4*)(rowp + bj * HALF) = w;
        }
        __builtin_amdgcn_sched_barrier(0);
      }
    __syncthreads();
  }
};

template <class Epi>
DEVI void gemm_phase(const int lda, const int ldb, const int K, const Sched& S, const Epi& E) {
  extern __shared__ __attribute__((aligned(16))) unsigned char smem[];
  LAS unsigned char* lds = (LAS unsigned char*)smem;
  const int tid = TIDX, wid = __builtin_amdgcn_readfirstlane(tid >> 6), lane = tid & 63, wr = wid >> 2, wc = wid & 3,
            fr = lane & 15, fq = lane >> 4;
  const int nt = opaque_s(K) / BK;
  unsigned voffA[2], voffB[2];
#pragma unroll
  for (int i = 0; i < 2; ++i) {
    int R, C;
    stage_rc(tid * 16 + i * 8192, R, C);
    const int Rb = Epi::PERM ? ((R & ~31) + perm32(R & 31)) : R;
    voffA[i] = (unsigned)(R * lda + C) * 2u;
    voffB[i] = (unsigned)(Rb * ldb + C) * 2u;
  }
  const size_t kstep = (size_t)(BK * 2);
  const size_t hstepA = (size_t)HALF * lda * 2, hstepB = (size_t)HALF * ldb * 2;
  const unsigned ldsw = (unsigned)wid * 1024u;
  const int aoff = lds_byte(wr * 64 + fr, fq * 8), boff = lds_byte(wc * 32 + fr, fq * 8);
#define PG8_SA(b, h) (((b) * 2 + (h)) * HTB)
#define PG8_SB(b, h) ((4 + (b) * 2 + (h)) * HTB)
#define PG8_STAGE(bufoff, gbase, voff)                                                                                \
  do {                                                                                                                \
    _Pragma("unroll") for (int _i = 0; _i < 2; ++_i) __builtin_amdgcn_global_load_lds(                                \
        (const unsigned*)((const char*)(gbase) + (voff)[_i]), (LAS unsigned*)(lds + (bufoff) + ldsw + _i * 8192), 16, 0, 0); \
  } while (0)
#define PG8_LDA(dst, b, h)                                                                                            \
  do {                                                                                                                \
    _Pragma("unroll") for (int m = 0; m < 4; ++m) _Pragma("unroll") for (int k = 0; k < 2; ++k) dst[m][k] =           \
        *(const LAS bf16x8*)(lds + PG8_SA(b, h) + aoff + m * 2048 + k * 1024);                                        \
  } while (0)
#define PG8_LDB(dst, b, h)                                                                                            \
  do {                                                                                                                \
    _Pragma("unroll") for (int n = 0; n < 2; ++n) _Pragma("unroll") for (int k = 0; k < 2; ++k) dst[n][k] =           \
        *(const LAS bf16x8*)(lds + PG8_SB(b, h) + boff + n * 2048 + k * 1024);                                        \
  } while (0)
#define PG8_MMA(ai, bj, At, Bt)                                                                                       \
  do {                                                                                                                \
    __builtin_amdgcn_s_setprio(1);                                                                                    \
    _Pragma("unroll") for (int m = 0; m < 4; ++m) _Pragma("unroll") for (int n = 0; n < 2; ++n)                       \
        _Pragma("unroll") for (int k = 0; k < 2; ++k) acc[ai][bj][m][n] =                                             \
            __builtin_amdgcn_mfma_f32_16x16x32_bf16(Bt[n][k], At[m][k], acc[ai][bj][m][n], 0, 0, 0);                  \
    __builtin_amdgcn_s_setprio(0);                                                                                    \
  } while (0)
#define PG8_WAIT_V(n) asm volatile("s_waitcnt vmcnt(" #n ")" ::: "memory")
#define PG8_WAIT_L(n) asm volatile("s_waitcnt lgkmcnt(" #n ")" ::: "memory")
#define PG8_BAR __builtin_amdgcn_s_barrier()
#define PG8_SCHED __builtin_amdgcn_sched_barrier(0)
  GUnit cur, nxt;
  int ui = 0;
  if (S.next(0, cur)) {
    f32x4 acc[2][2][4][2];
#pragma unroll
    for (int a = 0; a < 2; ++a)
#pragma unroll
      for (int b = 0; b < 2; ++b)
#pragma unroll
        for (int m = 0; m < 4; ++m)
#pragma unroll
          for (int n = 0; n < 2; ++n) acc[a][b][m][n] = (f32x4){0.f, 0.f, 0.f, 0.f};
    bf16x8 At[4][2], B0[2][2], B1[2][2];
    const char* cA = cur.a;
    const char* cB = cur.b;
    PG8_WAIT_V(0);
    PG8_STAGE(PG8_SB(0, 0), cB, voffB); PG8_STAGE(PG8_SA(0, 0), cA, voffA);
    PG8_STAGE(PG8_SB(0, 1), cB + hstepB, voffB); PG8_STAGE(PG8_SA(0, 1), cA + hstepA, voffA);
    if (wr == 1) PG8_BAR;
    PG8_WAIT_V(4); PG8_BAR;
    PG8_STAGE(PG8_SB(1, 0), cB + kstep, voffB); PG8_STAGE(PG8_SA(1, 0), cA + kstep, voffA);
    PG8_STAGE(PG8_SB(1, 1), cB + hstepB + kstep, voffB);
    PG8_WAIT_V(6); PG8_BAR;
    for (;;) {
      const bool has_next = S.next(ui + 1, nxt);
      const char* nA = has_next ? nxt.a : cA;
      const char* nB = has_next ? nxt.b : cB;
      for (int t = 0; t < nt; t += 2) {
        const bool last = (t == nt - 2);
        const char* a1 = cA + (size_t)(t + 1) * kstep;
        const char* a2 = last ? nA : cA + (size_t)(t + 2) * kstep;
        const char* b2 = last ? nB : cB + (size_t)(t + 2) * kstep;
        const char* a3 = a2 + kstep;
        const char* b3 = b2 + kstep;
        PG8_LDB(B0, 0, 0); PG8_SCHED; PG8_LDA(At, 0, 0); PG8_STAGE(PG8_SA(1, 1), a1 + hstepA, voffA);
        PG8_WAIT_L(8); PG8_BAR; PG8_WAIT_L(0); PG8_MMA(0, 0, At, B0); PG8_BAR; PG8_SCHED;
        PG8_LDB(B1, 0, 1); PG8_STAGE(PG8_SB(0, 0), b2, voffB);
        PG8_BAR; PG8_WAIT_L(0); PG8_MMA(0, 1, At, B1); PG8_BAR;
        PG8_LDA(At, 0, 1); PG8_STAGE(PG8_SA(0, 0), a2, voffA);
        PG8_BAR; PG8_WAIT_L(0); PG8_MMA(1, 0, At, B0); PG8_BAR; PG8_SCHED;
        PG8_STAGE(PG8_SB(0, 1), b2 + hstepB, voffB);
        PG8_WAIT_V(6); PG8_BAR; PG8_MMA(1, 1, At, B1); PG8_BAR;
        PG8_LDB(B0, 1, 0); PG8_SCHED; PG8_LDA(At, 1, 0); PG8_STAGE(PG8_SA(0, 1), a2 + hstepA, voffA);
        PG8_WAIT_L(8); PG8_BAR; PG8_WAIT_L(0); PG8_MMA(0, 0, At, B0); PG8_BAR; PG8_SCHED;
        PG8_LDB(B1, 1, 1); PG8_STAGE(PG8_SB(1, 0), b3, voffB);
        PG8_BAR; PG8_WAIT_L(0); PG8_MMA(0, 1, At, B1); PG8_BAR;
        PG8_LDA(At, 1, 1); PG8_STAGE(PG8_SA(1, 0), a3, voffA);
        PG8_BAR; PG8_WAIT_L(0); PG8_MMA(1, 0, At, B0); PG8_BAR; PG8_SCHED;
        PG8_STAGE(PG8_SB(1, 1), b3 + hstepB, voffB);
        PG8_WAIT_V(6); PG8_BAR; PG8_MMA(1, 1, At, B1); PG8_BAR;
      }
      E(acc, cur, wr, wc, fr, fq);
      if (!has_next) break;
#pragma unroll
      for (int a = 0; a < 2; ++a)
#pragma unroll
        for (int b = 0; b < 2; ++b)
#pragma unroll
          for (int m = 0; m < 4; ++m)
#pragma unroll
            for (int n = 0; n < 2; ++n) acc[a][b][m][n] = (f32x4){0.f, 0.f, 0.f, 0.f};
      cur = nxt; cA = nA; cB = nB; ++ui;
    }
    PG8_WAIT_V(0);
    if (wr == 0) PG8_BAR;
    PG8_BAR;
  }
  __syncthreads();
#undef PG8_SA
#undef PG8_SB
#undef PG8_STAGE
#undef PG8_LDA
#undef PG8_LDB
#undef PG8_MMA
}

DEVI void sincos_acc(float ang, float& c, float& s) {
  const double TWO_PI = 6.283185307179586476925286766559;
  double a = (double)ang;
  double k = rint(a * (1.0 / TWO_PI));
  double r = a - k * TWO_PI;
  double r2 = r * r;
  double sn = 0.0, cs = 0.0;
  double ts = r, tc = 1.0;
#pragma unroll
  for (int n = 0; n < 12; ++n) {
    sn += ts;
    cs += tc;
    ts *= -r2 / (double)((2 * n + 2) * (2 * n + 3));
    tc *= -r2 / (double)((2 * n + 1) * (2 * n + 2));
  }
  c = (float)cs;
  s = (float)sn;
}

DEVI void phase0(const Params& p) {
  const int tid0 = TIDX, bid0 = BIDX;
  const long gtid = (long)bid0 * 512 + tid0, gsz = (long)gridDim.x * 512;
  {
    const float4* x4 = (const float4*)p.in[0];
    float4* r4 = (float4*)p.out;
    uint2* X2 = (uint2*)(p.ws + WS_X);
    for (long i = gtid; i < (long)T_ * D_ / 4; i += gsz) {
      float4 v = x4[i];
      r4[i] = v;
      X2[i] = make_uint2(pack2(v.x, v.y), pack2(v.z, v.w));
    }
    const float4* m4 = (const float4*)p.in[1];
    uint2* M2 = (uint2*)(p.ws + WS_MB);
    for (long i = gtid; i < 512L * 1024 / 4; i += gsz) {
      float4 v = m4[i];
      M2[i] = make_uint2(pack2(v.x, v.y), pack2(v.z, v.w));
    }
  }
  {
    const int* pos = (const int*)p.in[2];
    float* rd = (float*)(p.ws + WS_ROPED);
    float* ri = (float*)(p.ws + WS_ROPEI);
    for (long i = gtid; i < (long)T_ * 12; i += gsz) {
      const int t = (int)(i / 12), f = (int)(i % 12);
      const float ps = (float)pos[t];
      float c, s;
      if (f < 8) {
        sincos_acc(ps * INV8_[f], c, s);
        rd[t * 16 + f] = c;
        rd[t * 16 + 8 + f] = s;
      } else {
        sincos_acc(ps * INV4_[f - 8], c, s);
        ri[t * 8 + (f - 8)] = c;
        ri[t * 8 + 4 + (f - 8)] = s;
      }
    }
  }
  if (bid0 == 0 && tid0 < 64) ((unsigned*)(p.ws + WS_CTL))[tid0] = 0u;
}

DEVI int map_in(int nd) {
  if (nd < 1576) return nd;
  if (nd < 1600) return -1;
  if (nd < 2368) return nd - 24;
  if (nd < 2560) return -1;
  if (nd < 2944) return nd - 216;
  return -1;
}

DEVI void convert_weights(const Params& p, int l) {
  extern __shared__ __attribute__((aligned(16))) unsigned char smem[];
  float* lt = (float*)smem;
  u16* WT = (u16*)(p.ws + WS_WT);
  const int t = TIDX;
  for (int tile = BIDX; tile < 4096; tile += gridDim.x) {
    const float* src;
    u16* dst;
    int K, Nsrc, mode = 0, tl;
    if (tile < 768) { src = p.in[3] + (size_t)l * 1024 * 2728; dst = WT + WT_IN; K = 1024; Nsrc = 2728; mode = 1; tl = tile; }
    else if (tile < 1024) { src = p.in[6] + (size_t)l * 1024 * 1024; dst = WT + WT_OUT; K = 1024; Nsrc = 1024; tl = tile - 768; }
    else if (tile < 1280) { src = p.in[9] + (size_t)l * 1024 * 1024; dst = WT + WT_MQ; K = 1024; Nsrc = 1024; tl = tile - 1024; }
    else if (tile < 1792) { src = p.in[10] + (size_t)l * 1024 * 2048; dst = WT + WT_KV; K = 1024; Nsrc = 2048; tl = tile - 1280; }
    else if (tile < 2048) { src = p.in[11] + (size_t)l * 1024 * 1024; dst = WT + WT_MO; K = 1024; Nsrc = 1024; tl = tile - 1792; }
    else if (tile < 3072) { src = p.in[14] + (size_t)l * 1024 * 4096; dst = WT + WT_FF1; K = 1024; Nsrc = 4096; tl = tile - 2048; }
    else { src = p.in[15] + (size_t)l * 4096 * 1024; dst = WT + WT_FF2; K = 4096; Nsrc = 1024; tl = tile - 3072; }
    const int nkt = K / 64;
    const int nt = tl / nkt, kt = tl % nkt;
    {
      const int n = t & 63, k0 = t >> 6;
      const int nd = nt * 64 + n;
      const int ns = mode ? map_in(nd) : nd;
#pragma unroll
      for (int i = 0; i < 8; ++i) {
        const int k = k0 + 8 * i;
        lt[k * 65 + n] = (ns >= 0) ? src[(size_t)(kt * 64 + k) * Nsrc + ns] : 0.f;
      }
    }
    __syncthreads();
    {
      const int n2 = t >> 3, ks = (t & 7) * 8;
      uint4 o;
      o.x = pack2(lt[(ks + 0) * 65 + n2], lt[(ks + 1) * 65 + n2]);
      o.y = pack2(lt[(ks + 2) * 65 + n2], lt[(ks + 3) * 65 + n2]);
      o.z = pack2(lt[(ks + 4) * 65 + n2], lt[(ks + 5) * 65 + n2]);
      o.w = pack2(lt[(ks + 6) * 65 + n2], lt[(ks + 7) * 65 + n2]);
      *(uint4*)(dst + (size_t)(nt * 64 + n2) * K + kt * 64 + ks) = o;
    }
    __syncthreads();
  }
}

DEVI float wave_sum(float v) {
  v += __shfl_xor(v, 32);
  v += __shfl_xor(v, 16);
  v += __shfl_xor(v, 8);
  v += __shfl_xor(v, 4);
  v += __shfl_xor(v, 2);
  v += __shfl_xor(v, 1);
  return v;
}
DEVI void ln_phase(const Params& p, const float* g, const float* b) {
  const int tidl = TIDX;
  const int wave = tidl >> 6, lane = tidl & 63;
  float* R = p.out;
  u16* X = (u16*)(p.ws + WS_X);
  float4 gg[4], bb[4];
#pragma unroll
  for (int i = 0; i < 4; ++i) {
    gg[i] = ((const float4*)g)[lane + 64 * i];
    bb[i] = ((const float4*)b)[lane + 64 * i];
  }
  for (int row = BIDX * 8 + wave; row < T_; row += gridDim.x * 8) {
    float4* rp = (float4*)(R + (size_t)row * 1024);
    float4 v[4];
#pragma unroll
    for (int i = 0; i < 4; ++i) v[i] = rp[lane + 64 * i];
    float s = 0.f;
#pragma unroll
    for (int i = 0; i < 4; ++i) s += v[i].x + v[i].y + v[i].z + v[i].w;
    const float mu = wave_sum(s) * (1.f / 1024.f);
    float q = 0.f;
#pragma unroll
    for (int i = 0; i < 4; ++i) {
      v[i].x -= mu; v[i].y -= mu; v[i].z -= mu; v[i].w -= mu;
      q += v[i].x * v[i].x + v[i].y * v[i].y + v[i].z * v[i].z + v[i].w * v[i].w;
    }
    const float rs = rsqrtf(wave_sum(q) * (1.f / 1024.f) + 1e-5f);
    uint2* xp = (uint2*)(X + (size_t)row * 1024);
#pragma unroll
    for (int i = 0; i < 4; ++i) {
      float4 o;
      o.x = v[i].x * rs * gg[i].x + bb[i].x;
      o.y = v[i].y * rs * gg[i].y + bb[i].y;
      o.z = v[i].z * rs * gg[i].z + bb[i].z;
      o.w = v[i].w * rs * gg[i].w + bb[i].w;
      rp[lane + 64 * i] = o;
      xp[lane + 64 * i] = make_uint2(pack2(o.x, o.y), pack2(o.z, o.w));
    }
  }
}

DEVI unsigned mono_key(float s) {
  unsigned u = __float_as_uint(s);
  return (u & 0x80000000u) ? ~u : (u | 0x80000000u);
}

DEVI void dsa_unit(const Params& p, const int u) {
  extern __shared__ __attribute__((aligned(16))) unsigned char smem[];
  const int tid = TIDX, lane = tid & 63, wave = tid >> 6;
  const int c = 255 - (u >> 3), b = (u >> 2) & 1, sub = u & 3;
  const int tok0 = b * S_ + c * 64 + sub * 16;
  const int N = (c + 1) * 64;
  const u16* proj = (const u16*)(p.ws + WS_Z);
  u16* Y = (u16*)(p.ws + WS_Y);
  u16* sel = (u16*)smem;
  float* cand_s = (float*)(smem + 8192);
  unsigned* cand_i = (unsigned*)(smem + 8192 + 16 * CAND_CAP * 4);
  unsigned* bm = (unsigned*)(smem + 73728);
  int* selcnt = (int*)(smem + OFF_CNT);
  int* candcnt = selcnt + 16;
  int* tbin = selcnt + 32;
  float* iwl = (float*)(smem + OFF_IW);

  if (c < 4) {
    for (int i = tid; i < 16 * 256; i += 512) sel[i] = (u16)(i & 255);
    __syncthreads();
  } else {
    if (tid < 128) iwl[tid] = bf2f(proj[(size_t)(tok0 + (tid >> 3)) * PW + C_IW + (tid & 7)]) * 0.35355339059327373f;
    {
      uint4* h4 = (uint4*)smem;
      const uint4 z = make_uint4(0, 0, 0, 0);
      for (int i = tid; i < 131072 / 16; i += 512) h4[i] = z;
    }
    if (tid < 64) selcnt[tid] = 0;
    __syncthreads();
    const int rho = lane & 31, hh = lane >> 5;
    bf16x8 af[4][2];
    float sg[4][16];
#pragma unroll
    for (int rt = 0; rt < 4; ++rt) {
      const int qi = 4 * rt + 2 * (rho >> 4) + ((rho >> 2) & 1);
      const int hd = (rho & 3) + 4 * ((rho >> 3) & 1);
      const float w = iwl[qi * 8 + hd];
#pragma unroll
      for (int s = 0; s < 2; ++s) {
        const uint4 raw = *(const uint4*)(proj + (size_t)(tok0 + qi) * PW + C_IQ + hd * 32 + 16 * s + 8 * hh);
        af[rt][s] = mk8(pack2(bflo(raw.x) * w, bfhi(raw.x) * w), pack2(bflo(raw.y) * w, bfhi(raw.y) * w),
                        pack2(bflo(raw.z) * w, bfhi(raw.z) * w), pack2(bflo(raw.w) * w, bfhi(raw.w) * w));
      }
#pragma unroll
      for (int i = 0; i < 16; ++i) {
        const float w2 = iwl[(4 * rt + 2 * (i >> 3) + hh) * 8 + (i & 7)];
        sg[rt][i] = (w2 > 0.f) ? __builtin_inff() : -__builtin_inff();
      }
    }
    const int ntile = N >> 5;
    const u16* ikb = proj + (size_t)(b * S_ + (lane & 31)) * PW + C_IK + 8 * hh;
    int tb[8];
#pragma unroll
    for (int i = 0; i < 8; ++i) tb[i] = 0;
    for (int pass = 0; pass < 2; ++pass) {
      if (pass == 1) {
#pragma unroll
        for (int i = 0; i < 8; ++i) tb[i] = tbin[4 * (i >> 1) + 2 * (i & 1) + hh];
      }
      int kt = wave;
      bf16x8 cb0 = {}, cb1 = {};
      if (kt < ntile) {
        cb0 = ld8(ikb + (size_t)kt * 32 * PW);
        cb1 = ld8(ikb + (size_t)kt * 32 * PW + 16);
      }
      for (; kt < ntile; kt += 8) {
        bf16x8 nb0 = cb0, nb1 = cb1;
        if (kt + 8 < ntile) {
          nb0 = ld8(ikb + (size_t)(kt + 8) * 32 * PW);
          nb1 = ld8(ikb + (size_t)(kt + 8) * 32 * PW + 16);
        }
        const int key = kt * 32 + (lane & 31);
#pragma unroll
        for (int rt = 0; rt < 4; ++rt) {
          f32x16 acc = {};
          acc = __builtin_amdgcn_mfma_f32_32x32x16_bf16(af[rt][0], cb0, acc, 0, 0, 0);
          acc = __builtin_amdgcn_mfma_f32_32x32x16_bf16(af[rt][1], cb1, acc, 0, 0, 0);
          float s0 = 0.f, s1 = 0.f;
#pragma unroll
          for (int i = 0; i < 8; ++i) s0 += __builtin_amdgcn_fmed3f(acc[i], 0.f, sg[rt][i]);
#pragma unroll
          for (int i = 8; i < 16; ++i) s1 += __builtin_amdgcn_fmed3f(acc[i], 0.f, sg[rt][i]);
#pragma unroll
          for (int uu = 0; uu < 2; ++uu) {
            const float sc = uu ? s1 : s0;
            const int qi = 4 * rt + 2 * uu + hh;
            const int bin = (int)(mono_key(sc) >> 20);
            if (pass == 0) {
              atomicAdd((unsigned*)smem + qi * 2048 + (bin >> 1), 1u << ((bin & 1) * 16));
            } else {
              const int t = tb[rt * 2 + uu];
              if (bin > t) {
                atomicAdd(&selcnt[qi], 1);
                atomicOr(&bm[qi * 512 + (key >> 5)], 1u << (key & 31));
              } else if (bin == t) {
                const int pos = atomicAdd(&candcnt[qi], 1);
                if (pos < CAND_CAP) {
                  cand_s[qi * CAND_CAP + pos] = sc;
                  cand_i[qi * CAND_CAP + pos] = (unsigned)key;
                }
              }
            }
          }
        }
        cb0 = nb0;
        cb1 = nb1;
      }
      __syncthreads();
      if (pass == 0) {
        const int qi = tid >> 5, seg = tid & 31;
        const unsigned* hq = (const unsigned*)smem + qi * 2048 + seg * 64;
        unsigned part = 0;
        for (int w = 0; w < 64; ++w) {
          const unsigned x = hq[(w + seg) & 63];
          part += (x & 0xffffu) + (x >> 16);
        }
        unsigned incl = part;
#pragma unroll
        for (int d = 1; d < 32; d <<= 1) {
          const unsigned o = __shfl_down(incl, d, 32);
          if (seg + d < 32) incl += o;
        }
        const unsigned above = incl - part;
        int mytb = -1;
        if (above < 256u && incl >= 256u) {
          unsigned cum = above;
          for (int w = 63; w >= 0; --w) {
            const unsigned x = hq[w];
            const unsigned chi = x >> 16, clo = x & 0xffffu;
            if (cum + chi >= 256u) { mytb = seg * 128 + 2 * w + 1; break; }
            cum += chi;
            if (cum + clo >= 256u) { mytb = seg * 128 + 2 * w; break; }
            cum += clo;
          }
        }
        __syncthreads();
        {
          uint4* bz = (uint4*)(smem + 73728);
          for (int i = tid; i < 2048; i += 512) bz[i] = make_uint4(0, 0, 0, 0);
        }
        if (mytb >= 0) tbin[qi] = mytb;
        __syncthreads();
      }
    }
    {
      const int qi = tid >> 5, seg = tid & 31;
      const int C = min(candcnt[qi], CAND_CAP);
      const int base = min(selcnt[qi], 256);
      const int need = 256 - base;
      for (int e = seg; e < C; e += 32) {
        const float s = cand_s[qi * CAND_CAP + e];
        const unsigned id = cand_i[qi * CAND_CAP + e];
        int rank = 0;
        for (int f = 0; f < C; ++f) {
          const float s2 = cand_s[qi * CAND_CAP + f];
          const unsigned id2 = cand_i[qi * CAND_CAP + f];
          rank += ((s2 > s) || (s2 == s && id2 < id)) ? 1 : 0;
        }
        if (rank < need) atomicOr(&bm[qi * 512 + (id >> 5)], 1u << (id & 31));
      }
    }
    __syncthreads();
    {
      const int qi = tid >> 5, seg = tid & 31;
      const unsigned* bq = bm + qi * 512 + seg * 16;
      int cnt = 0;
#pragma unroll
      for (int w = 0; w < 16; ++w) cnt += __popc(bq[w]);
      int incl = cnt;
#pragma unroll
      for (int d = 1; d < 32; d <<= 1) {
        const int o = __shfl_up(incl, d, 32);
        if (seg >= d) incl += o;
      }
      int pos = incl - cnt;
      for (int w = 0; w < 16; ++w) {
        unsigned x = bq[w];
        while (x) {
          const int bit = __ffs(x) - 1;
          x &= x - 1;
          if (pos < 256) sel[qi * 256 + pos] = (u16)((seg * 16 + w) * 32 + bit);
          ++pos;
        }
      }
    }
    __syncthreads();
  }

  {
    const int n = (N < 256) ? N : 256;
    const int nt16 = n >> 4;
    const int hc = lane & 15, g4 = lane >> 4;
    u16* Vs = (u16*)(smem + 8192 + wave * 9216);
    const float sc2 = 0.125f * LOG2E_;
    for (int e = 0; e < 2; ++e) {
      const int qq = wave * 2 + e;
      const size_t tok = (size_t)tok0 + qq;
      bf16x8 qf[2];
#pragma unroll
      for (int s = 0; s < 2; ++s) {
        bf16x8 z = {};
        qf[s] = (hc < 6) ? ld8(proj + tok * PW + C_DQ + hc * 64 + 32 * s + 8 * g4) : z;
      }
      f32x4 st[16];
#pragma unroll
      for (int kt = 0; kt < 16; ++kt) {
        if (kt < nt16) {
          const int key = sel[qq * 256 + kt * 16 + hc] & 16383;
          const u16* kp = proj + (size_t)(b * S_ + key) * PW + C_DK + 8 * g4;
          const bf16x8 a0 = ld8(kp), a1 = ld8(kp + 32);
          f32x4 a = {};
          a = __builtin_amdgcn_mfma_f32_16x16x32_bf16(a0, qf[0], a, 0, 0, 0);
          a = __builtin_amdgcn_mfma_f32_16x16x32_bf16(a1, qf[1], a, 0, 0, 0);
          st[kt] = a;
        } else {
          const float ninf = -__builtin_inff();
          st[kt] = f32x4{ninf, ninf, ninf, ninf};
        }
      }
      float mx = -__builtin_inff();
#pragma unroll
      for (int kt = 0; kt < 16; ++kt)
#pragma unroll
        for (int i = 0; i < 4; ++i) mx = fmaxf(mx, st[kt][i]);
      mx = fmaxf(mx, __shfl_xor(mx, 16));
      mx = fmaxf(mx, __shfl_xor(mx, 32));
      float ls = 0.f;
#pragma unroll
      for (int kt = 0; kt < 16; ++kt)
#pragma unroll
        for (int i = 0; i < 4; ++i) {
          const float pv = __builtin_amdgcn_exp2f((st[kt][i] - mx) * sc2);
          st[kt][i] = pv;
          ls += pv;
        }
      ls += __shfl_xor(ls, 16);
      ls += __shfl_xor(ls, 32);
      f32x4 o[4] = {};
#pragma unroll
      for (int ch = 0; ch < 4; ++ch) {
        if (ch * 64 < n) {
#pragma unroll
          for (int it = 0; it < 8; ++it) {
            const int slot = ch * 64 + it * 8 + (lane >> 3);
            const int key = sel[qq * 256 + slot] & 16383;
            const uint4 v = *(const uint4*)(proj + (size_t)(b * S_ + key) * PW + C_DV + 8 * (lane & 7));
            *(uint4*)(Vs + (it * 8 + (lane >> 3)) * 72 + 8 * (lane & 7)) = v;
          }
          asm volatile("s_waitcnt lgkmcnt(0)" ::: "memory");
#pragma unroll
          for (int tt = 0; tt < 2; ++tt) {
            const int t2 = (ch * 2 + tt) * 2;
            const bf16x8 pb = mk8(pack2(st[t2][0], st[t2][1]), pack2(st[t2][2], st[t2][3]),
                                  pack2(st[t2 + 1][0], st[t2 + 1][1]), pack2(st[t2 + 1][2], st[t2 + 1][3]));
#pragma unroll
            for (int dt = 0; dt < 4; ++dt) {
              bf16x8 va;
#pragma unroll
              for (int j = 0; j < 8; ++j)
                va[j] = (short)Vs[(32 * tt + 16 * (j >> 2) + 4 * g4 + (j & 3)) * 72 + 16 * dt + hc];
              o[dt] = __builtin_amdgcn_mfma_f32_16x16x32_bf16(va, pb, o[dt], 0, 0, 0);
            }
          }
          asm volatile("s_waitcnt lgkmcnt(0)" ::: "memory");
        }
      }
      const float inv = 1.f / ls;
      if (hc < 6) {
#pragma unroll
        for (int dt = 0; dt < 4; ++dt) {
          uint2 w2 = make_uint2(pack2(o[dt][0] * inv, o[dt][1] * inv), pack2(o[dt][2] * inv, o[dt][3] * inv));
          *(uint2*)(Y + tok * 1024 + 256 + hc * 64 + 16 * dt + 4 * g4) = w2;
        }
      }
    }
  }
  __syncthreads();
}

DEVI void band_unit(const Params& p, const int U) {
  extern __shared__ __attribute__((aligned(16))) unsigned char smem[];
  const int tid = TIDX, lane = tid & 63, wave = tid >> 6;
  const int wu = U * 8 + wave;
  const int qh = wu & 1, h = (wu >> 1) % 6, bc = wu / 12, c = bc & 255, b = bc >> 8;
  const int r = lane & 31, g = lane >> 5;
  const u16* proj = (const u16*)(p.ws + WS_Z);
  const u16* Vt = (const u16*)(p.ws + WS_VT);
  u16* Y = (u16*)(p.ws + WS_Y);
  const float* rb = (const float*)(smem + OFF_RB) + h * 192;
  const size_t tokq = (size_t)b * S_ + c * 64 + qh * 32 + r;
  bf16x8 qf[4];
#pragma unroll
  for (int s = 0; s < 4; ++s) qf[s] = ld8(proj + tokq * PW + C_CQ + h * 64 + 16 * s + 8 * g);
  const int c0 = (c >= 8) ? (c - 8) : 0;
  const int kt0 = c0 * 2, kt1 = (c + 1) * 2;
  const int pr = (r & 16) | ((r & 4) << 1) | ((r & 8) >> 1) | (r & 3);
  const int qpos = c * 64 + qh * 32 + r;
  const float SC2 = 0.125f * LOG2E_;
  f32x16 o0 = {}, o1 = {};
  float m = -1e30f, ls = 0.f;
  for (int kt = kt0; kt < kt1; ++kt) {
    const u16* kp = proj + (size_t)(b * S_ + kt * 32 + pr) * PW + C_CK + h * 64 + 8 * g;
    const bf16x8 k0 = ld8(kp), k1 = ld8(kp + 16), k2 = ld8(kp + 32), k3 = ld8(kp + 48);
    const u16* vp = Vt + (size_t)(h * 64 + r) * T_ + (size_t)b * S_ + kt * 32 + 8 * g;
    const bf16x8 v00 = ld8(vp), v01 = ld8(vp + 16), v10 = ld8(vp + (size_t)32 * T_), v11 = ld8(vp + (size_t)32 * T_ + 16);
    f32x16 s = {};
    s = __builtin_amdgcn_mfma_f32_32x32x16_bf16(k0, qf[0], s, 0, 0, 0);
    s = __builtin_amdgcn_mfma_f32_32x32x16_bf16(k1, qf[1], s, 0, 0, 0);
    s = __builtin_amdgcn_mfma_f32_32x32x16_bf16(k2, qf[2], s, 0, 0, 0);
    s = __builtin_amdgcn_mfma_f32_32x32x16_bf16(k3, qf[3], s, 0, 0, 0);
    float tm = -1e30f;
    const int kb = kt * 32 + 8 * g;
#pragma unroll
    for (int i = 0; i < 16; ++i) {
      int rel = qpos - (kb + 16 * (i >> 3) + (i & 7));
      rel = min(max(rel, -63), 128) + 63;
      const float v = s[i] * SC2 + rb[rel];
      s[i] = v;
      tm = fmaxf(tm, v);
    }
    tm = fmaxf(tm, __shfl_xor(tm, 32));
    const float mn = fmaxf(m, tm);
    const float al = __builtin_amdgcn_exp2f(m - mn);
    m = mn;
    float psum = 0.f;
#pragma unroll
    for (int i = 0; i < 16; ++i) {
      const float pv = __builtin_amdgcn_exp2f(s[i] - mn);
      s[i] = pv;
      psum += pv;
    }
    ls = ls * al + psum;
#pragma unroll
    for (int i = 0; i < 16; ++i) {
      o0[i] *= al;
      o1[i] *= al;
    }
    const bf16x8 pb0 = mk8(pack2(s[0], s[1]), pack2(s[2], s[3]), pack2(s[4], s[5]), pack2(s[6], s[7]));
    const bf16x8 pb1 = mk8(pack2(s[8], s[9]), pack2(s[10], s[11]), pack2(s[12], s[13]), pack2(s[14], s[15]));
    o0 = __builtin_amdgcn_mfma_f32_32x32x16_bf16(v00, pb0, o0, 0, 0, 0);
    o0 = __builtin_amdgcn_mfma_f32_32x32x16_bf16(v01, pb1, o0, 0, 0, 0);
    o1 = __builtin_amdgcn_mfma_f32_32x32x16_bf16(v10, pb0, o1, 0, 0, 0);
    o1 = __builtin_amdgcn_mfma_f32_32x32x16_bf16(v11, pb1, o1, 0, 0, 0);
  }
  ls += __shfl_xor(ls, 32);
  const float inv = 1.f / ls;
  u16* yp = Y + tokq * 1024 + 640 + h * 64 + 4 * g;
#pragma unroll
  for (int i4 = 0; i4 < 4; ++i4) {
    *(uint2*)(yp + 8 * i4) = make_uint2(pack2(o0[4 * i4] * inv, o0[4 * i4 + 1] * inv), pack2(o0[4 * i4 + 2] * inv, o0[4 * i4 + 3] * inv));
    *(uint2*)(yp + 32 + 8 * i4) = make_uint2(pack2(o1[4 * i4] * inv, o1[4 * i4 + 1] * inv), pack2(o1[4 * i4 + 2] * inv, o1[4 * i4 + 3] * inv));
  }
}

DEVI void conv_unit(const Params& p, const int l, const int U) {
  const u16* proj = (const u16*)(p.ws + WS_Z);
  u16* Y = (u16*)(p.ws + WS_Y);
  const float* cw = p.in[4] + (size_t)l * 3 * 256;
#pragma unroll 1
  for (int it = 0; it < 8; ++it) {
    const int item = TIDX + 512 * it;
    const int tok = U * 128 + (item >> 5), cg8 = (item & 31) * 8;
    const int s = tok & (S_ - 1);
    const uint4 cb = *(const uint4*)(proj + (size_t)tok * PW + C_CB + cg8);
    float acc[8];
#pragma unroll
    for (int e = 0; e < 8; ++e) acc[e] = 0.f;
#pragma unroll
    for (int j = 0; j < 3; ++j) {
      const int dt = 2 - j;
      if (s - dt >= 0) {
        const uint4 cc = *(const uint4*)(proj + (size_t)(tok - dt) * PW + C_CC + cg8);
        const uint4 ch = *(const uint4*)(proj + (size_t)(tok - dt) * PW + C_CH + cg8);
        const float4 w0 = *(const float4*)(cw + j * 256 + cg8);
        const float4 w1 = *(const float4*)(cw + j * 256 + cg8 + 4);
        acc[0] += w0.x * bflo(cc.x) * bflo(ch.x);
        acc[1] += w0.y * bfhi(cc.x) * bfhi(ch.x);
        acc[2] += w0.z * bflo(cc.y) * bflo(ch.y);
        acc[3] += w0.w * bfhi(cc.y) * bfhi(ch.y);
        acc[4] += w1.x * bflo(cc.z) * bflo(ch.z);
        acc[5] += w1.y * bfhi(cc.z) * bfhi(ch.z);
        acc[6] += w1.z * bflo(cc.w) * bflo(ch.w);
        acc[7] += w1.w * bfhi(cc.w) * bfhi(ch.w);
      }
    }
    uint4 o;
    o.x = pack2(bflo(cb.x) * acc[0], bfhi(cb.x) * acc[1]);
    o.y = pack2(bflo(cb.y) * acc[2], bfhi(cb.y) * acc[3]);
    o.z = pack2(bflo(cb.z) * acc[4], bfhi(cb.z) * acc[5]);
    o.w = pack2(bflo(cb.w) * acc[6], bfhi(cb.w) * acc[7]);
    *(uint4*)(Y + (size_t)tok * 1024 + cg8) = o;
  }
}

DEVI void memkv_unit(const Params& p, const int u) {
  const u16* WT = (const u16*)(p.ws + WS_WT);
  const u16* Mb = (const u16*)(p.ws + WS_MB);
  Sched S{};
  S.nM = 1; S.nN = 1; S.G = 1; S.c = 0;
  if (u < 8) {
    const int pm = u >> 2, pn = u & 3;
    S.A = (const char*)(Mb + (size_t)pm * 256 * 1024);
    S.B = (const char*)(WT + WT_KV + (size_t)pn * 256 * 1024);
    EpiStore16<0> E{(u16*)(p.ws + WS_KM) + (size_t)pm * 256 * 1024 + pn * 256, 1024};
    gemm_phase(1024, 1024, 1024, S, E);
  } else {
    const int v = u - 8, pm = v >> 1, pn = v & 1;
    S.A = (const char*)(WT + WT_KV + (size_t)(1024 + pm * 256) * 1024);
    S.B = (const char*)(Mb + (size_t)pn * 256 * 1024);
    EpiStore16<0> E{(u16*)(p.ws + WS_VTM) + (size_t)pm * 256 * 512 + pn * 256, 512};
    gemm_phase(1024, 1024, 1024, S, E);
  }
}

constexpr int NU_KV = 16, NU_DSA = 2048, NU_BAND = 768, NU_CONV = 256;
DEVI void phase_mixer(const Params& p, const int l) {
  extern __shared__ __attribute__((aligned(16))) unsigned char smem[];
  const int tid = TIDX;
  float* rb = (float*)(smem + OFF_RB);
  for (int i = tid; i < 6 * 192; i += 512) rb[i] = p.in[5][(size_t)l * 6 * 192 + i] * LOG2E_;
  const int G = (int)gridDim.x, bid = BIDX;
  __syncthreads();
  if (bid >= G - NU_KV) memkv_unit(p, bid - (G - NU_KV));
  const int NU = NU_DSA + NU_BAND + NU_CONV;
  for (int rnd = 0;; ++rnd) {
    const int base = rnd * G;
    if (base >= NU) break;
    const int u = base + ((rnd & 1) ? (G - 1 - bid) : bid);
    if (u < NU) {
      if (u < NU_DSA) dsa_unit(p, u);
      else if (u < NU_DSA + NU_BAND) band_unit(p, u - NU_DSA);
      else conv_unit(p, l, u - NU_DSA - NU_BAND);
    }
    __syncthreads();
  }
}

DEVI Sched mk_sched(const void* A, const void* B, size_t aStepM, size_t bStepN, int nM, int nN) {
  Sched S{};
  S.A = (const char*)A; S.B = (const char*)B;
  S.aStepM = aStepM; S.aStepN = 0; S.bStepN = bStepN; S.bStepB = 0;
  S.nM = nM; S.nN = nN; S.G = (int)gridDim.x; S.c = BIDX;
  return S;
}
DEVI void phase_inproj(const Params& p) {
  const u16* X = (const u16*)(p.ws + WS_X);
  const u16* WT = (const u16*)(p.ws + WS_WT) + WT_IN;
  {
    const Sched S = mk_sched(X, WT, 256 * 1024 * 2, 256 * 1024 * 2, 128, 10);
    EpiProj E{(u16*)(p.ws + WS_Z), (const float*)(p.ws + WS_ROPED), (const float*)(p.ws + WS_ROPEI)};
    gemm_phase(1024, 1024, 1024, S, E);
  }
  {
    const Sched S = mk_sched(WT + (size_t)2560 * 1024, X, 256 * 1024 * 2, 256 * 1024 * 2, 2, 128);
    EpiStore16<0> E{(u16*)(p.ws + WS_VT), T_};
    gemm_phase(1024, 1024, 1024, S, E);
  }
}
DEVI void phase_gemm_res(const Params& p, const int which) {
  const u16* A = (const u16*)(p.ws + (which == 0 ? WS_Y : (which == 1 ? WS_O : WS_H)));
  const u16* W = (const u16*)(p.ws + WS_WT) + (which == 0 ? WT_OUT : (which == 1 ? WT_MO : WT_FF2));
  const int K = (which == 2) ? 4096 : 1024;
  const Sched S = mk_sched(A, W, (size_t)256 * K * 2, (size_t)256 * K * 2, 128, 4);
  EpiRes E{p.out};
  gemm_phase(K, K, K, S, E);
}
DEVI void phase_gemm_q(const Params& p) {
  const Sched S = mk_sched(p.ws + WS_X, (const u16*)(p.ws + WS_WT) + WT_MQ, 256 * 1024 * 2, 256 * 1024 * 2, 128, 4);
  EpiStore16<0> E{(u16*)(p.ws + WS_Q), 1024};
  gemm_phase(1024, 1024, 1024, S, E);
}
DEVI void phase_gemm_s(const Params& p) {
  Sched S = mk_sched(p.ws + WS_Q, p.ws + WS_KM, 256 * 1024 * 2, 256 * 2, 128, 4);
  S.aStepN = 256 * 2;
  S.bStepB = 256 * 1024 * 2;
  EpiSoftmax E{(u16*)(p.ws + WS_P)};
  gemm_phase(1024, 1024, 256, S, E);
}
DEVI void phase_gemm_pv(const Params& p) {
  Sched S = mk_sched(p.ws + WS_P, p.ws + WS_VTM, 256 * 1024 * 2, 256 * 512 * 2, 128, 4);
  S.aStepN = 256 * 2;
  S.bStepB = 256 * 2;
  EpiStore16<0> E{(u16*)(p.ws + WS_O), 1024};
  gemm_phase(1024, 512, 256, S, E);
}
DEVI void phase_gemm_ff1(const Params& p) {
  const Sched S = mk_sched(p.ws + WS_X, (const u16*)(p.ws + WS_WT) + WT_FF1, 256 * 1024 * 2, 256 * 1024 * 2, 128, 16);
  EpiStore16<1> E{(u16*)(p.ws + WS_H), 4096};
  gemm_phase(1024, 1024, 1024, S, E);
}

DEVI void grid_seam(cg::grid_group& grid) {
  asm volatile("s_waitcnt vmcnt(0) lgkmcnt(0)" ::: "memory");
  __builtin_amdgcn_fence(__ATOMIC_RELEASE, "agent");
  asm volatile("s_waitcnt vmcnt(0)" ::: "memory");
  grid.sync();
  __builtin_amdgcn_fence(__ATOMIC_ACQUIRE, "agent");
  asm volatile("s_waitcnt vmcnt(0)" ::: "memory");
}
#define PHASE(stmt)                  \
  do {                               \
    Params q = p;                    \
    const int _z = opaque_s(0);      \
    q.ws = p.ws + _z;                \
    q.out = p.out + _z;              \
    stmt;                            \
  } while (0)
__global__ void __launch_bounds__(512, 2) mega(Params p) {
  cg::grid_group grid = cg::this_grid();
  PHASE(phase0(q));
  PHASE(convert_weights(q, 0));
  grid_seam(grid);
#pragma unroll 1
  for (int l = 0; l < NL_; ++l) {
    PHASE(phase_inproj(q));
    grid_seam(grid);
    PHASE(phase_mixer(q, l));
    grid_seam(grid);
    PHASE(phase_gemm_res(q, 0));
    grid_seam(grid);
    PHASE(ln_phase(q, q.in[7] + l * 1024, q.in[8] + l * 1024));
    grid_seam(grid);
    PHASE(phase_gemm_q(q));
    grid_seam(grid);
    PHASE(phase_gemm_s(q));
    grid_seam(grid);
    PHASE(phase_gemm_pv(q));
    grid_seam(grid);
    PHASE(phase_gemm_res(q, 1));
    grid_seam(grid);
    PHASE(ln_phase(q, q.in[12] + l * 1024, q.in[13] + l * 1024));
    grid_seam(grid);
    PHASE(phase_gemm_ff1(q));
    grid_seam(grid);
    PHASE(phase_gemm_res(q, 2));
    grid_seam(grid);
    PHASE(ln_phase(q, q.in[16] + l * 1024, q.in[17] + l * 1024));
    if (l + 1 < NL_) PHASE(convert_weights(q, l + 1));
    grid_seam(grid);
  }
}

extern "C" void kernel_launch(void* const* d_in, const int* in_sizes, int n_in, void* d_out, int out_size, void* d_ws,
                              size_t ws_size, hipStream_t stream) {
  static int grid_blocks = 0;
  if (grid_blocks == 0) {
    if (n_in != 18 || ws_size < WS_END) {
      fprintf(stderr, "kernel_launch: unexpected n_in %d or ws_size %zu (need %zu)\n", n_in, ws_size, (size_t)WS_END);
      grid_blocks = -1;
      return;
    }
    int dev = 0, cus = 0, per_cu = 0;
    hipGetDevice(&dev);
    hipDeviceGetAttribute(&cus, hipDeviceAttributeMultiprocessorCount, dev);
    if (hipFuncSetAttribute((const void*)mega, hipFuncAttributeMaxDynamicSharedMemorySize, LDS_BYTES) != hipSuccess)
      fprintf(stderr, "kernel_launch: hipFuncSetAttribute failed\n");
    if (hipOccupancyMaxActiveBlocksPerMultiprocessor(&per_cu, (const void*)mega, 512, LDS_BYTES) != hipSuccess || per_cu < 1)
      per_cu = 1;
    (void)hipGetLastError();
    grid_blocks = cus * per_cu;
  }
  if (grid_blocks < 0) return;
  Params p{};
  for (int i = 0; i < 18; ++i) p.in[i] = (const float*)d_in[i];
  p.out = (float*)d_out;
  p.ws = (unsigned char*)d_ws;
  void* args[] = {&p};
  hipError_t e = hipLaunchCooperativeKernel((const void*)mega, dim3(grid_blocks), dim3(512), args, LDS_BYTES, stream);
  if (e != hipSuccess) fprintf(stderr, "cooperative launch failed: %s (grid %d)\n", hipGetErrorString(e), grid_blocks);
}
```

```cpp
#include <hip/hip_runtime.h>
#include <hip/hip_cooperative_groups.h>
#include <cstdio>
#include <cmath>
namespace cg = cooperative_groups;

#define DEVI __device__ __forceinline__
typedef unsigned short u16;
using bf16x8 = __attribute__((ext_vector_type(8))) short;
using f32x4 = __attribute__((ext_vector_type(4))) float;
using f32x16 = __attribute__((ext_vector_type(16))) float;
typedef __bf16 bf2_t __attribute__((ext_vector_type(2)));
typedef float fl2_t __attribute__((ext_vector_type(2)));

constexpr int T_ = 32768, S_ = 16384, D_ = 1024, NL_ = 4, PW = 2560;
constexpr int C_CB = 0, C_CC = 256, C_CH = 512, C_DQ = 768, C_DK = 1152, C_DV = 1216, C_IQ = 1280, C_IK = 1536,
              C_IW = 1568, C_CQ = 1600, C_CK = 1984;
constexpr float ALPHA_ = 1.6817928305074290f;
constexpr float LOG2E_ = 1.4426950408889634f;
constexpr size_t MiB = 1u << 20;
constexpr size_t WS_CTL = 0, WS_X = 1 * MiB, WS_WT = WS_X + 64 * MiB, WS_MB = WS_WT + 32 * MiB, WS_KM = WS_MB + MiB,
                 WS_VTM = WS_KM + MiB, WS_ROPED = WS_VTM + MiB, WS_ROPEI = WS_ROPED + 2 * MiB, WS_Z = WS_ROPEI + MiB,
                 WS_VT = WS_Z + 160 * MiB, WS_Y = WS_Z + 192 * MiB, WS_Q = WS_Z, WS_P = WS_Z + 64 * MiB,
                 WS_O = WS_Z + 128 * MiB, WS_H = WS_Z, WS_END = WS_Z + 256 * MiB;
constexpr size_t WT_IN = 0, WT_OUT = 3072 * 1024, WT_MQ = WT_OUT + 1024 * 1024, WT_KV = WT_MQ + 1024 * 1024,
                 WT_MO = WT_KV + 2048 * 1024, WT_FF1 = WT_MO + 1024 * 1024, WT_FF2 = WT_FF1 + 4096 * 1024;
constexpr int LDS_BYTES = 147456;
constexpr int OFF_RB = 131072, OFF_CNT = OFF_RB + 4608, OFF_IW = OFF_CNT + 256, OFF_MISC = OFF_IW + 512,
              OFF_RED = OFF_MISC + 256;
constexpr int CAND_CAP = 768;
#ifndef PROBE_TK
#define PROBE_TK 1
#endif
#ifndef PROBE_AT
#define PROBE_AT 1
#endif
#ifndef PROBE_BD
#define PROBE_BD 1
#endif

struct Params {
  const float* in[18];
  float* out;
  unsigned char* ws;
};
__constant__ const float INV8_[8] = {1.0f, 0.19392274f, 0.03760603f, 0.0072926646f, 0.0014142136f, 0.0002742482f, 5.3182957e-05f, 1.0313385e-05f};
__constant__ const float INV4_[4] = {1.0f, 0.03760603f, 0.0014142136f, 5.3182957e-05f};

DEVI int opaque_v(int x) { asm volatile("" : "+v"(x)); return x; }
DEVI int opaque_s(int x) { asm volatile("" : "+s"(x)); return x; }
template <class Tp> DEVI Tp* opaque_p(Tp* x) { asm volatile("" : "+s"(x)); return x; }
#define TIDX opaque_v((int)threadIdx.x)
#define BIDX opaque_s((int)blockIdx.x)
DEVI unsigned pack2(float a, float b) {
  fl2_t x = {a, b};
  bf2_t y = __builtin_convertvector(x, bf2_t);
  return __builtin_bit_cast(unsigned, y);
}
DEVI u16 f2bf(float a) { return (u16)(pack2(a, 0.f) & 0xffffu); }
DEVI float bf2f(u16 h) { return __uint_as_float(((unsigned)h) << 16); }
DEVI float bflo(unsigned w) { return __uint_as_float(w << 16); }
DEVI float bfhi(unsigned w) { return __uint_as_float(w & 0xffff0000u); }
DEVI bf16x8 ld8(const u16* p) { return __builtin_bit_cast(bf16x8, *(const uint4*)p); }
DEVI bf16x8 mk8(unsigned a, unsigned b, unsigned c, unsigned d) {
  uint4 v = make_uint4(a, b, c, d);
  return __builtin_bit_cast(bf16x8, v);
}

#define LAS __attribute__((address_space(3)))
typedef unsigned u32x4 __attribute__((ext_vector_type(4)));
constexpr int BK = 64, HALF = 128, HTB = HALF * BK * 2;
DEVI int lds_byte(int r, int c) {
  const int st = (r >> 4) * 2 + (c >> 5), rr = r & 15, cc = c & 31, ob = rr * 64 + cc * 2;
  return st * 1024 + (ob ^ (((ob >> 9) & 1) << 5));
}
DEVI void stage_rc(int b, int& R, int& C) {
  const int st = b / 1024, sb = b % 1024, swz = sb ^ (((sb >> 9) & 1) << 5);
  R = (st >> 1) * 16 + swz / 64;
  C = (st & 1) * 32 + (swz % 64) / 2;
}
DEVI int perm32(int rho) {
  const int n = rho >> 4, i = rho & 15;
  return 8 * (i >> 2) + 4 * n + (i & 3);
}
DEVI void tile_coord(int v, int nM, int nN, int& pm, int& pn) {
  const int nwg = nM * nN;
  const int q = nwg / 8, r = nwg % 8, xcd = v % 8, off = v / 8;
  const int w = (xcd < r ? xcd * (q + 1) : r * (q + 1) + (xcd - r) * q) + off;
  const int nig = 8 * nN, gid = w / nig, fm = gid * 8, gsz = min(nM - fm, 8);
  pm = fm + ((w % nig) % gsz);
  pn = (w % nig) / gsz;
}
struct GUnit { const char* a; const char* b; int pm, pn; };
struct Sched {
  const char* A; const char* B;
  size_t aStepM, aStepN, bStepN, bStepB;
  int nM, nN, G, c;
  DEVI bool next(int i, GUnit& u) const {
    const int L = i * G + c;
    if (L >= nM * nN) return false;
    int pm, pn;
    tile_coord(L, nM, nN, pm, pn);
    u.pm = pm; u.pn = pn;
    u.a = A + (size_t)pm * aStepM + (size_t)pn * aStepN;
    u.b = B + (size_t)pn * bStepN + (size_t)(pm >> 6) * bStepB;
    return true;
  }
};

template <int ACT>
struct EpiStore16 {
  static constexpr bool PERM = true;
  u16* C; int ldc;
  DEVI void operator()(f32x4 (&acc)[2][2][4][2], const GUnit& u, int wr, int wc, int fr, int fq) const {
    const int row0 = u.pm * 256 + wr * 64 + fr, col0 = u.pn * 256 + wc * 32 + 8 * fq;
#pragma unroll
    for (int ai = 0; ai < 2; ++ai)
#pragma unroll
      for (int m = 0; m < 4; ++m) {
        u16* rowp = C + (size_t)(row0 + ai * HALF + m * 16) * ldc + col0;
#pragma unroll
        for (int bj = 0; bj < 2; ++bj) {
          f32x4 v0 = acc[ai][bj][m][0], v1 = acc[ai][bj][m][1];
          if (ACT == 1) {
#pragma unroll
            for (int j = 0; j < 4; ++j) {
              const float a = fmaxf(v0[j], 0.f), b = fmaxf(v1[j], 0.f);
              v0[j] = a * a;
              v1[j] = b * b;
            }
          }
          u32x4 w;
          w.x = pack2(v0[0], v0[1]); w.y = pack2(v0[2], v0[3]); w.z = pack2(v1[0], v1[1]); w.w = pack2(v1[2], v1[3]);
          *(u32x4*)(rowp + bj * HALF) = w;
        }
      }
  }
};
struct EpiProj {
  static constexpr bool PERM = true;
  u16* C; const float* ropeD; const float* ropeI;
  DEVI void operator()(f32x4 (&acc)[2][2][4][2], const GUnit& u, int wr, int wc, int fr, int fq) const {
    const int row0 = u.pm * 256 + wr * 64 + fr, col0 = u.pn * 256 + wc * 32 + 8 * fq;
#pragma unroll
    for (int ai = 0; ai < 2; ++ai)
#pragma unroll
      for (int m = 0; m < 4; ++m) {
        const int row = row0 + ai * HALF + m * 16;
        u16* rowp = C + (size_t)row * PW + col0;
#pragma unroll
        for (int bj = 0; bj < 2; ++bj) {
          f32x4 v0 = acc[ai][bj][m][0], v1 = acc[ai][bj][m][1];
          const int gg = u.pn * 256 + bj * HALF + wc * 32;
          if (gg >= C_DQ && gg < C_DV && (gg & 63) == 0) {
            const f32x4 c0 = *(const f32x4*)(ropeD + (size_t)row * 16), c1 = *(const f32x4*)(ropeD + (size_t)row * 16 + 4);
            const f32x4 s0 = *(const f32x4*)(ropeD + (size_t)row * 16 + 8), s1 = *(const f32x4*)(ropeD + (size_t)row * 16 + 12);
#pragma unroll
            for (int j = 0; j < 4; ++j) {
              const float p0 = __shfl_xor(v0[j], 16), p1 = __shfl_xor(v1[j], 16);
              const float a0 = (fq == 0) ? (v0[j] * c0[j] - p0 * s0[j]) : (v0[j] * c0[j] + p0 * s0[j]);
              const float a1 = (fq == 0) ? (v1[j] * c1[j] - p1 * s1[j]) : (v1[j] * c1[j] + p1 * s1[j]);
              v0[j] = (fq < 2) ? a0 : v0[j];
              v1[j] = (fq < 2) ? a1 : v1[j];
            }
          } else if (gg >= C_IQ && gg < C_IW) {
            const f32x4 cs = *(const f32x4*)(ropeI + (size_t)row * 8), sn = *(const f32x4*)(ropeI + (size_t)row * 8 + 4);
#pragma unroll
            for (int j = 0; j < 4; ++j) {
              const float x1 = v0[j], x2 = v1[j];
              v0[j] = (fq == 0) ? (x1 * cs[j] - x2 * sn[j]) : x1;
              v1[j] = (fq == 0) ? (x2 * cs[j] + x1 * sn[j]) : x2;
            }
          }
          u32x4 w;
          w.x = pack2(v0[0], v0[1]); w.y = pack2(v0[2], v0[3]); w.z = pack2(v1[0], v1[1]); w.w = pack2(v1[2], v1[3]);
          *(u32x4*)(rowp + bj * HALF) = w;
        }
      }
  }
};
struct EpiRes {
  static constexpr bool PERM = false;
  float* R;
  DEVI void operator()(f32x4 (&acc)[2][2][4][2], const GUnit& u, int wr, int wc, int fr, int fq) const {
    const int row0 = u.pm * 256 + wr * 64 + fr, col0 = u.pn * 256 + wc * 32 + 4 * fq;
#pragma unroll
    for (int ai = 0; ai < 2; ++ai)
#pragma unroll
      for (int m = 0; m < 4; ++m) {
        float* rowp = R + (size_t)(row0 + ai * HALF + m * 16) * 1024 + col0;
#pragma unroll
        for (int bj = 0; bj < 2; ++bj)
#pragma unroll
          for (int n = 0; n < 2; ++n) {
            f32x4* q = (f32x4*)(rowp + bj * HALF + n * 16);
            const f32x4 old = *q;
            *q = old * ALPHA_ + acc[ai][bj][m][n];
          }
      }
  }
};
struct EpiSoftmax {
  static constexpr bool PERM = true;
  u16* C;
  DEVI void operator()(f32x4 (&acc)[2][2][4][2], const GUnit& u, int wr, int wc, int fr, int fq) const {
    extern __shared__ __attribute__((aligned(16))) unsigned char smem[];
    float* red = (float*)(smem + OFF_RED);
    const float sc2 = 0.0625f * LOG2E_;
#pragma unroll
    for (int ai = 0; ai < 2; ++ai)
#pragma unroll
      for (int m = 0; m < 4; ++m) {
        float mx = -__builtin_inff();
#pragma unroll
        for (int bj = 0; bj < 2; ++bj)
#pragma unroll
          for (int n = 0; n < 2; ++n)
#pragma unroll
            for (int j = 0; j < 4; ++j) mx = fmaxf(mx, acc[ai][bj][m][n][j]);
        mx = fmaxf(mx, __shfl_xor(mx, 16));
        mx = fmaxf(mx, __shfl_xor(mx, 32));
        float sum = 0.f;
#pragma unroll
        for (int bj = 0; bj < 2; ++bj)
#pragma unroll
          for (int n = 0; n < 2; ++n)
#pragma unroll
            for (int j = 0; j < 4; ++j) sum += __builtin_amdgcn_exp2f((acc[ai][bj][m][n][j] - mx) * sc2);
        sum += __shfl_xor(sum, 16);
        sum += __shfl_xor(sum, 32);
        if (fq == 0) *(float2*)(red + ((ai * HALF + wr * 64 + m * 16 + fr) * 4 + wc) * 2) = make_float2(mx, sum);
        __builtin_amdgcn_sched_barrier(0);
      }
    __syncthreads();
    u16* cbase = C + (size_t)(u.pm * 256 + wr * 64 + fr) * 1024 + u.pn * 256 + wc * 32 + 8 * fq;
#pragma unroll
    for (int ai = 0; ai < 2; ++ai)
#pragma unroll
      for (int m = 0; m < 4; ++m) {
        const int rl = ai * HALF + wr * 64 + m * 16 + fr;
        const f32x4 ra = *(const f32x4*)(red + rl * 8), rb = *(const f32x4*)(red + rl * 8 + 4);
        const float mx = fmaxf(fmaxf(ra[0], ra[2]), fmaxf(rb[0], rb[2]));
        const float L = ra[1] * __builtin_amdgcn_exp2f((ra[0] - mx) * sc2) + ra[3] * __builtin_amdgcn_exp2f((ra[2] - mx) * sc2) +
                        rb[1] * __builtin_amdgcn_exp2f((rb[0] - mx) * sc2) + rb[3] * __builtin_amdgcn_exp2f((rb[2] - mx) * sc2);
        const float inv = 1.f / L;
        u16* rowp = cbase + (size_t)(ai * HALF + m * 16) * 1024;
#pragma unroll
        for (int bj = 0; bj < 2; ++bj) {
          f32x4 v0 = acc[ai][bj][m][0], v1 = acc[ai][bj][m][1];
#pragma unroll
          for (int j = 0; j < 4; ++j) {
            v0[j] = __builtin_amdgcn_exp2f((v0[j] - mx) * sc2) * inv;
            v1[j] = __builtin_amdgcn_exp2f((v1[j] - mx) * sc2) * inv;
          }
          u32x4 w;
          w.x = pack2(v0[0], v0[1]); w.y = pack2(v0[2], v0[3]); w.z = pack2(v1[0], v1[1]); w.w = pack2(v1[2], v1[3]);
          *(u32x4*)(rowp + bj * HALF) = w;
        }
        __builtin_amdgcn_sched_barrier(0);
      }
    __syncthreads();
  }
};

template <class Epi>
DEVI void gemm_phase(const int lda, const int ldb, const int K, const Sched& S, const Epi& E) {
  extern __shared__ __attribute__((aligned(16))) unsigned char smem[];
  LAS unsigned char* lds = (LAS unsigned char*)smem;
  const int tid = TIDX, wid = __builtin_amdgcn_readfirstlane(tid >> 6), lane = tid & 63, wr = wid >> 2, wc = wid & 3,
            fr = lane & 15, fq = lane >> 4;
  const int nt = opaque_s(K) / BK;
  unsigned voffA[2], voffB[2];
#pragma unroll
  for (int i = 0; i < 2; ++i) {
    int R, C;
    stage_rc(tid * 16 + i * 8192, R, C);
    const int Rb = Epi::PERM ? ((R & ~31) + perm32(R & 31)) : R;
    voffA[i] = (unsigned)(R * lda + C) * 2u;
    voffB[i] = (unsigned)(Rb * ldb + C) * 2u;
  }
  const size_t kstep = (size_t)(BK * 2);
  const size_t hstepA = (size_t)HALF * lda * 2, hstepB = (size_t)HALF * ldb * 2;
  const unsigned ldsw = (unsigned)wid * 1024u;
  const int aoff = lds_byte(wr * 64 + fr, fq * 8), boff = lds_byte(wc * 32 + fr, fq * 8);
#define PG8_SA(b, h) (((b) * 2 + (h)) * HTB)
#define PG8_SB(b, h) ((4 + (b) * 2 + (h)) * HTB)
#define PG8_STAGE(bufoff, gbase, voff)                                                                                \
  do {                                                                                                                \
    _Pragma("unroll") for (int _i = 0; _i < 2; ++_i) __builtin_amdgcn_global_load_lds(                                \
        (const unsigned*)((const char*)(gbase) + (voff)[_i]), (LAS unsigned*)(lds + (bufoff) + ldsw + _i * 8192), 16, 0, 0); \
  } while (0)
#define PG8_LDA(dst, b, h)                                                                                            \
  do {                                                                                                                \
    _Pragma("unroll") for (int m = 0; m < 4; ++m) _Pragma("unroll") for (int k = 0; k < 2; ++k) dst[m][k] =           \
        *(const LAS bf16x8*)(lds + PG8_SA(b, h) + aoff + m * 2048 + k * 1024);                                        \
  } while (0)
#define PG8_LDB(dst, b, h)                                                                                            \
  do {                                                                                                                \
    _Pragma("unroll") for (int n = 0; n < 2; ++n) _Pragma("unroll") for (int k = 0; k < 2; ++k) dst[n][k] =           \
        *(const LAS bf16x8*)(lds + PG8_SB(b, h) + boff + n * 2048 + k * 1024);                                        \
  } while (0)
#define PG8_MMA(ai, bj, At, Bt)                                                                                       \
  do {                                                                                                                \
    __builtin_amdgcn_s_setprio(1);                                                                                    \
    _Pragma("unroll") for (int m = 0; m < 4; ++m) _Pragma("unroll") for (int n = 0; n < 2; ++n)                       \
        _Pragma("unroll") for (int k = 0; k < 2; ++k) acc[ai][bj][m][n] =                                             \
            __builtin_amdgcn_mfma_f32_16x16x32_bf16(Bt[n][k], At[m][k], acc[ai][bj][m][n], 0, 0, 0);                  \
    __builtin_amdgcn_s_setprio(0);                                                                                    \
  } while (0)
#define PG8_WAIT_V(n) asm volatile("s_waitcnt vmcnt(" #n ")" ::: "memory")
#define PG8_WAIT_L(n) asm volatile("s_waitcnt lgkmcnt(" #n ")" ::: "memory")
#define PG8_BAR __builtin_amdgcn_s_barrier()
#define PG8_SCHED __builtin_amdgcn_sched_barrier(0)
  GUnit cur, nxt;
  int ui = 0;
  if (S.next(0, cur)) {
    f32x4 acc[2][2][4][2];
#pragma unroll
    for (int a = 0; a < 2; ++a)
#pragma unroll
      for (int b = 0; b < 2; ++b)
#pragma unroll
        for (int m = 0; m < 4; ++m)
#pragma unroll
          for (int n = 0; n < 2; ++n) acc[a][b][m][n] = (f32x4){0.f, 0.f, 0.f, 0.f};
    bf16x8 At[4][2], B0[2][2], B1[2][2];
    const char* cA = cur.a;
    const char* cB = cur.b;
    PG8_WAIT_V(0);
    PG8_STAGE(PG8_SB(0, 0), cB, voffB); PG8_STAGE(PG8_SA(0, 0), cA, voffA);
    PG8_STAGE(PG8_SB(0, 1), cB + hstepB, voffB); PG8_STAGE(PG8_SA(0, 1), cA + hstepA, voffA);
    if (wr == 1) PG8_BAR;
    PG8_WAIT_V(4); PG8_BAR;
    PG8_STAGE(PG8_SB(1, 0), cB + kstep, voffB); PG8_STAGE(PG8_SA(1, 0), cA + kstep, voffA);
    PG8_STAGE(PG8_SB(1, 1), cB + hstepB + kstep, voffB);
    PG8_WAIT_V(6); PG8_BAR;
    for (;;) {
      const bool has_next = S.next(ui + 1, nxt);
      const char* nA = has_next ? nxt.a : cA;
      const char* nB = has_next ? nxt.b : cB;
      for (int t = 0; t < nt; t += 2) {
        const bool last = (t == nt - 2);
        const char* a1 = cA + (size_t)(t + 1) * kstep;
        const char* a2 = last ? nA : cA + (size_t)(t + 2) * kstep;
        const char* b2 = last ? nB : cB + (size_t)(t + 2) * kstep;
        const char* a3 = a2 + kstep;
        const char* b3 = b2 + kstep;
        PG8_LDB(B0, 0, 0); PG8_SCHED; PG8_LDA(At, 0, 0); PG8_STAGE(PG8_SA(1, 1), a1 + hstepA, voffA);
        PG8_WAIT_L(8); PG8_BAR; PG8_WAIT_L(0); PG8_MMA(0, 0, At, B0); PG8_BAR; PG8_SCHED;
        PG8_LDB(B1, 0, 1); PG8_STAGE(PG8_SB(0, 0), b2, voffB);
        PG8_BAR; PG8_WAIT_L(0); PG8_MMA(0, 1, At, B1); PG8_BAR;
        PG8_LDA(At, 0, 1); PG8_STAGE(PG8_SA(0, 0), a2, voffA);
        PG8_BAR; PG8_WAIT_L(0); PG8_MMA(1, 0, At, B0); PG8_BAR; PG8_SCHED;
        PG8_STAGE(PG8_SB(0, 1), b2 + hstepB, voffB);
        PG8_WAIT_V(6); PG8_BAR; PG8_MMA(1, 1, At, B1); PG8_BAR;
        PG8_LDB(B0, 1, 0); PG8_SCHED; PG8_LDA(At, 1, 0); PG8_STAGE(PG8_SA(0, 1), a2 + hstepA, voffA);
        PG8_WAIT_L(8); PG8_BAR; PG8_WAIT_L(0); PG8_MMA(0, 0, At, B0); PG8_BAR; PG8_SCHED;
        PG8_LDB(B1, 1, 1); PG8_STAGE(PG8_SB(1, 0), b3, voffB);
        PG8_BAR; PG8_WAIT_L(0); PG8_MMA(0, 1, At, B1); PG8_BAR;
        PG8_LDA(At, 1, 1); PG8_STAGE(PG8_SA(1, 0), a3, voffA);
        PG8_BAR; PG8_WAIT_L(0); PG8_MMA(1, 0, At, B0); PG8_BAR; PG8_SCHED;
        PG8_STAGE(PG8_SB(1, 1), b3 + hstepB, voffB);
        PG8_WAIT_V(6); PG8_BAR; PG8_MMA(1, 1, At, B1); PG8_BAR;
      }
      E(acc, cur, wr, wc, fr, fq);
      if (!has_next) break;
#pragma unroll
      for (int a = 0; a < 2; ++a)
#pragma unroll
        for (int b = 0; b < 2; ++b)
#pragma unroll
          for (int m = 0; m < 4; ++m)
#pragma unroll
            for (int n = 0; n < 2; ++n) acc[a][b][m][n] = (f32x4){0.f, 0.f, 0.f, 0.f};
      cur = nxt; cA = nA; cB = nB; ++ui;
    }
    PG8_WAIT_V(0);
    if (wr == 0) PG8_BAR;
    PG8_BAR;
  }
  __syncthreads();
#undef PG8_SA
#undef PG8_SB
#undef PG8_STAGE
#undef PG8_LDA
#undef PG8_LDB
#undef PG8_MMA
}

DEVI void sincos_acc(float ang, float& c, float& s) {
  const double TWO_PI = 6.283185307179586476925286766559;
  double a = (double)ang;
  double k = rint(a * (1.0 / TWO_PI));
  double r = a - k * TWO_PI;
  double r2 = r * r;
  double sn = 0.0, cs = 0.0;
  double ts = r, tc = 1.0;
#pragma unroll
  for (int n = 0; n < 12; ++n) {
    sn += ts;
    cs += tc;
    ts *= -r2 / (double)((2 * n + 2) * (2 * n + 3));
    tc *= -r2 / (double)((2 * n + 1) * (2 * n + 2));
  }
  c = (float)cs;
  s = (float)sn;
}

DEVI void phase0(const Params& p) {
  const int tid0 = TIDX, bid0 = BIDX;
  const long gtid = (long)bid0 * 512 + tid0, gsz = (long)gridDim.x * 512;
  {
    const float4* x4 = (const float4*)p.in[0];
    float4* r4 = (float4*)p.out;
    uint2* X2 = (uint2*)(p.ws + WS_X);
    for (long i = gtid; i < (long)T_ * D_ / 4; i += gsz) {
      float4 v = x4[i];
      r4[i] = v;
      X2[i] = make_uint2(pack2(v.x, v.y), pack2(v.z, v.w));
    }
    const float4* m4 = (const float4*)p.in[1];
    uint2* M2 = (uint2*)(p.ws + WS_MB);
    for (long i = gtid; i < 512L * 1024 / 4; i += gsz) {
      float4 v = m4[i];
      M2[i] = make_uint2(pack2(v.x, v.y), pack2(v.z, v.w));
    }
  }
  {
    const int* pos = (const int*)p.in[2];
    float* rd = (float*)(p.ws + WS_ROPED);
    float* ri = (float*)(p.ws + WS_ROPEI);
    for (long i = gtid; i < (long)T_ * 12; i += gsz) {
      const int t = (int)(i / 12), f = (int)(i % 12);
      const float ps = (float)pos[t];
      float c, s;
      if (f < 8) {
        sincos_acc(ps * INV8_[f], c, s);
        rd[t * 16 + f] = c;
        rd[t * 16 + 8 + f] = s;
      } else {
        sincos_acc(ps * INV4_[f - 8], c, s);
        ri[t * 8 + (f - 8)] = c;
        ri[t * 8 + 4 + (f - 8)] = s;
      }
    }
  }
  if (bid0 == 0 && tid0 < 64) ((unsigned*)(p.ws + WS_CTL))[tid0] = 0u;
}

DEVI int map_in(int nd) {
  if (nd < 1576) return nd;
  if (nd < 1600) return -1;
  if (nd < 2368) return nd - 24;
  if (nd < 2560) return -1;
  if (nd < 2944) return nd - 216;
  return -1;
}

DEVI void convert_weights(const Params& p, int l) {
  extern __shared__ __attribute__((aligned(16))) unsigned char smem[];
  float* lt = (float*)smem;
  u16* WT = (u16*)(p.ws + WS_WT);
  const int t = TIDX;
  for (int tile = BIDX; tile < 4096; tile += gridDim.x) {
    const float* src;
    u16* dst;
    int K, Nsrc, mode = 0, tl;
    if (tile < 768) { src = p.in[3] + (size_t)l * 1024 * 2728; dst = WT + WT_IN; K = 1024; Nsrc = 2728; mode = 1; tl = tile; }
    else if (tile < 1024) { src = p.in[6] + (size_t)l * 1024 * 1024; dst = WT + WT_OUT; K = 1024; Nsrc = 1024; tl = tile - 768; }
    else if (tile < 1280) { src = p.in[9] + (size_t)l * 1024 * 1024; dst = WT + WT_MQ; K = 1024; Nsrc = 1024; tl = tile - 1024; }
    else if (tile < 1792) { src = p.in[10] + (size_t)l * 1024 * 2048; dst = WT + WT_KV; K = 1024; Nsrc = 2048; tl = tile - 1280; }
    else if (tile < 2048) { src = p.in[11] + (size_t)l * 1024 * 1024; dst = WT + WT_MO; K = 1024; Nsrc = 1024; tl = tile - 1792; }
    else if (tile < 3072) { src = p.in[14] + (size_t)l * 1024 * 4096; dst = WT + WT_FF1; K = 1024; Nsrc = 4096; tl = tile - 2048; }
    else { src = p.in[15] + (size_t)l * 4096 * 1024; dst = WT + WT_FF2; K = 4096; Nsrc = 1024; tl = tile - 3072; }
    const int nkt = K / 64;
    const int nt = tl / nkt, kt = tl % nkt;
    {
      const int n = t & 63, k0 = t >> 6;
      const int nd = nt * 64 + n;
      const int ns = mode ? map_in(nd) : nd;
#pragma unroll
      for (int i = 0; i < 8; ++i) {
        const int k = k0 + 8 * i;
        lt[k * 65 + n] = (ns >= 0) ? src[(size_t)(kt * 64 + k) * Nsrc + ns] : 0.f;
      }
    }
    __syncthreads();
    {
      const int n2 = t >> 3, ks = (t & 7) * 8;
      uint4 o;
      o.x = pack2(lt[(ks + 0) * 65 + n2], lt[(ks + 1) * 65 + n2]);
      o.y = pack2(lt[(ks + 2) * 65 + n2], lt[(ks + 3) * 65 + n2]);
      o.z = pack2(lt[(ks + 4) * 65 + n2], lt[(ks + 5) * 65 + n2]);
      o.w = pack2(lt[(ks + 6) * 65 + n2], lt[(ks + 7) * 65 + n2]);
      *(uint4*)(dst + (size_t)(nt * 64 + n2) * K + kt * 64 + ks) = o;
    }
    __syncthreads();
  }
}

DEVI float wave_sum(float v) {
  v += __shfl_xor(v, 32);
  v += __shfl_xor(v, 16);
  v += __shfl_xor(v, 8);
  v += __shfl_xor(v, 4);
  v += __shfl_xor(v, 2);
  v += __shfl_xor(v, 1);
  return v;
}
DEVI void ln_phase(const Params& p, const float* g, const float* b) {
  const int tidl = TIDX;
  const int wave = tidl >> 6, lane = tidl & 63;
  float* R = p.out;
  u16* X = (u16*)(p.ws + WS_X);
  float4 gg[4], bb[4];
#pragma unroll
  for (int i = 0; i < 4; ++i) {
    gg[i] = ((const float4*)g)[lane + 64 * i];
    bb[i] = ((const float4*)b)[lane + 64 * i];
  }
  for (int row = BIDX * 8 + wave; row < T_; row += gridDim.x * 8) {
    float4* rp = (float4*)(R + (size_t)row * 1024);
    float4 v[4];
#pragma unroll
    for (int i = 0; i < 4; ++i) v[i] = rp[lane + 64 * i];
    float s = 0.f;
#pragma unroll
    for (int i = 0; i < 4; ++i) s += v[i].x + v[i].y + v[i].z + v[i].w;
    const float mu = wave_sum(s) * (1.f / 1024.f);
    float q = 0.f;
#pragma unroll
    for (int i = 0; i < 4; ++i) {
      v[i].x -= mu; v[i].y -= mu; v[i].z -= mu; v[i].w -= mu;
      q += v[i].x * v[i].x + v[i].y * v[i].y + v[i].z * v[i].z + v[i].w * v[i].w;
    }
    const float rs = rsqrtf(wave_sum(q) * (1.f / 1024.f) + 1e-5f);
    uint2* xp = (uint2*)(X + (size_t)row * 1024);
#pragma unroll
    for (int i = 0; i < 4; ++i) {
      float4 o;
      o.x = v[i].x * rs * gg[i].x + bb[i].x;
      o.y = v[i].y * rs * gg[i].y + bb[i].y;
      o.z = v[i].z * rs * gg[i].z + bb[i].z;
      o.w = v[i].w * rs * gg[i].w + bb[i].w;
      rp[lane + 64 * i] = o;
      xp[lane + 64 * i] = make_uint2(pack2(o.x, o.y), pack2(o.z, o.w));
    }
  }
}

DEVI unsigned mono_key(float s) {
  unsigned u = __float_as_uint(s);
  return (u & 0x80000000u) ? ~u : (u | 0x80000000u);
}

DEVI void dsa_unit(const Params& p, const int u) {
  extern __shared__ __attribute__((aligned(16))) unsigned char smem[];
  const int tid = TIDX, lane = tid & 63, wave = tid >> 6;
  const int c = 255 - (u >> 3), b = (u >> 2) & 1, sub = u & 3;
  const int tok0 = b * S_ + c * 64 + sub * 16;
  const int N = (c + 1) * 64;
  const u16* proj = (const u16*)(p.ws + WS_Z);
  u16* Y = (u16*)(p.ws + WS_Y);
  float* cand_s = (float*)smem;
  u16* cand_i = (u16*)(smem + 49152);
  unsigned* h2 = (unsigned*)(smem + 73728);
  float* mem_s = (float*)(smem + 73728);
  unsigned* mem_i = (unsigned*)(smem + 73728 + 8192);
  unsigned* bm = (unsigned*)(smem + 90112);
  u16* sel = (u16*)(smem + 122880);
  int* candcnt = (int*)(smem + OFF_CNT);
  int* tbin = candcnt + 16;
  int* tb2a = candcnt + 32;
  int* base2 = candcnt + 48;
  int* mcnt = (int*)(smem + OFF_MISC);
  int* flag = mcnt + 16;
  float* iwl = (float*)(smem + OFF_IW);

  if (c < 4) {
    for (int i = tid; i < 16 * 256; i += 512) sel[i] = (u16)(i & 255);
    __syncthreads();
  } else {
   for (int rep_tk = 0; rep_tk < PROBE_TK; ++rep_tk) {
    if (tid < 128) iwl[tid] = bf2f(proj[(size_t)(tok0 + (tid >> 3)) * PW + C_IW + (tid & 7)]) * 0.17677669529663687f;
    __syncthreads();
    const int rho = lane & 31, hh = lane >> 5;
    bf16x8 af[4][2];
    float sg[4][16];
#pragma unroll
    for (int rt = 0; rt < 4; ++rt) {
      const int qi = 4 * rt + 2 * (rho >> 4) + ((rho >> 2) & 1);
      const int hd = (rho & 3) + 4 * ((rho >> 3) & 1);
      const float w = iwl[qi * 8 + hd];
#pragma unroll
      for (int s = 0; s < 2; ++s) {
        const uint4 raw = *(const uint4*)(proj + (size_t)(tok0 + qi) * PW + C_IQ + hd * 32 + 16 * s + 8 * hh);
        af[rt][s] = mk8(pack2(bflo(raw.x) * w, bfhi(raw.x) * w), pack2(bflo(raw.y) * w, bfhi(raw.y) * w),
                        pack2(bflo(raw.z) * w, bfhi(raw.z) * w), pack2(bflo(raw.w) * w, bfhi(raw.w) * w));
      }
#pragma unroll
      for (int i = 0; i < 16; ++i) {
        const float w2 = iwl[(4 * rt + 2 * (i >> 3) + hh) * 8 + (i & 7)];
        sg[rt][i] = (w2 > 0.f) ? 1.f : -1.f;
      }
    }
    bf16x8 al[2];
    {
      const int ii = (rho & 3) + 4 * (rho >> 3), gq = (rho >> 2) & 1;
      const int qi = 2 * (ii & 7) + gq, part = ii >> 3;
#pragma unroll
      for (int s = 0; s < 2; ++s) {
        float v[8];
#pragma unroll
        for (int j = 0; j < 8; ++j) v[j] = 0.f;
#pragma unroll
        for (int hd = 0; hd < 8; ++hd) {
          const float w = iwl[qi * 8 + hd];
          const uint4 raw = *(const uint4*)(proj + (size_t)(tok0 + qi) * PW + C_IQ + hd * 32 + 16 * s + 8 * hh);
          const unsigned r0 = pack2(bflo(raw.x) * w, bfhi(raw.x) * w), r1 = pack2(bflo(raw.y) * w, bfhi(raw.y) * w),
                         r2 = pack2(bflo(raw.z) * w, bfhi(raw.z) * w), r3 = pack2(bflo(raw.w) * w, bfhi(raw.w) * w);
          v[0] += bflo(r0); v[1] += bfhi(r0); v[2] += bflo(r1); v[3] += bfhi(r1);
          v[4] += bflo(r2); v[5] += bfhi(r2); v[6] += bflo(r3); v[7] += bfhi(r3);
        }
        unsigned hi[4];
#pragma unroll
        for (int j = 0; j < 4; ++j) hi[j] = pack2(v[2 * j], v[2 * j + 1]);
        if (part) {
#pragma unroll
          for (int j = 0; j < 4; ++j) hi[j] = pack2(v[2 * j] - bflo(hi[j]), v[2 * j + 1] - bfhi(hi[j]));
        }
        al[s] = mk8(hi[0], hi[1], hi[2], hi[3]);
      }
    }
    const int ntile = N >> 5;
    const u16* ikb = proj + (size_t)(b * S_ + (lane & 31)) * PW + C_IK + 8 * hh;
    for (int attempt = 0; attempt < 2; ++attempt) {
      const int ss = (attempt == 0 && N >= 4096) ? 8 : 1;
      const unsigned rank_t = (ss == 8) ? 48u : 256u;
      {
        uint4* h4 = (uint4*)smem;
        const uint4 z = make_uint4(0, 0, 0, 0);
        for (int i = tid; i < 131072 / 16; i += 512) h4[i] = z;
      }
      if (tid < 64) candcnt[tid] = 0;
      if (tid < 32) mcnt[tid] = 0;
      __syncthreads();
      float Lf[8];
#pragma unroll
      for (int i = 0; i < 8; ++i) Lf[i] = 0.f;
      for (int pass = 0; pass < 2; ++pass) {
        const int st = (pass == 0) ? ss : 1;
        if (pass == 1) {
#pragma unroll
          for (int i = 0; i < 8; ++i) {
            const unsigned k0 = ((unsigned)tbin[2 * i + hh]) << 20;
            Lf[i] = __uint_as_float((k0 & 0x80000000u) ? (k0 & 0x7fffffffu) : ~k0);
          }
        }
        int kt = wave * st;
        bf16x8 cb0 = {}, cb1 = {};
        if (kt < ntile) {
          cb0 = ld8(ikb + (size_t)kt * 32 * PW);
          cb1 = ld8(ikb + (size_t)kt * 32 * PW + 16);
        }
        for (; kt < ntile; kt += 8 * st) {
          bf16x8 nb0 = cb0, nb1 = cb1;
          if (kt + 8 * st < ntile) {
            nb0 = ld8(ikb + (size_t)(kt + 8 * st) * 32 * PW);
            nb1 = ld8(ikb + (size_t)(kt + 8 * st) * 32 * PW + 16);
          }
          const int key = kt * 32 + (lane & 31);
          f32x16 la = {};
          la = __builtin_amdgcn_mfma_f32_32x32x16_bf16(al[0], cb0, la, 0, 0, 0);
          la = __builtin_amdgcn_mfma_f32_32x32x16_bf16(al[1], cb1, la, 0, 0, 0);
#pragma unroll
          for (int rt = 0; rt < 4; ++rt) {
            f32x16 acc = {};
            acc = __builtin_amdgcn_mfma_f32_32x32x16_bf16(af[rt][0], cb0, acc, 0, 0, 0);
            acc = __builtin_amdgcn_mfma_f32_32x32x16_bf16(af[rt][1], cb1, acc, 0, 0, 0);
            float s0 = la[2 * rt] + la[2 * rt + 8], s1 = la[2 * rt + 1] + la[2 * rt + 9];
#pragma unroll
            for (int i = 0; i < 8; ++i) s0 = __builtin_fmaf(__builtin_fabsf(acc[i]), sg[rt][i], s0);
#pragma unroll
            for (int i = 8; i < 16; ++i) s1 = __builtin_fmaf(__builtin_fabsf(acc[i]), sg[rt][i], s1);
#pragma unroll
            for (int uu = 0; uu < 2; ++uu) {
              const float sc = uu ? s1 : s0;
              const int qi = 4 * rt + 2 * uu + hh;
              if (pass == 0) {
                const int bin = (int)(mono_key(sc) >> 20);
                atomicAdd((unsigned*)smem + qi * 2048 + (bin >> 1), 1u << ((bin & 1) * 16));
              } else if (sc >= Lf[rt * 2 + uu]) {
                const int pos = atomicAdd(&candcnt[qi], 1);
                if (pos < CAND_CAP) {
                  cand_s[qi * CAND_CAP + pos] = sc;
                  cand_i[qi * CAND_CAP + pos] = (u16)key;
                }
              }
            }
          }
          cb0 = nb0;
          cb1 = nb1;
        }
        __syncthreads();
        if (pass == 0) {
          const int qi = tid >> 5, seg = tid & 31;
          const unsigned* hq = (const unsigned*)smem + qi * 2048 + seg * 64;
          unsigned part = 0;
          for (int w = 0; w < 64; ++w) {
            const unsigned x = hq[(w + seg) & 63];
            part += (x & 0xffffu) + (x >> 16);
          }
          unsigned incl = part;
#pragma unroll
          for (int d = 1; d < 32; d <<= 1) {
            const unsigned o = __shfl_down(incl, d, 32);
            if (seg + d < 32) incl += o;
          }
          const unsigned above = incl - part;
          int mytb = -1;
          if (above < rank_t && incl >= rank_t) {
            unsigned cum = above;
            for (int w = 63; w >= 0; --w) {
              const unsigned x = hq[w];
              const unsigned chi = x >> 16, clo = x & 0xffffu;
              if (cum + chi >= rank_t) { mytb = seg * 128 + 2 * w + 1; break; }
              cum += chi;
              if (cum + clo >= rank_t) { mytb = seg * 128 + 2 * w; break; }
              cum += clo;
            }
          }
          __syncthreads();
          {
            uint4* bz = (uint4*)(smem + 73728);
            for (int i = tid; i < 3072; i += 512) bz[i] = make_uint4(0, 0, 0, 0);
          }
          if (mytb >= 0) tbin[qi] = mytb;
          __syncthreads();
        }
      }
      if (tid < 16) {
        const int cc = candcnt[tid];
        if (cc < 256 || cc > CAND_CAP) atomicOr((unsigned*)flag, 1u);
      }
      __syncthreads();
      const int bad = *(volatile int*)flag;
      __syncthreads();
      if (!bad) break;
    }
    {
      const int qi = tid >> 5, seg = tid & 31;
      const int C = min(candcnt[qi], CAND_CAP);
      unsigned prefix = 0u;
      unsigned kneed = 256u;
      const bool few = (C < 256);
#pragma unroll 1
      for (int d = 3; d >= 0; --d) {
        const int shift = 8 * d;
#pragma unroll
        for (int w = 0; w < 8; ++w) h2[qi * 256 + seg * 8 + w] = 0u;
        __syncthreads();
        for (int e = seg; e < C; e += 32) {
          const unsigned key = mono_key(cand_s[qi * CAND_CAP + e]);
          const bool match = (d == 3) || ((key >> (shift + 8)) == (prefix >> (shift + 8)));
          if (match) atomicAdd(&h2[qi * 256 + ((key >> shift) & 255u)], 1u);
        }
        __syncthreads();
        unsigned cnt8[8];
        unsigned part = 0;
#pragma unroll
        for (int w = 0; w < 8; ++w) {
          cnt8[w] = h2[qi * 256 + seg * 8 + w];
          part += cnt8[w];
        }
        unsigned incl = part;
#pragma unroll
        for (int dd = 1; dd < 32; dd <<= 1) {
          const unsigned o = __shfl_down(incl, dd, 32);
          if (seg + dd < 32) incl += o;
        }
        const unsigned above = incl - part;
        if (above < kneed && incl >= kneed) {
          unsigned cum = above;
          int t2 = -1;
#pragma unroll
          for (int w = 7; w >= 0; --w) {
            if (t2 < 0) {
              if (cum + cnt8[w] >= kneed) t2 = seg * 8 + w;
              else cum += cnt8[w];
            }
          }
          tb2a[qi] = t2;
          base2[qi] = (int)cum;
        }
        __syncthreads();
        if (!few) {
          prefix |= ((unsigned)tb2a[qi]) << shift;
          kneed -= (unsigned)base2[qi];
        }
      }
      for (int e = seg; e < C; e += 32) {
        const float s = cand_s[qi * CAND_CAP + e];
        const unsigned id = cand_i[qi * CAND_CAP + e];
        const unsigned key = mono_key(s);
        if (few || key > prefix) atomicOr(&bm[qi * 512 + (id >> 5)], 1u << (id & 31));
        else if (key == prefix) {
          const int pos = atomicAdd(&mcnt[qi], 1);
          if (pos < 128) { mem_s[qi * 128 + pos] = s; mem_i[qi * 128 + pos] = id; }
        }
      }
      __syncthreads();
      const int M = min(mcnt[qi], 128);
      const int need = (int)kneed;
      for (int e = seg; e < M; e += 32) {
        const unsigned id = mem_i[qi * 128 + e];
        int rank = 0;
        for (int f = 0; f < M; ++f) rank += (mem_i[qi * 128 + f] < id) ? 1 : 0;
        if (rank < need) atomicOr(&bm[qi * 512 + (id >> 5)], 1u << (id & 31));
      }
      __syncthreads();
      const unsigned* bq = bm + qi * 512 + seg * 16;
      int cnt = 0;
#pragma unroll
      for (int w = 0; w < 16; ++w) cnt += __popc(bq[w]);
      int inc2 = cnt;
#pragma unroll
      for (int d = 1; d < 32; d <<= 1) {
        const int o = __shfl_up(inc2, d, 32);
        if (seg >= d) inc2 += o;
      }
      int pos = inc2 - cnt;
      for (int w = 0; w < 16; ++w) {
        unsigned x = bq[w];
        while (x) {
          const int bit = __ffs(x) - 1;
          x &= x - 1;
          if (pos < 256) sel[qi * 256 + pos] = (u16)((seg * 16 + w) * 32 + bit);
          ++pos;
        }
      }
      if (seg == 31) {
        for (int q2 = pos; q2 < 256; ++q2) sel[qi * 256 + q2] = 0;
      }
    }
    __syncthreads();
   }
  }

  {
    const int n = (N < 256) ? N : 256;
    const int nt16 = n >> 4;
    const int hc = lane & 15, g4 = lane >> 4;
    u16* Vs = (u16*)(smem + wave * 9216);
    const float sc2 = 0.125f * LOG2E_;
    for (int e2 = 0; e2 < 2 * PROBE_AT; ++e2) {
      const int e = e2 & 1;
      const int qq = wave * 2 + e;
      const size_t tok = (size_t)tok0 + qq;
      bf16x8 qf[2];
#pragma unroll
      for (int s = 0; s < 2; ++s) {
        bf16x8 z = {};
        qf[s] = (hc < 6) ? ld8(proj + tok * PW + C_DQ + hc * 64 + 32 * s + 8 * g4) : z;
      }
      f32x4 st[16];
#pragma unroll
      for (int kt = 0; kt < 16; ++kt) {
        if (kt < nt16) {
          const int key = sel[qq * 256 + kt * 16 + hc] & 16383;
          const u16* kp = proj + (size_t)(b * S_ + key) * PW + C_DK + 8 * g4;
          const bf16x8 a0 = ld8(kp), a1 = ld8(kp + 32);
          f32x4 a = {};
          a = __builtin_amdgcn_mfma_f32_16x16x32_bf16(a0, qf[0], a, 0, 0, 0);
          a = __builtin_amdgcn_mfma_f32_16x16x32_bf16(a1, qf[1], a, 0, 0, 0);
          st[kt] = a;
        } else {
          const float ninf = -__builtin_inff();
          st[kt] = f32x4{ninf, ninf, ninf, ninf};
        }
      }
      float mx = -__builtin_inff();
#pragma unroll
      for (int kt = 0; kt < 16; ++kt)
#pragma unroll
        for (int i = 0; i < 4; ++i) mx = fmaxf(mx, st[kt][i]);
      mx = fmaxf(mx, __shfl_xor(mx, 16));
      mx = fmaxf(mx, __shfl_xor(mx, 32));
      float ls = 0.f;
#pragma unroll
      for (int kt = 0; kt < 16; ++kt)
#pragma unroll
        for (int i = 0; i < 4; ++i) {
          const float pv = __builtin_amdgcn_exp2f((st[kt][i] - mx) * sc2);
          st[kt][i] = pv;
          ls += pv;
        }
      ls += __shfl_xor(ls, 16);
      ls += __shfl_xor(ls, 32);
      f32x4 o[4] = {};
#pragma unroll
      for (int ch = 0; ch < 4; ++ch) {
        if (ch * 64 < n) {
#pragma unroll
          for (int it = 0; it < 8; ++it) {
            const int slot = ch * 64 + it * 8 + (lane >> 3);
            const int key = sel[qq * 256 + slot] & 16383;
            const uint4 v = *(const uint4*)(proj + (size_t)(b * S_ + key) * PW + C_DV + 8 * (lane & 7));
            *(uint4*)(Vs + (it * 8 + (lane >> 3)) * 72 + 8 * (lane & 7)) = v;
          }
          asm volatile("s_waitcnt lgkmcnt(0)" ::: "memory");
#pragma unroll
          for (int tt = 0; tt < 2; ++tt) {
            const int t2 = (ch * 2 + tt) * 2;
            const bf16x8 pb = mk8(pack2(st[t2][0], st[t2][1]), pack2(st[t2][2], st[t2][3]),
                                  pack2(st[t2 + 1][0], st[t2 + 1][1]), pack2(st[t2 + 1][2], st[t2 + 1][3]));
#pragma unroll
            for (int dt = 0; dt < 4; ++dt) {
              bf16x8 va;
#pragma unroll
              for (int j = 0; j < 8; ++j)
                va[j] = (short)Vs[(32 * tt + 16 * (j >> 2) + 4 * g4 + (j & 3)) * 72 + 16 * dt + hc];
              o[dt] = __builtin_amdgcn_mfma_f32_16x16x32_bf16(va, pb, o[dt], 0, 0, 0);
            }
          }
          asm volatile("s_waitcnt lgkmcnt(0)" ::: "memory");
        }
      }
      const float inv = 1.f / ls;
      if (hc < 6) {
#pragma unroll
        for (int dt = 0; dt < 4; ++dt) {
          uint2 w2 = make_uint2(pack2(o[dt][0] * inv, o[dt][1] * inv), pack2(o[dt][2] * inv, o[dt][3] * inv));
          *(uint2*)(Y + tok * 1024 + 256 + hc * 64 + 16 * dt + 4 * g4) = w2;
        }
      }
    }
  }
  __syncthreads();
}

DEVI void band_unit(const Params& p, const int U) {
  extern __shared__ __attribute__((aligned(16))) unsigned char smem[];
  const int tid = TIDX, lane = tid & 63, wave = tid >> 6;
  const int wu = U * 8 + wave;
  const int qh = wu & 1, h = (wu >> 1) % 6, bc = wu / 12, c = bc & 255, b = bc >> 8;
  const int r = lane & 31, g = lane >> 5;
  const u16* proj = (const u16*)(p.ws + WS_Z);
  const u16* Vt = (const u16*)(p.ws + WS_VT);
  u16* Y = (u16*)(p.ws + WS_Y);
  const float* rb = (const float*)(smem + OFF_RB) + h * 192;
  const size_t tokq = (size_t)b * S_ + c * 64 + qh * 32 + r;
  bf16x8 qf[4];
#pragma unroll
  for (int s = 0; s < 4; ++s) qf[s] = ld8(proj + tokq * PW + C_CQ + h * 64 + 16 * s + 8 * g);
  const int c0 = (c >= 8) ? (c - 8) : 0;
  const int kt0 = c0 * 2, kt1 = (c + 1) * 2;
  const int pr = (r & 16) | ((r & 4) << 1) | ((r & 8) >> 1) | (r & 3);
  const int qpos = c * 64 + qh * 32 + r;
  const float SC2 = 0.125f * LOG2E_;
  f32x16 o0 = {}, o1 = {};
  float m = -1e30f, ls = 0.f;
  for (int kt = kt0; kt < kt1; ++kt) {
    const u16* kp = proj + (size_t)(b * S_ + kt * 32 + pr) * PW + C_CK + h * 64 + 8 * g;
    const bf16x8 k0 = ld8(kp), k1 = ld8(kp + 16), k2 = ld8(kp + 32), k3 = ld8(kp + 48);
    const u16* vp = Vt + (size_t)(h * 64 + r) * T_ + (size_t)b * S_ + kt * 32 + 8 * g;
    const bf16x8 v00 = ld8(vp), v01 = ld8(vp + 16), v10 = ld8(vp + (size_t)32 * T_), v11 = ld8(vp + (size_t)32 * T_ + 16);
    f32x16 s = {};
    s = __builtin_amdgcn_mfma_f32_32x32x16_bf16(k0, qf[0], s, 0, 0, 0);
    s = __builtin_amdgcn_mfma_f32_32x32x16_bf16(k1, qf[1], s, 0, 0, 0);
    s = __builtin_amdgcn_mfma_f32_32x32x16_bf16(k2, qf[2], s, 0, 0, 0);
    s = __builtin_amdgcn_mfma_f32_32x32x16_bf16(k3, qf[3], s, 0, 0, 0);
    float tm = -1e30f;
    const int kb = kt * 32 + 8 * g;
#pragma unroll
    for (int i = 0; i < 16; ++i) {
      int rel = qpos - (kb + 16 * (i >> 3) + (i & 7));
      rel = min(max(rel, -63), 128) + 63;
      const float v = s[i] * SC2 + rb[rel];
      s[i] = v;
      tm = fmaxf(tm, v);
    }
    tm = fmaxf(tm, __shfl_xor(tm, 32));
    const float mn = fmaxf(m, tm);
    const float al = __builtin_amdgcn_exp2f(m - mn);
    m = mn;
    float psum = 0.f;
#pragma unroll
    for (int i = 0; i < 16; ++i) {
      const float pv = __builtin_amdgcn_exp2f(s[i] - mn);
      s[i] = pv;
      psum += pv;
    }
    ls = ls * al + psum;
#pragma unroll
    for (int i = 0; i < 16; ++i) {
      o0[i] *= al;
      o1[i] *= al;
    }
    const bf16x8 pb0 = mk8(pack2(s[0], s[1]), pack2(s[2], s[3]), pack2(s[4], s[5]), pack2(s[6], s[7]));
    const bf16x8 pb1 = mk8(pack2(s[8], s[9]), pack2(s[10], s[11]), pack2(s[12], s[13]), pack2(s[14], s[15]));
    o0 = __builtin_amdgcn_mfma_f32_32x32x16_bf16(v00, pb0, o0, 0, 0, 0);
    o0 = __builtin_amdgcn_mfma_f32_32x32x16_bf16(v01, pb1, o0, 0, 0, 0);
    o1 = __builtin_amdgcn_mfma_f32_32x32x16_bf16(v10, pb0, o1, 0, 0, 0);
    o1 = __builtin_amdgcn_mfma_f32_32x32x16_bf16(v11, pb1, o1, 0, 0, 0);
  }
  ls += __shfl_xor(ls, 32);
  const float inv = 1.f / ls;
  u16* yp = Y + tokq * 1024 + 640 + h * 64 + 4 * g;
#pragma unroll
  for (int i4 = 0; i4 < 4; ++i4) {
    *(uint2*)(yp + 8 * i4) = make_uint2(pack2(o0[4 * i4] * inv, o0[4 * i4 + 1] * inv), pack2(o0[4 * i4 + 2] * inv, o0[4 * i4 + 3] * inv));
    *(uint2*)(yp + 32 + 8 * i4) = make_uint2(pack2(o1[4 * i4] * inv, o1[4 * i4 + 1] * inv), pack2(o1[4 * i4 + 2] * inv, o1[4 * i4 + 3] * inv));
  }
}

DEVI void conv_unit(const Params& p, const int l, const int U) {
  const u16* proj = (const u16*)(p.ws + WS_Z);
  u16* Y = (u16*)(p.ws + WS_Y);
  const float* cw = p.in[4] + (size_t)l * 3 * 256;
#pragma unroll 1
  for (int it = 0; it < 8; ++it) {
    const int item = TIDX + 512 * it;
    const int tok = U * 128 + (item >> 5), cg8 = (item & 31) * 8;
    const int s = tok & (S_ - 1);
    const uint4 cb = *(const uint4*)(proj + (size_t)tok * PW + C_CB + cg8);
    float acc[8];
#pragma unroll
    for (int e = 0; e < 8; ++e) acc[e] = 0.f;
#pragma unroll
    for (int j = 0; j < 3; ++j) {
      const int dt = 2 - j;
      if (s - dt >= 0) {
        const uint4 cc = *(const uint4*)(proj + (size_t)(tok - dt) * PW + C_CC + cg8);
        const uint4 ch = *(const uint4*)(proj + (size_t)(tok - dt) * PW + C_CH + cg8);
        const float4 w0 = *(const float4*)(cw + j * 256 + cg8);
        const float4 w1 = *(const float4*)(cw + j * 256 + cg8 + 4);
        acc[0] += w0.x * bflo(cc.x) * bflo(ch.x);
        acc[1] += w0.y * bfhi(cc.x) * bfhi(ch.x);
        acc[2] += w0.z * bflo(cc.y) * bflo(ch.y);
        acc[3] += w0.w * bfhi(cc.y) * bfhi(ch.y);
        acc[4] += w1.x * bflo(cc.z) * bflo(ch.z);
        acc[5] += w1.y * bfhi(cc.z) * bfhi(ch.z);
        acc[6] += w1.z * bflo(cc.w) * bflo(ch.w);
        acc[7] += w1.w * bfhi(cc.w) * bfhi(ch.w);
      }
    }
    uint4 o;
    o.x = pack2(bflo(cb.x) * acc[0], bfhi(cb.x) * acc[1]);
    o.y = pack2(bflo(cb.y) * acc[2], bfhi(cb.y) * acc[3]);
    o.z = pack2(bflo(cb.z) * acc[4], bfhi(cb.z) * acc[5]);
    o.w = pack2(bflo(cb.w) * acc[6], bfhi(cb.w) * acc[7]);
    *(uint4*)(Y + (size_t)tok * 1024 + cg8) = o;
  }
}

DEVI void memkv_unit(const Params& p, const int u) {
  const u16* WT = (const u16*)(p.ws + WS_WT);
  const u16* Mb = (const u16*)(p.ws + WS_MB);
  Sched S{};
  S.nM = 1; S.nN = 1; S.G = 1; S.c = 0;
  if (u < 8) {
    const int pm = u >> 2, pn = u & 3;
    S.A = (const char*)(Mb + (size_t)pm * 256 * 1024);
    S.B = (const char*)(WT + WT_KV + (size_t)pn * 256 * 1024);
    EpiStore16<0> E{(u16*)(p.ws + WS_KM) + (size_t)pm * 256 * 1024 + pn * 256, 1024};
    gemm_phase(1024, 1024, 1024, S, E);
  } else {
    const int v = u - 8, pm = v >> 1, pn = v & 1;
    S.A = (const char*)(WT + WT_KV + (size_t)(1024 + pm * 256) * 1024);
    S.B = (const char*)(Mb + (size_t)pn * 256 * 1024);
    EpiStore16<0> E{(u16*)(p.ws + WS_VTM) + (size_t)pm * 256 * 512 + pn * 256, 512};
    gemm_phase(1024, 1024, 1024, S, E);
  }
}

constexpr int NU_KV = 16, NU_DSA = 2048, NU_BAND = 768, NU_CONV = 256;
DEVI void phase_mixer(const Params& p, const int l) {
  extern __shared__ __attribute__((aligned(16))) unsigned char smem[];
  const int tid = TIDX;
  float* rb = (float*)(smem + OFF_RB);
  for (int i = tid; i < 6 * 192; i += 512) rb[i] = p.in[5][(size_t)l * 6 * 192 + i] * LOG2E_;
  const int G = (int)gridDim.x, bid = BIDX;
  __syncthreads();
  if (bid >= G - NU_KV) memkv_unit(p, bid - (G - NU_KV));
  const int NU = NU_DSA + NU_BAND + NU_CONV;
  for (int rnd = 0;; ++rnd) {
    const int base = rnd * G;
    if (base >= NU) break;
    const int u = base + ((rnd & 1) ? (G - 1 - bid) : bid);
    if (u < NU) {
      if (u < NU_DSA) dsa_unit(p, u);
      else if (u < NU_DSA + NU_BAND) { for (int rb_ = 0; rb_ < PROBE_BD; ++rb_) band_unit(p, u - NU_DSA); }
      else conv_unit(p, l, u - NU_DSA - NU_BAND);
    }
    __syncthreads();
  }
}

DEVI Sched mk_sched(const void* A, const void* B, size_t aStepM, size_t bStepN, int nM, int nN) {
  Sched S{};
  S.A = (const char*)A; S.B = (const char*)B;
  S.aStepM = aStepM; S.aStepN = 0; S.bStepN = bStepN; S.bStepB = 0;
  S.nM = nM; S.nN = nN; S.G = (int)gridDim.x; S.c = BIDX;
  return S;
}
DEVI void phase_inproj(const Params& p) {
  const u16* X = (const u16*)(p.ws + WS_X);
  const u16* WT = (const u16*)(p.ws + WS_WT) + WT_IN;
  {
    const Sched S = mk_sched(X, WT, 256 * 1024 * 2, 256 * 1024 * 2, 128, 10);
    EpiProj E{(u16*)(p.ws + WS_Z), (const float*)(p.ws + WS_ROPED), (const float*)(p.ws + WS_ROPEI)};
    gemm_phase(1024, 1024, 1024, S, E);
  }
  {
    const Sched S = mk_sched(WT + (size_t)2560 * 1024, X, 256 * 1024 * 2, 256 * 1024 * 2, 2, 128);
    EpiStore16<0> E{(u16*)(p.ws + WS_VT), T_};
    gemm_phase(1024, 1024, 1024, S, E);
  }
}
DEVI void phase_gemm_res(const Params& p, const int which) {
  const u16* A = (const u16*)(p.ws + (which == 0 ? WS_Y : (which == 1 ? WS_O : WS_H)));
  const u16* W = (const u16*)(p.ws + WS_WT) + (which == 0 ? WT_OUT : (which == 1 ? WT_MO : WT_FF2));
  const int K = (which == 2) ? 4096 : 1024;
  const Sched S = mk_sched(A, W, (size_t)256 * K * 2, (size_t)256 * K * 2, 128, 4);
  EpiRes E{p.out};
  gemm_phase(K, K, K, S, E);
}
DEVI void phase_gemm_q(const Params& p) {
  const Sched S = mk_sched(p.ws + WS_X, (const u16*)(p.ws + WS_WT) + WT_MQ, 256 * 1024 * 2, 256 * 1024 * 2, 128, 4);
  EpiStore16<0> E{(u16*)(p.ws + WS_Q), 1024};
  gemm_phase(1024, 1024, 1024, S, E);
}
DEVI void phase_gemm_s(const Params& p) {
  Sched S = mk_sched(p.ws + WS_Q, p.ws + WS_KM, 256 * 1024 * 2, 256 * 2, 128, 4);
  S.aStepN = 256 * 2;
  S.bStepB = 256 * 1024 * 2;
  EpiSoftmax E{(u16*)(p.ws + WS_P)};
  gemm_phase(1024, 1024, 256, S, E);
}
DEVI void phase_gemm_pv(const Params& p) {
  Sched S = mk_sched(p.ws + WS_P, p.ws + WS_VTM, 256 * 1024 * 2, 256 * 512 * 2, 128, 4);
  S.aStepN = 256 * 2;
  S.bStepB = 256 * 2;
  EpiStore16<0> E{(u16*)(p.ws + WS_O), 1024};
  gemm_phase(1024, 512, 256, S, E);
}
DEVI void phase_gemm_ff1(const Params& p) {
  const Sched S = mk_sched(p.ws + WS_X, (const u16*)(p.ws + WS_WT) + WT_FF1, 256 * 1024 * 2, 256 * 1024 * 2, 128, 16);
  EpiStore16<1> E{(u16*)(p.ws + WS_H), 4096};
  gemm_phase(1024, 1024, 1024, S, E);
}

DEVI void grid_seam(cg::grid_group& grid) {
  asm volatile("s_waitcnt vmcnt(0) lgkmcnt(0)" ::: "memory");
  __builtin_amdgcn_fence(__ATOMIC_RELEASE, "agent");
  asm volatile("s_waitcnt vmcnt(0)" ::: "memory");
  grid.sync();
  __builtin_amdgcn_fence(__ATOMIC_ACQUIRE, "agent");
  asm volatile("s_waitcnt vmcnt(0)" ::: "memory");
}
#define PHASE(stmt)                  \
  do {                               \
    Params q = p;                    \
    const int _z = opaque_s(0);      \
    q.ws = p.ws + _z;                \
    q.out = p.out + _z;              \
    stmt;                            \
  } while (0)
__global__ void __launch_bounds__(512, 2) mega(Params p) {
  cg::grid_group grid = cg::this_grid();
  PHASE(phase0(q));
  PHASE(convert_weights(q, 0));
  grid_seam(grid);
#pragma unroll 1
  for (int l = 0; l < NL_; ++l) {
    PHASE(phase_inproj(q));
    grid_seam(grid);
    PHASE(phase_mixer(q, l));
    grid_seam(grid);
    PHASE(phase_gemm_res(q, 0));
    grid_seam(grid);
    PHASE(ln_phase(q, q.in[7] + l * 1024, q.in[8] + l * 1024));
    grid_seam(grid);
    PHASE(phase_gemm_q(q));
    grid_seam(grid);
    PHASE(phase_gemm_s(q));
    grid_seam(grid);
    PHASE(phase_gemm_pv(q));
    grid_seam(grid);
    PHASE(phase_gemm_res(q, 1));
    grid_seam(grid);
    PHASE(ln_phase(q, q.in[12] + l * 1024, q.in[13] + l * 1024));
    grid_seam(grid);
    PHASE(phase_gemm_ff1(q));
    grid_seam(grid);
    PHASE(phase_gemm_res(q, 2));
    grid_seam(grid);
    PHASE(ln_phase(q, q.in[16] + l * 1024, q.in[17] + l * 1024));
    if (l + 1 < NL_) PHASE(convert_weights(q, l + 1));
    grid_seam(grid);
  }
}

extern "C" void kernel_launch(void* const* d_in, const int* in_sizes, int n_in, void* d_out, int out_size, void* d_ws,
                              size_t ws_size, hipStream_t stream) {
  static int grid_blocks = 0;
  if (grid_blocks == 0) {
    if (n_in != 18 || ws_size < WS_END) {
      fprintf(stderr, "kernel_launch: unexpected n_in %d or ws_size %zu (need %zu)\n", n_in, ws_size, (size_t)WS_END);
      grid_blocks = -1;
      return;
    }
    int dev = 0, cus = 0, per_cu = 0;
    hipGetDevice(&dev);
    hipDeviceGetAttribute(&cus, hipDeviceAttributeMultiprocessorCount, dev);
    if (hipFuncSetAttribute((const void*)mega, hipFuncAttributeMaxDynamicSharedMemorySize, LDS_BYTES) != hipSuccess)
      fprintf(stderr, "kernel_launch: hipFuncSetAttribute failed\n");
    if (hipOccupancyMaxActiveBlocksPerMultiprocessor(&per_cu, (const void*)mega, 512, LDS_BYTES) != hipSuccess || per_cu < 1)
      per_cu = 1;
    (void)hipGetLastError();
    grid_blocks = cus * per_cu;
  }
  if (grid_blocks < 0) return;
  Params p{};
  for (int i = 0; i < 18; ++i) p.in[i] = (const float*)d_in[i];
  p.out = (float*)d_out;
  p.ws = (unsigned char*)d_ws;
  void* args[] = {&p};
  hipError_t e = hipLaunchCooperativeKernel((const void*)mega, dim3(grid_blocks), dim3(512), args, LDS_BYTES, stream);
  if (e != hipSuccess) fprintf(stderr, "cooperative launch failed: %s (grid %d)\n", hipGetErrorString(e), grid_blocks);
}
```

```cpp
#include <hip/hip_runtime.h>
#include <hip/hip_cooperative_groups.h>
#include <cstdio>
#include <cmath>
namespace cg = cooperative_groups;

#define DEVI __device__ __forceinline__
typedef unsigned short u16;
using bf16x8 = __attribute__((ext_vector_type(8))) short;
using f32x4 = __attribute__((ext_vector_type(4))) float;
using f32x16 = __attribute__((ext_vector_type(16))) float;
typedef __bf16 bf2_t __attribute__((ext_vector_type(2)));
typedef float fl2_t __attribute__((ext_vector_type(2)));

constexpr int T_ = 32768, S_ = 16384, D_ = 1024, NL_ = 4, PW = 2560;
constexpr int C_CB = 0, C_CC = 256, C_CH = 512, C_DQ = 768, C_DK = 1152, C_DV = 1216, C_IQ = 1280, C_IK = 1536,
              C_IW = 1568, C_CQ = 1600, C_CK = 1984;
constexpr float ALPHA_ = 1.6817928305074290f;
constexpr float LOG2E_ = 1.4426950408889634f;
constexpr size_t MiB = 1u << 20;
constexpr size_t WS_BAR = 4096;
constexpr size_t WS_CTL = 0, WS_X = 1 * MiB, WS_WT = WS_X + 64 * MiB, WS_MB = WS_WT + 32 * MiB, WS_KM = WS_MB + MiB,
                 WS_VTM = WS_KM + MiB, WS_ROPED = WS_VTM + MiB, WS_ROPEI = WS_ROPED + 2 * MiB, WS_Z = WS_ROPEI + MiB,
                 WS_VT = WS_Z + 160 * MiB, WS_Y = WS_Z + 192 * MiB, WS_Q = WS_Z, WS_P = WS_Z + 64 * MiB,
                 WS_O = WS_Z + 128 * MiB, WS_H = WS_Z, WS_END = WS_Z + 256 * MiB;
constexpr size_t WT_IN = 0, WT_OUT = 3072 * 1024, WT_MQ = WT_OUT + 1024 * 1024, WT_KV = WT_MQ + 1024 * 1024,
                 WT_MO = WT_KV + 2048 * 1024, WT_FF1 = WT_MO + 1024 * 1024, WT_FF2 = WT_FF1 + 4096 * 1024;
constexpr int LDS_BYTES = 147456;
constexpr int OFF_RB = 131072, OFF_CNT = OFF_RB + 4608, OFF_IW = OFF_CNT + 256, OFF_MISC = OFF_IW + 512,
              OFF_RED = OFF_MISC + 256, OFF_XB = OFF_RED + 8192;
constexpr int CAND_CAP = 768;
#ifndef PROBE_TK
#define PROBE_TK 1
#endif
#ifndef PROBE_AT
#define PROBE_AT 1
#endif
#ifndef PROBE_BD
#define PROBE_BD 1
#endif

struct Params {
  const float* in[18];
  float* out;
  unsigned char* ws;
};
__constant__ const float INV8_[8] = {1.0f, 0.19392274f, 0.03760603f, 0.0072926646f, 0.0014142136f, 0.0002742482f, 5.3182957e-05f, 1.0313385e-05f};
__constant__ const float INV4_[4] = {1.0f, 0.03760603f, 0.0014142136f, 5.3182957e-05f};

DEVI int opaque_v(int x) { asm volatile("" : "+v"(x)); return x; }
DEVI int opaque_s(int x) { asm volatile("" : "+s"(x)); return x; }
template <class Tp> DEVI Tp* opaque_p(Tp* x) { asm volatile("" : "+s"(x)); return x; }
#define TIDX opaque_v((int)threadIdx.x)
#define BIDX opaque_s((int)blockIdx.x)
DEVI unsigned pack2(float a, float b) {
  fl2_t x = {a, b};
  bf2_t y = __builtin_convertvector(x, bf2_t);
  return __builtin_bit_cast(unsigned, y);
}
DEVI u16 f2bf(float a) { return (u16)(pack2(a, 0.f) & 0xffffu); }
DEVI float bf2f(u16 h) { return __uint_as_float(((unsigned)h) << 16); }
DEVI float bflo(unsigned w) { return __uint_as_float(w << 16); }
DEVI float bfhi(unsigned w) { return __uint_as_float(w & 0xffff0000u); }
DEVI bf16x8 ld8(const u16* p) { return __builtin_bit_cast(bf16x8, *(const uint4*)p); }
DEVI bf16x8 mk8(unsigned a, unsigned b, unsigned c, unsigned d) {
  uint4 v = make_uint4(a, b, c, d);
  return __builtin_bit_cast(bf16x8, v);
}

#define LAS __attribute__((address_space(3)))
typedef unsigned u32x4 __attribute__((ext_vector_type(4)));
constexpr int BK = 64, HALF = 128, HTB = HALF * BK * 2;
DEVI int lds_byte(int r, int c) {
  const int st = (r >> 4) * 2 + (c >> 5), rr = r & 15, cc = c & 31, ob = rr * 64 + cc * 2;
  return st * 1024 + (ob ^ (((ob >> 9) & 1) << 5));
}
DEVI void stage_rc(int b, int& R, int& C) {
  const int st = b / 1024, sb = b % 1024, swz = sb ^ (((sb >> 9) & 1) << 5);
  R = (st >> 1) * 16 + swz / 64;
  C = (st & 1) * 32 + (swz % 64) / 2;
}
DEVI int perm32(int rho) {
  const int n = rho >> 4, i = rho & 15;
  return 8 * (i >> 2) + 4 * n + (i & 3);
}
DEVI void tile_coord(int v, int nM, int nN, int& pm, int& pn) {
  const int nwg = nM * nN;
  const int q = nwg / 8, r = nwg % 8, xcd = v % 8, off = v / 8;
  const int w = (xcd < r ? xcd * (q + 1) : r * (q + 1) + (xcd - r) * q) + off;
  const int nig = 8 * nN, gid = w / nig, fm = gid * 8, gsz = min(nM - fm, 8);
  pm = fm + ((w % nig) % gsz);
  pn = (w % nig) / gsz;
}
struct GUnit { const char* a; const char* b; int pm, pn; };
struct Sched {
  const char* A; const char* B;
  size_t aStepM, aStepN, bStepN, bStepB;
  int nM, nN, G, c;
  DEVI bool next(int i, GUnit& u) const {
    const int L = i * G + c;
    if (L >= nM * nN) return false;
    int pm, pn;
    tile_coord(L, nM, nN, pm, pn);
    u.pm = pm; u.pn = pn;
    u.a = A + (size_t)pm * aStepM + (size_t)pn * aStepN;
    u.b = B + (size_t)pn * bStepN + (size_t)(pm >> 6) * bStepB;
    return true;
  }
};

template <int ACT>
struct EpiStore16 {
  static constexpr bool PERM = true;
  u16* C; int ldc;
  DEVI void operator()(f32x4 (&acc)[2][2][4][2], const GUnit& u, int wr, int wc, int fr, int fq) const {
    const int row0 = u.pm * 256 + wr * 64 + fr, col0 = u.pn * 256 + wc * 32 + 8 * fq;
#pragma unroll
    for (int ai = 0; ai < 2; ++ai)
#pragma unroll
      for (int m = 0; m < 4; ++m) {
        u16* rowp = C + (size_t)(row0 + ai * HALF + m * 16) * ldc + col0;
#pragma unroll
        for (int bj = 0; bj < 2; ++bj) {
          f32x4 v0 = acc[ai][bj][m][0], v1 = acc[ai][bj][m][1];
          if (ACT == 1) {
#pragma unroll
            for (int j = 0; j < 4; ++j) {
              const float a = fmaxf(v0[j], 0.f), b = fmaxf(v1[j], 0.f);
              v0[j] = a * a;
              v1[j] = b * b;
            }
          }
          u32x4 w;
          w.x = pack2(v0[0], v0[1]); w.y = pack2(v0[2], v0[3]); w.z = pack2(v1[0], v1[1]); w.w = pack2(v1[2], v1[3]);
          *(u32x4*)(rowp + bj * HALF) = w;
        }
      }
  }
};
struct EpiProj {
  static constexpr bool PERM = true;
  u16* C; const float* ropeD; const float* ropeI;
  DEVI void operator()(f32x4 (&acc)[2][2][4][2], const GUnit& u, int wr, int wc, int fr, int fq) const {
    const int row0 = u.pm * 256 + wr * 64 + fr, col0 = u.pn * 256 + wc * 32 + 8 * fq;
#pragma unroll
    for (int ai = 0; ai < 2; ++ai)
#pragma unroll
      for (int m = 0; m < 4; ++m) {
        const int row = row0 + ai * HALF + m * 16;
        u16* rowp = C + (size_t)row * PW + col0;
#pragma unroll
        for (int bj = 0; bj < 2; ++bj) {
          f32x4 v0 = acc[ai][bj][m][0], v1 = acc[ai][bj][m][1];
          const int gg = u.pn * 256 + bj * HALF + wc * 32;
          if (gg >= C_DQ && gg < C_DV && (gg & 63) == 0) {
            const f32x4 c0 = *(const f32x4*)(ropeD + (size_t)row * 16), c1 = *(const f32x4*)(ropeD + (size_t)row * 16 + 4);
            const f32x4 s0 = *(const f32x4*)(ropeD + (size_t)row * 16 + 8), s1 = *(const f32x4*)(ropeD + (size_t)row * 16 + 12);
#pragma unroll
            for (int j = 0; j < 4; ++j) {
              const float p0 = __shfl_xor(v0[j], 16), p1 = __shfl_xor(v1[j], 16);
              const float a0 = (fq == 0) ? (v0[j] * c0[j] - p0 * s0[j]) : (v0[j] * c0[j] + p0 * s0[j]);
              const float a1 = (fq == 0) ? (v1[j] * c1[j] - p1 * s1[j]) : (v1[j] * c1[j] + p1 * s1[j]);
              v0[j] = (fq < 2) ? a0 : v0[j];
              v1[j] = (fq < 2) ? a1 : v1[j];
            }
          } else if (gg >= C_IQ && gg < C_IW) {
            const f32x4 cs = *(const f32x4*)(ropeI + (size_t)row * 8), sn = *(const f32x4*)(ropeI + (size_t)row * 8 + 4);
#pragma unroll
            for (int j = 0; j < 4; ++j) {
              const float x1 = v0[j], x2 = v1[j];
              v0[j] = (fq == 0) ? (x1 * cs[j] - x2 * sn[j]) : x1;
              v1[j] = (fq == 0) ? (x2 * cs[j] + x1 * sn[j]) : x2;
            }
          }
          u32x4 w;
          w.x = pack2(v0[0], v0[1]); w.y = pack2(v0[2], v0[3]); w.z = pack2(v1[0], v1[1]); w.w = pack2(v1[2], v1[3]);
          *(u32x4*)(rowp + bj * HALF) = w;
        }
      }
  }
};
struct EpiRes {
  static constexpr bool PERM = false;
  float* R;
  DEVI void operator()(f32x4 (&acc)[2][2][4][2], const GUnit& u, int wr, int wc, int fr, int fq) const {
    const int row0 = u.pm * 256 + wr * 64 + fr, col0 = u.pn * 256 + wc * 32 + 4 * fq;
#pragma unroll
    for (int ai = 0; ai < 2; ++ai)
#pragma unroll
      for (int m = 0; m < 4; ++m) {
        float* rowp = R + (size_t)(row0 + ai * HALF + m * 16) * 1024 + col0;
#pragma unroll
        for (int bj = 0; bj < 2; ++bj)
#pragma unroll
          for (int n = 0; n < 2; ++n) {
            f32x4* q = (f32x4*)(rowp + bj * HALF + n * 16);
            const f32x4 old = *q;
            *q = old * ALPHA_ + acc[ai][bj][m][n];
          }
      }
  }
};
struct EpiSoftmax {
  static constexpr bool PERM = true;
  u16* C;
  DEVI void operator()(f32x4 (&acc)[2][2][4][2], const GUnit& u, int wr, int wc, int fr, int fq) const {
    extern __shared__ __attribute__((aligned(16))) unsigned char smem[];
    float* red = (float*)(smem + OFF_RED);
    const float sc2 = 0.0625f * LOG2E_;
#pragma unroll
    for (int ai = 0; ai < 2; ++ai)
#pragma unroll
      for (int m = 0; m < 4; ++m) {
        float mx = -__builtin_inff();
#pragma unroll
        for (int bj = 0; bj < 2; ++bj)
#pragma unroll
          for (int n = 0; n < 2; ++n)
#pragma unroll
            for (int j = 0; j < 4; ++j) mx = fmaxf(mx, acc[ai][bj][m][n][j]);
        mx = fmaxf(mx, __shfl_xor(mx, 16));
        mx = fmaxf(mx, __shfl_xor(mx, 32));
        float sum = 0.f;
#pragma unroll
        for (int bj = 0; bj < 2; ++bj)
#pragma unroll
          for (int n = 0; n < 2; ++n)
#pragma unroll
            for (int j = 0; j < 4; ++j) sum += __builtin_amdgcn_exp2f((acc[ai][bj][m][n][j] - mx) * sc2);
        sum += __shfl_xor(sum, 16);
        sum += __shfl_xor(sum, 32);
        if (fq == 0) *(float2*)(red + ((ai * HALF + wr * 64 + m * 16 + fr) * 4 + wc) * 2) = make_float2(mx, sum);
        __builtin_amdgcn_sched_barrier(0);
      }
    __syncthreads();
    u16* cbase = C + (size_t)(u.pm * 256 + wr * 64 + fr) * 1024 + u.pn * 256 + wc * 32 + 8 * fq;
#pragma unroll
    for (int ai = 0; ai < 2; ++ai)
#pragma unroll
      for (int m = 0; m < 4; ++m) {
        const int rl = ai * HALF + wr * 64 + m * 16 + fr;
        const f32x4 ra = *(const f32x4*)(red + rl * 8), rb = *(const f32x4*)(red + rl * 8 + 4);
        const float mx = fmaxf(fmaxf(ra[0], ra[2]), fmaxf(rb[0], rb[2]));
        const float L = ra[1] * __builtin_amdgcn_exp2f((ra[0] - mx) * sc2) + ra[3] * __builtin_amdgcn_exp2f((ra[2] - mx) * sc2) +
                        rb[1] * __builtin_amdgcn_exp2f((rb[0] - mx) * sc2) + rb[3] * __builtin_amdgcn_exp2f((rb[2] - mx) * sc2);
        const float inv = 1.f / L;
        u16* rowp = cbase + (size_t)(ai * HALF + m * 16) * 1024;
#pragma unroll
        for (int bj = 0; bj < 2; ++bj) {
          f32x4 v0 = acc[ai][bj][m][0], v1 = acc[ai][bj][m][1];
#pragma unroll
          for (int j = 0; j < 4; ++j) {
            v0[j] = __builtin_amdgcn_exp2f((v0[j] - mx) * sc2) * inv;
            v1[j] = __builtin_amdgcn_exp2f((v1[j] - mx) * sc2) * inv;
          }
          u32x4 w;
          w.x = pack2(v0[0], v0[1]); w.y = pack2(v0[2], v0[3]); w.z = pack2(v1[0], v1[1]); w.w = pack2(v1[2], v1[3]);
          *(u32x4*)(rowp + bj * HALF) = w;
        }
        __builtin_amdgcn_sched_barrier(0);
      }
    __syncthreads();
  }
};

template <class Epi>
DEVI void gemm_phase(const int lda, const int ldb, const int K, const Sched& S, const Epi& E) {
  extern __shared__ __attribute__((aligned(16))) unsigned char smem[];
  LAS unsigned char* lds = (LAS unsigned char*)smem;
  const int tid = TIDX, wid = __builtin_amdgcn_readfirstlane(tid >> 6), lane = tid & 63, wr = wid >> 2, wc = wid & 3,
            fr = lane & 15, fq = lane >> 4;
  const int nt = opaque_s(K) / BK;
  unsigned voffA[2], voffB[2];
#pragma unroll
  for (int i = 0; i < 2; ++i) {
    int R, C;
    stage_rc(tid * 16 + i * 8192, R, C);
    const int Rb = Epi::PERM ? ((R & ~31) + perm32(R & 31)) : R;
    voffA[i] = (unsigned)(R * lda + C) * 2u;
    voffB[i] = (unsigned)(Rb * ldb + C) * 2u;
  }
  const size_t kstep = (size_t)(BK * 2);
  const size_t hstepA = (size_t)HALF * lda * 2, hstepB = (size_t)HALF * ldb * 2;
  const unsigned ldsw = (unsigned)wid * 1024u;
  const int aoff = lds_byte(wr * 64 + fr, fq * 8), boff = lds_byte(wc * 32 + fr, fq * 8);
#define PG8_SA(b, h) (((b) * 2 + (h)) * HTB)
#define PG8_SB(b, h) ((4 + (b) * 2 + (h)) * HTB)
#define PG8_STAGE(bufoff, gbase, voff)                                                                                \
  do {                                                                                                                \
    _Pragma("unroll") for (int _i = 0; _i < 2; ++_i) __builtin_amdgcn_global_load_lds(                                \
        (const unsigned*)((const char*)(gbase) + (voff)[_i]), (LAS unsigned*)(lds + (bufoff) + ldsw + _i * 8192), 16, 0, 0); \
  } while (0)
#define PG8_LDA(dst, b, h)                                                                                            \
  do {                                                                                                                \
    _Pragma("unroll") for (int m = 0; m < 4; ++m) _Pragma("unroll") for (int k = 0; k < 2; ++k) dst[m][k] =           \
        *(const LAS bf16x8*)(lds + PG8_SA(b, h) + aoff + m * 2048 + k * 1024);                                        \
  } while (0)
#define PG8_LDB(dst, b, h)                                                                                            \
  do {                                                                                                                \
    _Pragma("unroll") for (int n = 0; n < 2; ++n) _Pragma("unroll") for (int k = 0; k < 2; ++k) dst[n][k] =           \
        *(const LAS bf16x8*)(lds + PG8_SB(b, h) + boff + n * 2048 + k * 1024);                                        \
  } while (0)
#define PG8_MMA(ai, bj, At, Bt)                                                                                       \
  do {                                                                                                                \
    __builtin_amdgcn_s_setprio(1);                                                                                    \
    _Pragma("unroll") for (int m = 0; m < 4; ++m) _Pragma("unroll") for (int n = 0; n < 2; ++n)                       \
        _Pragma("unroll") for (int k = 0; k < 2; ++k) acc[ai][bj][m][n] =                                             \
            __builtin_amdgcn_mfma_f32_16x16x32_bf16(Bt[n][k], At[m][k], acc[ai][bj][m][n], 0, 0, 0);                  \
    __builtin_amdgcn_s_setprio(0);                                                                                    \
  } while (0)
#define PG8_WAIT_V(n) asm volatile("s_waitcnt vmcnt(" #n ")" ::: "memory")
#define PG8_WAIT_L(n) asm volatile("s_waitcnt lgkmcnt(" #n ")" ::: "memory")
#define PG8_BAR __builtin_amdgcn_s_barrier()
#define PG8_SCHED __builtin_amdgcn_sched_barrier(0)
  GUnit cur, nxt;
  int ui = 0;
  if (S.next(0, cur)) {
    f32x4 acc[2][2][4][2];
#pragma unroll
    for (int a = 0; a < 2; ++a)
#pragma unroll
      for (int b = 0; b < 2; ++b)
#pragma unroll
        for (int m = 0; m < 4; ++m)
#pragma unroll
          for (int n = 0; n < 2; ++n) acc[a][b][m][n] = (f32x4){0.f, 0.f, 0.f, 0.f};
    bf16x8 At[4][2], B0[2][2], B1[2][2];
    const char* cA = cur.a;
    const char* cB = cur.b;
    PG8_WAIT_V(0);
    PG8_STAGE(PG8_SB(0, 0), cB, voffB); PG8_STAGE(PG8_SA(0, 0), cA, voffA);
    PG8_STAGE(PG8_SB(0, 1), cB + hstepB, voffB); PG8_STAGE(PG8_SA(0, 1), cA + hstepA, voffA);
    if (wr == 1) PG8_BAR;
    PG8_WAIT_V(4); PG8_BAR;
    PG8_STAGE(PG8_SB(1, 0), cB + kstep, voffB); PG8_STAGE(PG8_SA(1, 0), cA + kstep, voffA);
    PG8_STAGE(PG8_SB(1, 1), cB + hstepB + kstep, voffB);
    PG8_WAIT_V(6); PG8_BAR;
    for (;;) {
      const bool has_next = S.next(ui + 1, nxt);
      const char* nA = has_next ? nxt.a : cA;
      const char* nB = has_next ? nxt.b : cB;
      for (int t = 0; t < nt; t += 2) {
        const bool last = (t == nt - 2);
        const char* a1 = cA + (size_t)(t + 1) * kstep;
        const char* a2 = last ? nA : cA + (size_t)(t + 2) * kstep;
        const char* b2 = last ? nB : cB + (size_t)(t + 2) * kstep;
        const char* a3 = a2 + kstep;
        const char* b3 = b2 + kstep;
        PG8_LDB(B0, 0, 0); PG8_SCHED; PG8_LDA(At, 0, 0); PG8_STAGE(PG8_SA(1, 1), a1 + hstepA, voffA);
        PG8_WAIT_L(8); PG8_BAR; PG8_WAIT_L(0); PG8_MMA(0, 0, At, B0); PG8_BAR; PG8_SCHED;
        PG8_LDB(B1, 0, 1); PG8_STAGE(PG8_SB(0, 0), b2, voffB);
        PG8_BAR; PG8_WAIT_L(0); PG8_MMA(0, 1, At, B1); PG8_BAR;
        PG8_LDA(At, 0, 1); PG8_STAGE(PG8_SA(0, 0), a2, voffA);
        PG8_BAR; PG8_WAIT_L(0); PG8_MMA(1, 0, At, B0); PG8_BAR; PG8_SCHED;
        PG8_STAGE(PG8_SB(0, 1), b2 + hstepB, voffB);
        PG8_WAIT_V(6); PG8_BAR; PG8_MMA(1, 1, At, B1); PG8_BAR;
        PG8_LDB(B0, 1, 0); PG8_SCHED; PG8_LDA(At, 1, 0); PG8_STAGE(PG8_SA(0, 1), a2 + hstepA, voffA);
        PG8_WAIT_L(8); PG8_BAR; PG8_WAIT_L(0); PG8_MMA(0, 0, At, B0); PG8_BAR; PG8_SCHED;
        PG8_LDB(B1, 1, 1); PG8_STAGE(PG8_SB(1, 0), b3, voffB);
        PG8_BAR; PG8_WAIT_L(0); PG8_MMA(0, 1, At, B1); PG8_BAR;
        PG8_LDA(At, 1, 1); PG8_STAGE(PG8_SA(1, 0), a3, voffA);
        PG8_BAR; PG8_WAIT_L(0); PG8_MMA(1, 0, At, B0); PG8_BAR; PG8_SCHED;
        PG8_STAGE(PG8_SB(1, 1), b3 + hstepB, voffB);
        PG8_WAIT_V(6); PG8_BAR; PG8_MMA(1, 1, At, B1); PG8_BAR;
      }
      E(acc, cur, wr, wc, fr, fq);
      if (!has_next) break;
#pragma unroll
      for (int a = 0; a < 2; ++a)
#pragma unroll
        for (int b = 0; b < 2; ++b)
#pragma unroll
          for (int m = 0; m < 4; ++m)
#pragma unroll
            for (int n = 0; n < 2; ++n) acc[a][b][m][n] = (f32x4){0.f, 0.f, 0.f, 0.f};
      cur = nxt; cA = nA; cB = nB; ++ui;
    }
    PG8_WAIT_V(0);
    if (wr == 0) PG8_BAR;
    PG8_BAR;
  }
  __syncthreads();
#undef PG8_SA
#undef PG8_SB
#undef PG8_STAGE
#undef PG8_LDA
#undef PG8_LDB
#undef PG8_MMA
}

DEVI void sincos_acc(float ang, float& c, float& s) {
  const double TWO_PI = 6.283185307179586476925286766559;
  double a = (double)ang;
  double k = rint(a * (1.0 / TWO_PI));
  double r = a - k * TWO_PI;
  double r2 = r * r;
  double sn = 0.0, cs = 0.0;
  double ts = r, tc = 1.0;
#pragma unroll
  for (int n = 0; n < 12; ++n) {
    sn += ts;
    cs += tc;
    ts *= -r2 / (double)((2 * n + 2) * (2 * n + 3));
    tc *= -r2 / (double)((2 * n + 1) * (2 * n + 2));
  }
  c = (float)cs;
  s = (float)sn;
}

DEVI void phase0(const Params& p) {
  const int tid0 = TIDX, bid0 = BIDX;
  const long gtid = (long)bid0 * 512 + tid0, gsz = (long)gridDim.x * 512;
  {
    const float4* x4 = (const float4*)p.in[0];
    float4* r4 = (float4*)p.out;
    uint2* X2 = (uint2*)(p.ws + WS_X);
    for (long i = gtid; i < (long)T_ * D_ / 4; i += gsz) {
      float4 v = x4[i];
      r4[i] = v;
      X2[i] = make_uint2(pack2(v.x, v.y), pack2(v.z, v.w));
    }
    const float4* m4 = (const float4*)p.in[1];
    uint2* M2 = (uint2*)(p.ws + WS_MB);
    for (long i = gtid; i < 512L * 1024 / 4; i += gsz) {
      float4 v = m4[i];
      M2[i] = make_uint2(pack2(v.x, v.y), pack2(v.z, v.w));
    }
  }
  {
    const int* pos = (const int*)p.in[2];
    float* rd = (float*)(p.ws + WS_ROPED);
    float* ri = (float*)(p.ws + WS_ROPEI);
    for (long i = gtid; i < (long)T_ * 12; i += gsz) {
      const int t = (int)(i / 12), f = (int)(i % 12);
      const float ps = (float)pos[t];
      float c, s;
      if (f < 8) {
        sincos_acc(ps * INV8_[f], c, s);
        rd[t * 16 + f] = c;
        rd[t * 16 + 8 + f] = s;
      } else {
        sincos_acc(ps * INV4_[f - 8], c, s);
        ri[t * 8 + (f - 8)] = c;
        ri[t * 8 + 4 + (f - 8)] = s;
      }
    }
  }
  if (bid0 == 0 && tid0 < 64) ((unsigned*)(p.ws + WS_CTL))[tid0] = 0u;
}

DEVI int map_in(int nd) {
  if (nd < 1576) return nd;
  if (nd < 1600) return -1;
  if (nd < 2368) return nd - 24;
  if (nd < 2560) return -1;
  if (nd < 2944) return nd - 216;
  return -1;
}

DEVI void convert_weights(const Params& p, int l) {
  extern __shared__ __attribute__((aligned(16))) unsigned char smem[];
  float* lt = (float*)smem;
  u16* WT = (u16*)(p.ws + WS_WT);
  const int t = TIDX;
  for (int tile = BIDX; tile < 4096; tile += gridDim.x) {
    const float* src;
    u16* dst;
    int K, Nsrc, mode = 0, tl;
    if (tile < 768) { src = p.in[3] + (size_t)l * 1024 * 2728; dst = WT + WT_IN; K = 1024; Nsrc = 2728; mode = 1; tl = tile; }
    else if (tile < 1024) { src = p.in[6] + (size_t)l * 1024 * 1024; dst = WT + WT_OUT; K = 1024; Nsrc = 1024; tl = tile - 768; }
    else if (tile < 1280) { src = p.in[9] + (size_t)l * 1024 * 1024; dst = WT + WT_MQ; K = 1024; Nsrc = 1024; tl = tile - 1024; }
    else if (tile < 1792) { src = p.in[10] + (size_t)l * 1024 * 2048; dst = WT + WT_KV; K = 1024; Nsrc = 2048; tl = tile - 1280; }
    else if (tile < 2048) { src = p.in[11] + (size_t)l * 1024 * 1024; dst = WT + WT_MO; K = 1024; Nsrc = 1024; tl = tile - 1792; }
    else if (tile < 3072) { src = p.in[14] + (size_t)l * 1024 * 4096; dst = WT + WT_FF1; K = 1024; Nsrc = 4096; tl = tile - 2048; }
    else { src = p.in[15] + (size_t)l * 4096 * 1024; dst = WT + WT_FF2; K = 4096; Nsrc = 1024; tl = tile - 3072; }
    const int nkt = K / 64;
    const int nt = tl / nkt, kt = tl % nkt;
    {
      const int n = t & 63, k0 = t >> 6;
      const int nd = nt * 64 + n;
      const int ns = mode ? map_in(nd) : nd;
#pragma unroll
      for (int i = 0; i < 8; ++i) {
        const int k = k0 + 8 * i;
        lt[k * 65 + n] = (ns >= 0) ? src[(size_t)(kt * 64 + k) * Nsrc + ns] : 0.f;
      }
    }
    __syncthreads();
    {
      const int n2 = t >> 3, ks = (t & 7) * 8;
      uint4 o;
      o.x = pack2(lt[(ks + 0) * 65 + n2], lt[(ks + 1) * 65 + n2]);
      o.y = pack2(lt[(ks + 2) * 65 + n2], lt[(ks + 3) * 65 + n2]);
      o.z = pack2(lt[(ks + 4) * 65 + n2], lt[(ks + 5) * 65 + n2]);
      o.w = pack2(lt[(ks + 6) * 65 + n2], lt[(ks + 7) * 65 + n2]);
      *(uint4*)(dst + (size_t)(nt * 64 + n2) * K + kt * 64 + ks) = o;
    }
    __syncthreads();
  }
}

DEVI float wave_sum(float v) {
  v += __shfl_xor(v, 32);
  v += __shfl_xor(v, 16);
  v += __shfl_xor(v, 8);
  v += __shfl_xor(v, 4);
  v += __shfl_xor(v, 2);
  v += __shfl_xor(v, 1);
  return v;
}
DEVI void ln_phase(const Params& p, const float* g, const float* b) {
  const int tidl = TIDX;
  const int wave = tidl >> 6, lane = tidl & 63;
  float* R = p.out;
  u16* X = (u16*)(p.ws + WS_X);
  float4 gg[4], bb[4];
#pragma unroll
  for (int i = 0; i < 4; ++i) {
    gg[i] = ((const float4*)g)[lane + 64 * i];
    bb[i] = ((const float4*)b)[lane + 64 * i];
  }
  for (int row = BIDX * 8 + wave; row < T_; row += gridDim.x * 8) {
    float4* rp = (float4*)(R + (size_t)row * 1024);
    float4 v[4];
#pragma unroll
    for (int i = 0; i < 4; ++i) v[i] = rp[lane + 64 * i];
    float s = 0.f;
#pragma unroll
    for (int i = 0; i < 4; ++i) s += v[i].x + v[i].y + v[i].z + v[i].w;
    const float mu = wave_sum(s) * (1.f / 1024.f);
    float q = 0.f;
#pragma unroll
    for (int i = 0; i < 4; ++i) {
      v[i].x -= mu; v[i].y -= mu; v[i].z -= mu; v[i].w -= mu;
      q += v[i].x * v[i].x + v[i].y * v[i].y + v[i].z * v[i].z + v[i].w * v[i].w;
    }
    const float rs = rsqrtf(wave_sum(q) * (1.f / 1024.f) + 1e-5f);
    uint2* xp = (uint2*)(X + (size_t)row * 1024);
#pragma unroll
    for (int i = 0; i < 4; ++i) {
      float4 o;
      o.x = v[i].x * rs * gg[i].x + bb[i].x;
      o.y = v[i].y * rs * gg[i].y + bb[i].y;
      o.z = v[i].z * rs * gg[i].z + bb[i].z;
      o.w = v[i].w * rs * gg[i].w + bb[i].w;
      rp[lane + 64 * i] = o;
      xp[lane + 64 * i] = make_uint2(pack2(o.x, o.y), pack2(o.z, o.w));
    }
  }
}

DEVI unsigned mono_key(float s) {
  unsigned u = __float_as_uint(s);
  return (u & 0x80000000u) ? ~u : (u | 0x80000000u);
}

DEVI void dsa_unit(const Params& p, const int u) {
  extern __shared__ __attribute__((aligned(16))) unsigned char smem[];
  const int tid = TIDX, lane = tid & 63, wave = tid >> 6;
  const int c = 255 - (u >> 3), b = (u >> 2) & 1, sub = u & 3;
  const int tok0 = b * S_ + c * 64 + sub * 16;
  const int N = (c + 1) * 64;
  const u16* proj = (const u16*)(p.ws + WS_Z);
  u16* Y = (u16*)(p.ws + WS_Y);
  float* cand_s = (float*)smem;
  u16* cand_i = (u16*)(smem + 49152);
  unsigned* h2 = (unsigned*)(smem + 73728);
  float* mem_s = (float*)(smem + 73728);
  unsigned* mem_i = (unsigned*)(smem + 73728 + 8192);
  unsigned* bm = (unsigned*)(smem + 90112);
  u16* sel = (u16*)(smem + 122880);
  int* candcnt = (int*)(smem + OFF_CNT);
  int* tbin = candcnt + 16;
  int* tb2a = candcnt + 32;
  int* base2 = candcnt + 48;
  int* mcnt = (int*)(smem + OFF_MISC);
  int* flag = mcnt + 16;
  float* iwl = (float*)(smem + OFF_IW);

  if (c < 4) {
    for (int i = tid; i < 16 * 256; i += 512) sel[i] = (u16)(i & 255);
    __syncthreads();
  } else {
   for (int rep_tk = 0; rep_tk < PROBE_TK; ++rep_tk) {
    if (tid < 128) iwl[tid] = bf2f(proj[(size_t)(tok0 + (tid >> 3)) * PW + C_IW + (tid & 7)]) * 0.17677669529663687f;
    __syncthreads();
    const int rho = lane & 31, hh = lane >> 5;
    bf16x8 af[4][2];
    float sg[4][16];
#pragma unroll
    for (int rt = 0; rt < 4; ++rt) {
      const int qi = 4 * rt + 2 * (rho >> 4) + ((rho >> 2) & 1);
      const int hd = (rho & 3) + 4 * ((rho >> 3) & 1);
      const float w = iwl[qi * 8 + hd];
#pragma unroll
      for (int s = 0; s < 2; ++s) {
        const uint4 raw = *(const uint4*)(proj + (size_t)(tok0 + qi) * PW + C_IQ + hd * 32 + 16 * s + 8 * hh);
        af[rt][s] = mk8(pack2(bflo(raw.x) * w, bfhi(raw.x) * w), pack2(bflo(raw.y) * w, bfhi(raw.y) * w),
                        pack2(bflo(raw.z) * w, bfhi(raw.z) * w), pack2(bflo(raw.w) * w, bfhi(raw.w) * w));
      }
#pragma unroll
      for (int i = 0; i < 16; ++i) {
        const float w2 = iwl[(4 * rt + 2 * (i >> 3) + hh) * 8 + (i & 7)];
        sg[rt][i] = (w2 > 0.f) ? 1.f : -1.f;
      }
    }
    bf16x8 al[2];
    {
      const int ii = (rho & 3) + 4 * (rho >> 3), gq = (rho >> 2) & 1;
      const int qi = 2 * (ii & 7) + gq, part = ii >> 3;
#pragma unroll
      for (int s = 0; s < 2; ++s) {
        float v[8];
#pragma unroll
        for (int j = 0; j < 8; ++j) v[j] = 0.f;
#pragma unroll
        for (int hd = 0; hd < 8; ++hd) {
          const float w = iwl[qi * 8 + hd];
          const uint4 raw = *(const uint4*)(proj + (size_t)(tok0 + qi) * PW + C_IQ + hd * 32 + 16 * s + 8 * hh);
          const unsigned r0 = pack2(bflo(raw.x) * w, bfhi(raw.x) * w), r1 = pack2(bflo(raw.y) * w, bfhi(raw.y) * w),
                         r2 = pack2(bflo(raw.z) * w, bfhi(raw.z) * w), r3 = pack2(bflo(raw.w) * w, bfhi(raw.w) * w);
          v[0] += bflo(r0); v[1] += bfhi(r0); v[2] += bflo(r1); v[3] += bfhi(r1);
          v[4] += bflo(r2); v[5] += bfhi(r2); v[6] += bflo(r3); v[7] += bfhi(r3);
        }
        unsigned hi[4];
#pragma unroll
        for (int j = 0; j < 4; ++j) hi[j] = pack2(v[2 * j], v[2 * j + 1]);
        if (part) {
#pragma unroll
          for (int j = 0; j < 4; ++j) hi[j] = pack2(v[2 * j] - bflo(hi[j]), v[2 * j + 1] - bfhi(hi[j]));
        }
        al[s] = mk8(hi[0], hi[1], hi[2], hi[3]);
      }
    }
    const int ntile = N >> 5;
    const u16* ikb = proj + (size_t)(b * S_ + (lane & 31)) * PW + C_IK + 8 * hh;
    for (int attempt = 0; attempt < 2; ++attempt) {
      const int ss = (attempt == 0 && N >= 4096) ? 8 : 1;
      const unsigned rank_t = (ss == 8) ? 48u : 256u;
      {
        uint4* h4 = (uint4*)smem;
        const uint4 z = make_uint4(0, 0, 0, 0);
        for (int i = tid; i < 131072 / 16; i += 512) h4[i] = z;
      }
      if (tid < 64) candcnt[tid] = 0;
      if (tid < 32) mcnt[tid] = 0;
      __syncthreads();
      float Lf[8];
#pragma unroll
      for (int i = 0; i < 8; ++i) Lf[i] = 0.f;
      for (int pass = 0; pass < 2; ++pass) {
        const int st = (pass == 0) ? ss : 1;
        if (pass == 1) {
#pragma unroll
          for (int i = 0; i < 8; ++i) {
            const unsigned k0 = ((unsigned)tbin[2 * i + hh]) << 20;
            Lf[i] = __uint_as_float((k0 & 0x80000000u) ? (k0 & 0x7fffffffu) : ~k0);
          }
        }
        int kt = wave * st;
        bf16x8 cb0 = {}, cb1 = {};
        if (kt < ntile) {
          cb0 = ld8(ikb + (size_t)kt * 32 * PW);
          cb1 = ld8(ikb + (size_t)kt * 32 * PW + 16);
        }
        for (; kt < ntile; kt += 8 * st) {
          bf16x8 nb0 = cb0, nb1 = cb1;
          if (kt + 8 * st < ntile) {
            nb0 = ld8(ikb + (size_t)(kt + 8 * st) * 32 * PW);
            nb1 = ld8(ikb + (size_t)(kt + 8 * st) * 32 * PW + 16);
          }
          const int key = kt * 32 + (lane & 31);
          f32x16 la = {};
          la = __builtin_amdgcn_mfma_f32_32x32x16_bf16(al[0], cb0, la, 0, 0, 0);
          la = __builtin_amdgcn_mfma_f32_32x32x16_bf16(al[1], cb1, la, 0, 0, 0);
#pragma unroll
          for (int rt = 0; rt < 4; ++rt) {
            f32x16 acc = {};
            acc = __builtin_amdgcn_mfma_f32_32x32x16_bf16(af[rt][0], cb0, acc, 0, 0, 0);
            acc = __builtin_amdgcn_mfma_f32_32x32x16_bf16(af[rt][1], cb1, acc, 0, 0, 0);
            float s0 = la[2 * rt] + la[2 * rt + 8], s1 = la[2 * rt + 1] + la[2 * rt + 9];
#pragma unroll
            for (int i = 0; i < 8; ++i) s0 = __builtin_fmaf(__builtin_fabsf(acc[i]), sg[rt][i], s0);
#pragma unroll
            for (int i = 8; i < 16; ++i) s1 = __builtin_fmaf(__builtin_fabsf(acc[i]), sg[rt][i], s1);
#pragma unroll
            for (int uu = 0; uu < 2; ++uu) {
              const float sc = uu ? s1 : s0;
              const int qi = 4 * rt + 2 * uu + hh;
              if (pass == 0) {
                const int bin = (int)(mono_key(sc) >> 20);
                atomicAdd((unsigned*)smem + qi * 2048 + (bin >> 1), 1u << ((bin & 1) * 16));
              } else if (sc >= Lf[rt * 2 + uu]) {
                const int pos = atomicAdd(&candcnt[qi], 1);
                if (pos < CAND_CAP) {
                  cand_s[qi * CAND_CAP + pos] = sc;
                  cand_i[qi * CAND_CAP + pos] = (u16)key;
                }
              }
            }
          }
          cb0 = nb0;
          cb1 = nb1;
        }
        __syncthreads();
        if (pass == 0) {
          const int qi = tid >> 5, seg = tid & 31;
          const unsigned* hq = (const unsigned*)smem + qi * 2048 + seg * 64;
          unsigned part = 0;
          for (int w = 0; w < 64; ++w) {
            const unsigned x = hq[(w + seg) & 63];
            part += (x & 0xffffu) + (x >> 16);
          }
          unsigned incl = part;
#pragma unroll
          for (int d = 1; d < 32; d <<= 1) {
            const unsigned o = __shfl_down(incl, d, 32);
            if (seg + d < 32) incl += o;
          }
          const unsigned above = incl - part;
          int mytb = -1;
          if (above < rank_t && incl >= rank_t) {
            unsigned cum = above;
            for (int w = 63; w >= 0; --w) {
              const unsigned x = hq[w];
              const unsigned chi = x >> 16, clo = x & 0xffffu;
              if (cum + chi >= rank_t) { mytb = seg * 128 + 2 * w + 1; break; }
              cum += chi;
              if (cum + clo >= rank_t) { mytb = seg * 128 + 2 * w; break; }
              cum += clo;
            }
          }
          __syncthreads();
          {
            uint4* bz = (uint4*)(smem + 73728);
            for (int i = tid; i < 3072; i += 512) bz[i] = make_uint4(0, 0, 0, 0);
          }
          if (mytb >= 0) tbin[qi] = mytb;
          __syncthreads();
        }
      }
      if (tid < 16) {
        const int cc = candcnt[tid];
        if (cc < 256 || cc > CAND_CAP) atomicOr((unsigned*)flag, 1u);
      }
      __syncthreads();
      const int bad = *(volatile int*)flag;
      __syncthreads();
      if (!bad) break;
    }
    {
      const int qi = tid >> 5, seg = tid & 31;
      const int C = min(candcnt[qi], CAND_CAP);
      unsigned prefix = 0u;
      unsigned kneed = 256u;
      const bool few = (C < 256);
#pragma unroll 1
      for (int d = 3; d >= 0; --d) {
        const int shift = 8 * d;
#pragma unroll
        for (int w = 0; w < 8; ++w) h2[qi * 256 + seg * 8 + w] = 0u;
        __syncthreads();
        for (int e = seg; e < C; e += 32) {
          const unsigned key = mono_key(cand_s[qi * CAND_CAP + e]);
          const bool match = (d == 3) || ((key >> (shift + 8)) == (prefix >> (shift + 8)));
          if (match) atomicAdd(&h2[qi * 256 + ((key >> shift) & 255u)], 1u);
        }
        __syncthreads();
        unsigned cnt8[8];
        unsigned part = 0;
#pragma unroll
        for (int w = 0; w < 8; ++w) {
          cnt8[w] = h2[qi * 256 + seg * 8 + w];
          part += cnt8[w];
        }
        unsigned incl = part;
#pragma unroll
        for (int dd = 1; dd < 32; dd <<= 1) {
          const unsigned o = __shfl_down(incl, dd, 32);
          if (seg + dd < 32) incl += o;
        }
        const unsigned above = incl - part;
        if (above < kneed && incl >= kneed) {
          unsigned cum = above;
          int t2 = -1;
#pragma unroll
          for (int w = 7; w >= 0; --w) {
            if (t2 < 0) {
              if (cum + cnt8[w] >= kneed) t2 = seg * 8 + w;
              else cum += cnt8[w];
            }
          }
          tb2a[qi] = t2;
          base2[qi] = (int)cum;
        }
        __syncthreads();
        if (!few) {
          prefix |= ((unsigned)tb2a[qi]) << shift;
          kneed -= (unsigned)base2[qi];
        }
      }
      for (int e = seg; e < C; e += 32) {
        const float s = cand_s[qi * CAND_CAP + e];
        const unsigned id = cand_i[qi * CAND_CAP + e];
        const unsigned key = mono_key(s);
        if (few || key > prefix) atomicOr(&bm[qi * 512 + (id >> 5)], 1u << (id & 31));
        else if (key == prefix) {
          const int pos = atomicAdd(&mcnt[qi], 1);
          if (pos < 128) { mem_s[qi * 128 + pos] = s; mem_i[qi * 128 + pos] = id; }
        }
      }
      __syncthreads();
      const int M = min(mcnt[qi], 128);
      const int need = (int)kneed;
      for (int e = seg; e < M; e += 32) {
        const unsigned id = mem_i[qi * 128 + e];
        int rank = 0;
        for (int f = 0; f < M; ++f) rank += (mem_i[qi * 128 + f] < id) ? 1 : 0;
        if (rank < need) atomicOr(&bm[qi * 512 + (id >> 5)], 1u << (id & 31));
      }
      __syncthreads();
      const unsigned* bq = bm + qi * 512 + seg * 16;
      int cnt = 0;
#pragma unroll
      for (int w = 0; w < 16; ++w) cnt += __popc(bq[w]);
      int inc2 = cnt;
#pragma unroll
      for (int d = 1; d < 32; d <<= 1) {
        const int o = __shfl_up(inc2, d, 32);
        if (seg >= d) inc2 += o;
      }
      int pos = inc2 - cnt;
      for (int w = 0; w < 16; ++w) {
        unsigned x = bq[w];
        while (x) {
          const int bit = __ffs(x) - 1;
          x &= x - 1;
          if (pos < 256) sel[qi * 256 + pos] = (u16)((seg * 16 + w) * 32 + bit);
          ++pos;
        }
      }
      if (seg == 31) {
        for (int q2 = pos; q2 < 256; ++q2) sel[qi * 256 + q2] = 0;
      }
    }
    __syncthreads();
   }
  }

  {
    const int n = (N < 256) ? N : 256;
    const int nt16 = n >> 4;
    const int hc = lane & 15, g4 = lane >> 4;
    u16* Vs = (u16*)(smem + wave * 9216);
    const float sc2 = 0.125f * LOG2E_;
    for (int e2 = 0; e2 < 2 * PROBE_AT; ++e2) {
      const int e = e2 & 1;
      const int qq = wave * 2 + e;
      const size_t tok = (size_t)tok0 + qq;
      bf16x8 qf[2];
#pragma unroll
      for (int s = 0; s < 2; ++s) {
        bf16x8 z = {};
        qf[s] = (hc < 6) ? ld8(proj + tok * PW + C_DQ + hc * 64 + 32 * s + 8 * g4) : z;
      }
      f32x4 st[16];
#pragma unroll
      for (int kt = 0; kt < 16; ++kt) {
        if (kt < nt16) {
          const int key = sel[qq * 256 + kt * 16 + hc] & 16383;
          const u16* kp = proj + (size_t)(b * S_ + key) * PW + C_DK + 8 * g4;
          const bf16x8 a0 = ld8(kp), a1 = ld8(kp + 32);
          f32x4 a = {};
          a = __builtin_amdgcn_mfma_f32_16x16x32_bf16(a0, qf[0], a, 0, 0, 0);
          a = __builtin_amdgcn_mfma_f32_16x16x32_bf16(a1, qf[1], a, 0, 0, 0);
          st[kt] = a;
        } else {
          const float ninf = -__builtin_inff();
          st[kt] = f32x4{ninf, ninf, ninf, ninf};
        }
      }
      float mx = -__builtin_inff();
#pragma unroll
      for (int kt = 0; kt < 16; ++kt)
#pragma unroll
        for (int i = 0; i < 4; ++i) mx = fmaxf(mx, st[kt][i]);
      mx = fmaxf(mx, __shfl_xor(mx, 16));
      mx = fmaxf(mx, __shfl_xor(mx, 32));
      float ls = 0.f;
#pragma unroll
      for (int kt = 0; kt < 16; ++kt)
#pragma unroll
        for (int i = 0; i < 4; ++i) {
          const float pv = __builtin_amdgcn_exp2f((st[kt][i] - mx) * sc2);
          st[kt][i] = pv;
          ls += pv;
        }
      ls += __shfl_xor(ls, 16);
      ls += __shfl_xor(ls, 32);
      f32x4 o[4] = {};
#pragma unroll
      for (int ch = 0; ch < 4; ++ch) {
        if (ch * 64 < n) {
#pragma unroll
          for (int it = 0; it < 8; ++it) {
            const int slot = ch * 64 + it * 8 + (lane >> 3);
            const int key = sel[qq * 256 + slot] & 16383;
            const uint4 v = *(const uint4*)(proj + (size_t)(b * S_ + key) * PW + C_DV + 8 * (lane & 7));
            *(uint4*)(Vs + (it * 8 + (lane >> 3)) * 72 + 8 * (lane & 7)) = v;
          }
          asm volatile("s_waitcnt lgkmcnt(0)" ::: "memory");
#pragma unroll
          for (int tt = 0; tt < 2; ++tt) {
            const int t2 = (ch * 2 + tt) * 2;
            const bf16x8 pb = mk8(pack2(st[t2][0], st[t2][1]), pack2(st[t2][2], st[t2][3]),
                                  pack2(st[t2 + 1][0], st[t2 + 1][1]), pack2(st[t2 + 1][2], st[t2 + 1][3]));
#pragma unroll
            for (int dt = 0; dt < 4; ++dt) {
              bf16x8 va;
#pragma unroll
              for (int j = 0; j < 8; ++j)
                va[j] = (short)Vs[(32 * tt + 16 * (j >> 2) + 4 * g4 + (j & 3)) * 72 + 16 * dt + hc];
              o[dt] = __builtin_amdgcn_mfma_f32_16x16x32_bf16(va, pb, o[dt], 0, 0, 0);
            }
          }
          asm volatile("s_waitcnt lgkmcnt(0)" ::: "memory");
        }
      }
      const float inv = 1.f / ls;
      if (hc < 6) {
#pragma unroll
        for (int dt = 0; dt < 4; ++dt) {
          uint2 w2 = make_uint2(pack2(o[dt][0] * inv, o[dt][1] * inv), pack2(o[dt][2] * inv, o[dt][3] * inv));
          *(uint2*)(Y + tok * 1024 + 256 + hc * 64 + 16 * dt + 4 * g4) = w2;
        }
      }
    }
  }
  __syncthreads();
}

DEVI void band_unit(const Params& p, const int U) {
  extern __shared__ __attribute__((aligned(16))) unsigned char smem[];
  const int tid = TIDX, lane = tid & 63, wave = tid >> 6;
  const int wu = U * 8 + wave;
  const int qh = wu & 1, h = (wu >> 1) % 6, bc = wu / 12, c = bc & 255, b = bc >> 8;
  const int r = lane & 31, g = lane >> 5;
  const u16* proj = (const u16*)(p.ws + WS_Z);
  const u16* Vt = (const u16*)(p.ws + WS_VT);
  u16* Y = (u16*)(p.ws + WS_Y);
  const float* rb = (const float*)(smem + OFF_RB) + h * 192;
  const size_t tokq = (size_t)b * S_ + c * 64 + qh * 32 + r;
  bf16x8 qf[4];
#pragma unroll
  for (int s = 0; s < 4; ++s) qf[s] = ld8(proj + tokq * PW + C_CQ + h * 64 + 16 * s + 8 * g);
  const int c0 = (c >= 8) ? (c - 8) : 0;
  const int kt0 = c0 * 2, kt1 = (c + 1) * 2;
  const int pr = (r & 16) | ((r & 4) << 1) | ((r & 8) >> 1) | (r & 3);
  const int qpos = c * 64 + qh * 32 + r;
  const float SC2 = 0.125f * LOG2E_;
  f32x16 o0 = {}, o1 = {};
  float m = -1e30f, ls = 0.f;
  for (int kt = kt0; kt < kt1; ++kt) {
    const u16* kp = proj + (size_t)(b * S_ + kt * 32 + pr) * PW + C_CK + h * 64 + 8 * g;
    const bf16x8 k0 = ld8(kp), k1 = ld8(kp + 16), k2 = ld8(kp + 32), k3 = ld8(kp + 48);
    const u16* vp = Vt + (size_t)(h * 64 + r) * T_ + (size_t)b * S_ + kt * 32 + 8 * g;
    const bf16x8 v00 = ld8(vp), v01 = ld8(vp + 16), v10 = ld8(vp + (size_t)32 * T_), v11 = ld8(vp + (size_t)32 * T_ + 16);
    f32x16 s = {};
    s = __builtin_amdgcn_mfma_f32_32x32x16_bf16(k0, qf[0], s, 0, 0, 0);
    s = __builtin_amdgcn_mfma_f32_32x32x16_bf16(k1, qf[1], s, 0, 0, 0);
    s = __builtin_amdgcn_mfma_f32_32x32x16_bf16(k2, qf[2], s, 0, 0, 0);
    s = __builtin_amdgcn_mfma_f32_32x32x16_bf16(k3, qf[3], s, 0, 0, 0);
    float tm = -1e30f;
    const int kb = kt * 32 + 8 * g;
#pragma unroll
    for (int i = 0; i < 16; ++i) {
      int rel = qpos - (kb + 16 * (i >> 3) + (i & 7));
      rel = min(max(rel, -63), 128) + 63;
      const float v = s[i] * SC2 + rb[rel];
      s[i] = v;
      tm = fmaxf(tm, v);
    }
    tm = fmaxf(tm, __shfl_xor(tm, 32));
    const float mn = fmaxf(m, tm);
    const float al = __builtin_amdgcn_exp2f(m - mn);
    m = mn;
    float psum = 0.f;
#pragma unroll
    for (int i = 0; i < 16; ++i) {
      const float pv = __builtin_amdgcn_exp2f(s[i] - mn);
      s[i] = pv;
      psum += pv;
    }
    ls = ls * al + psum;
#pragma unroll
    for (int i = 0; i < 16; ++i) {
      o0[i] *= al;
      o1[i] *= al;
    }
    const bf16x8 pb0 = mk8(pack2(s[0], s[1]), pack2(s[2], s[3]), pack2(s[4], s[5]), pack2(s[6], s[7]));
    const bf16x8 pb1 = mk8(pack2(s[8], s[9]), pack2(s[10], s[11]), pack2(s[12], s[13]), pack2(s[14], s[15]));
    o0 = __builtin_amdgcn_mfma_f32_32x32x16_bf16(v00, pb0, o0, 0, 0, 0);
    o0 = __builtin_amdgcn_mfma_f32_32x32x16_bf16(v01, pb1, o0, 0, 0, 0);
    o1 = __builtin_amdgcn_mfma_f32_32x32x16_bf16(v10, pb0, o1, 0, 0, 0);
    o1 = __builtin_amdgcn_mfma_f32_32x32x16_bf16(v11, pb1, o1, 0, 0, 0);
  }
  ls += __shfl_xor(ls, 32);
  const float inv = 1.f / ls;
  u16* yp = Y + tokq * 1024 + 640 + h * 64 + 4 * g;
#pragma unroll
  for (int i4 = 0; i4 < 4; ++i4) {
    *(uint2*)(yp + 8 * i4) = make_uint2(pack2(o0[4 * i4] * inv, o0[4 * i4 + 1] * inv), pack2(o0[4 * i4 + 2] * inv, o0[4 * i4 + 3] * inv));
    *(uint2*)(yp + 32 + 8 * i4) = make_uint2(pack2(o1[4 * i4] * inv, o1[4 * i4 + 1] * inv), pack2(o1[4 * i4 + 2] * inv, o1[4 * i4 + 3] * inv));
  }
}

DEVI void conv_unit(const Params& p, const int l, const int U) {
  const u16* proj = (const u16*)(p.ws + WS_Z);
  u16* Y = (u16*)(p.ws + WS_Y);
  const float* cw = p.in[4] + (size_t)l * 3 * 256;
#pragma unroll 1
  for (int it = 0; it < 8; ++it) {
    const int item = TIDX + 512 * it;
    const int tok = U * 128 + (item >> 5), cg8 = (item & 31) * 8;
    const int s = tok & (S_ - 1);
    const uint4 cb = *(const uint4*)(proj + (size_t)tok * PW + C_CB + cg8);
    float acc[8];
#pragma unroll
    for (int e = 0; e < 8; ++e) acc[e] = 0.f;
#pragma unroll
    for (int j = 0; j < 3; ++j) {
      const int dt = 2 - j;
      if (s - dt >= 0) {
        const uint4 cc = *(const uint4*)(proj + (size_t)(tok - dt) * PW + C_CC + cg8);
        const uint4 ch = *(const uint4*)(proj + (size_t)(tok - dt) * PW + C_CH + cg8);
        const float4 w0 = *(const float4*)(cw + j * 256 + cg8);
        const float4 w1 = *(const float4*)(cw + j * 256 + cg8 + 4);
        acc[0] += w0.x * bflo(cc.x) * bflo(ch.x);
        acc[1] += w0.y * bfhi(cc.x) * bfhi(ch.x);
        acc[2] += w0.z * bflo(cc.y) * bflo(ch.y);
        acc[3] += w0.w * bfhi(cc.y) * bfhi(ch.y);
        acc[4] += w1.x * bflo(cc.z) * bflo(ch.z);
        acc[5] += w1.y * bfhi(cc.z) * bfhi(ch.z);
        acc[6] += w1.z * bflo(cc.w) * bflo(ch.w);
        acc[7] += w1.w * bfhi(cc.w) * bfhi(ch.w);
      }
    }
    uint4 o;
    o.x = pack2(bflo(cb.x) * acc[0], bfhi(cb.x) * acc[1]);
    o.y = pack2(bflo(cb.y) * acc[2], bfhi(cb.y) * acc[3]);
    o.z = pack2(bflo(cb.z) * acc[4], bfhi(cb.z) * acc[5]);
    o.w = pack2(bflo(cb.w) * acc[6], bfhi(cb.w) * acc[7]);
    *(uint4*)(Y + (size_t)tok * 1024 + cg8) = o;
  }
}

DEVI void memkv_unit(const Params& p, const int u) {
  const u16* WT = (const u16*)(p.ws + WS_WT);
  const u16* Mb = (const u16*)(p.ws + WS_MB);
  Sched S{};
  S.nM = 1; S.nN = 1; S.G = 1; S.c = 0;
  if (u < 8) {
    const int pm = u >> 2, pn = u & 3;
    S.A = (const char*)(Mb + (size_t)pm * 256 * 1024);
    S.B = (const char*)(WT + WT_KV + (size_t)pn * 256 * 1024);
    EpiStore16<0> E{(u16*)(p.ws + WS_KM) + (size_t)pm * 256 * 1024 + pn * 256, 1024};
    gemm_phase(1024, 1024, 1024, S, E);
  } else {
    const int v = u - 8, pm = v >> 1, pn = v & 1;
    S.A = (const char*)(WT + WT_KV + (size_t)(1024 + pm * 256) * 1024);
    S.B = (const char*)(Mb + (size_t)pn * 256 * 1024);
    EpiStore16<0> E{(u16*)(p.ws + WS_VTM) + (size_t)pm * 256 * 512 + pn * 256, 512};
    gemm_phase(1024, 1024, 1024, S, E);
  }
}

constexpr int NU_KV = 16, NU_DSA = 2048, NU_BAND = 768, NU_CONV = 256;
DEVI void phase_mixer(const Params& p, const int l) {
  extern __shared__ __attribute__((aligned(16))) unsigned char smem[];
  const int tid = TIDX;
  float* rb = (float*)(smem + OFF_RB);
  for (int i = tid; i < 6 * 192; i += 512) rb[i] = p.in[5][(size_t)l * 6 * 192 + i] * LOG2E_;
  const int G = (int)gridDim.x, bid = BIDX;
  __syncthreads();
  if (bid >= G - NU_KV) memkv_unit(p, bid - (G - NU_KV));
  const int NU = NU_DSA + NU_BAND + NU_CONV;
  for (int rnd = 0;; ++rnd) {
    const int base = rnd * G;
    if (base >= NU) break;
    const int u = base + ((rnd & 1) ? (G - 1 - bid) : bid);
    if (u < NU) {
      if (u < NU_DSA) dsa_unit(p, u);
      else if (u < NU_DSA + NU_BAND) { for (int rb_ = 0; rb_ < PROBE_BD; ++rb_) band_unit(p, u - NU_DSA); }
      else conv_unit(p, l, u - NU_DSA - NU_BAND);
    }
    __syncthreads();
  }
}

DEVI Sched mk_sched(const void* A, const void* B, size_t aStepM, size_t bStepN, int nM, int nN) {
  Sched S{};
  S.A = (const char*)A; S.B = (const char*)B;
  S.aStepM = aStepM; S.aStepN = 0; S.bStepN = bStepN; S.bStepB = 0;
  S.nM = nM; S.nN = nN; S.G = (int)gridDim.x; S.c = BIDX;
  return S;
}
DEVI void phase_inproj(const Params& p) {
  const u16* X = (const u16*)(p.ws + WS_X);
  const u16* WT = (const u16*)(p.ws + WS_WT) + WT_IN;
  {
    const Sched S = mk_sched(X, WT, 256 * 1024 * 2, 256 * 1024 * 2, 128, 10);
    EpiProj E{(u16*)(p.ws + WS_Z), (const float*)(p.ws + WS_ROPED), (const float*)(p.ws + WS_ROPEI)};
    gemm_phase(1024, 1024, 1024, S, E);
  }
  {
    const Sched S = mk_sched(WT + (size_t)2560 * 1024, X, 256 * 1024 * 2, 256 * 1024 * 2, 2, 128);
    EpiStore16<0> E{(u16*)(p.ws + WS_VT), T_};
    gemm_phase(1024, 1024, 1024, S, E);
  }
}
DEVI void phase_gemm_res(const Params& p, const int which) {
  const u16* A = (const u16*)(p.ws + (which == 0 ? WS_Y : (which == 1 ? WS_O : WS_H)));
  const u16* W = (const u16*)(p.ws + WS_WT) + (which == 0 ? WT_OUT : (which == 1 ? WT_MO : WT_FF2));
  const int K = (which == 2) ? 4096 : 1024;
  const Sched S = mk_sched(A, W, (size_t)256 * K * 2, (size_t)256 * K * 2, 128, 4);
  EpiRes E{p.out};
  gemm_phase(K, K, K, S, E);
}
DEVI void phase_gemm_q(const Params& p) {
  const Sched S = mk_sched(p.ws + WS_X, (const u16*)(p.ws + WS_WT) + WT_MQ, 256 * 1024 * 2, 256 * 1024 * 2, 128, 4);
  EpiStore16<0> E{(u16*)(p.ws + WS_Q), 1024};
  gemm_phase(1024, 1024, 1024, S, E);
}
DEVI void phase_gemm_s(const Params& p) {
  Sched S = mk_sched(p.ws + WS_Q, p.ws + WS_KM, 256 * 1024 * 2, 256 * 2, 128, 4);
  S.aStepN = 256 * 2;
  S.bStepB = 256 * 1024 * 2;
  EpiSoftmax E{(u16*)(p.ws + WS_P)};
  gemm_phase(1024, 1024, 256, S, E);
}
DEVI void phase_gemm_pv(const Params& p) {
  Sched S = mk_sched(p.ws + WS_P, p.ws + WS_VTM, 256 * 1024 * 2, 256 * 512 * 2, 128, 4);
  S.aStepN = 256 * 2;
  S.bStepB = 256 * 2;
  EpiStore16<0> E{(u16*)(p.ws + WS_O), 1024};
  gemm_phase(1024, 512, 256, S, E);
}
DEVI void phase_gemm_ff1(const Params& p) {
  const Sched S = mk_sched(p.ws + WS_X, (const u16*)(p.ws + WS_WT) + WT_FF1, 256 * 1024 * 2, 256 * 1024 * 2, 128, 16);
  EpiStore16<1> E{(u16*)(p.ws + WS_H), 4096};
  gemm_phase(1024, 1024, 1024, S, E);
}

#define XB_TMO      128
#define XB_XCNT(j)  (256  + 64 * (j))
#define XB_XSUB(j)  (1280 + 64 * (j))
#define XB_XGEN(j)  (2304 + 64 * (j))
#define XB_TOP      3328
#define XB_TOPGEN   3392
#define XCD_BAR_WORDS 3456
#define XB_SPIN_CAP (1u << 18)
DEVI unsigned xb_ld(unsigned* p) { return __hip_atomic_load(p, __ATOMIC_RELAXED, __HIP_MEMORY_SCOPE_AGENT); }
DEVI unsigned xb_add(unsigned* p, unsigned v) { return __hip_atomic_fetch_add(p, v, __ATOMIC_RELAXED, __HIP_MEMORY_SCOPE_AGENT); }
DEVI unsigned xb_xcc_id() { return (unsigned)__builtin_amdgcn_s_getreg((3 << 11) | 20) & 0xFu; }
#define XB_SPIN(cond, bar) do { unsigned _sp = 0; while (cond) { __builtin_amdgcn_s_sleep(1); \
    if ((++_sp & 255u) == 0u) { if (xb_ld(&(bar)[XB_TMO])) break; if (_sp > XB_SPIN_CAP) { atomicAdd(&(bar)[XB_TMO], 1u); break; } } } } while (0)
struct XcdBarrier { unsigned* bar; unsigned x; volatile LAS unsigned* st; };
DEVI XcdBarrier xcd_barrier_post(unsigned* bar, volatile LAS unsigned* st) {
  XcdBarrier b; b.bar = bar; b.x = xb_xcc_id(); b.st = st;
  if (threadIdx.x == 0) (void)xb_add(&bar[XB_XCNT(b.x)], 1u);
  return b;
}
DEVI void xcd_barrier_complete(unsigned* bar, unsigned x, unsigned& nloc, unsigned& nx) {
  const unsigned G = gridDim.x * gridDim.y * gridDim.z;
  unsigned sum, cnt, mine, sp = 0u;
  for (;;) {
    sum = 0u; cnt = 0u; mine = 0u;
#pragma unroll
    for (unsigned j = 0; j < 16; ++j) { const unsigned c = xb_ld(&bar[XB_XCNT(j)]); sum += c; cnt += (c > 0u) ? 1u : 0u; mine = (j == x) ? c : mine; }
    if (sum == G) break;
    __builtin_amdgcn_s_sleep(1);
    if ((++sp & 255u) == 0u) { if (xb_ld(&bar[XB_TMO])) break; if (sp > XB_SPIN_CAP) { atomicAdd(&bar[XB_TMO], 1u); break; } }
  }
  nloc = mine > 0u ? mine : 1u; nx = cnt > 0u ? cnt : 1u;
}
DEVI void xcd_barrier(const XcdBarrier& b) {
  asm volatile("s_waitcnt vmcnt(0)" ::: "memory");
  __syncthreads();
  if (threadIdx.x == 0) {
    unsigned* bar = b.bar;
    __builtin_amdgcn_s_waitcnt(0);
    unsigned nloc = b.st[0], nx = b.st[1];
    if (nloc == 0u) { xcd_barrier_complete(bar, b.x, nloc, nx); b.st[0] = nloc; b.st[1] = nx; }
    const unsigned old = xb_add(&bar[XB_XSUB(b.x)], 1u);
    const unsigned gen = old / nloc;
    if (old + 1u == (gen + 1u) * nloc) {
      __builtin_amdgcn_fence(__ATOMIC_RELEASE, "agent");
      asm volatile("s_waitcnt vmcnt(0)" ::: "memory");
      const unsigned og = xb_add(&bar[XB_TOP], 1u);
      const unsigned tg = og / nx;
      if (og + 1u == (tg + 1u) * nx) xb_add(&bar[XB_TOPGEN], 1u);
      else XB_SPIN(xb_ld(&bar[XB_TOPGEN]) == tg, bar);
      __builtin_amdgcn_fence(__ATOMIC_ACQUIRE, "agent");
      xb_add(&bar[XB_XGEN(b.x)], 1u);
      asm volatile("s_waitcnt vmcnt(0)" ::: "memory");
    } else {
      XB_SPIN(xb_ld(&bar[XB_XGEN(b.x)]) == gen, bar);
      __builtin_amdgcn_fence(__ATOMIC_ACQUIRE, "agent");
      asm volatile("s_waitcnt vmcnt(0)" ::: "memory");
    }
  }
  __syncthreads();
}

DEVI void grid_seam(cg::grid_group& grid) {
  asm volatile("s_waitcnt vmcnt(0) lgkmcnt(0)" ::: "memory");
  __builtin_amdgcn_fence(__ATOMIC_RELEASE, "agent");
  asm volatile("s_waitcnt vmcnt(0)" ::: "memory");
  grid.sync();
  __builtin_amdgcn_fence(__ATOMIC_ACQUIRE, "agent");
  asm volatile("s_waitcnt vmcnt(0)" ::: "memory");
  __builtin_amdgcn_fence(__ATOMIC_RELEASE, "agent");
  asm volatile("s_waitcnt vmcnt(0)" ::: "memory");
  grid.sync();
  __builtin_amdgcn_fence(__ATOMIC_ACQUIRE, "agent");
  asm volatile("s_waitcnt vmcnt(0)" ::: "memory");
}
#define PHASE(stmt)                  \
  do {                               \
    Params q = p;                    \
    const int _z = opaque_s(0);      \
    q.ws = p.ws + _z;                \
    q.out = p.out + _z;              \
    stmt;                            \
  } while (0)
__global__ void __launch_bounds__(512, 2) mega(Params p) {
  cg::grid_group grid = cg::this_grid();
  extern __shared__ __attribute__((aligned(16))) unsigned char smem[];
  volatile LAS unsigned* xst = (volatile LAS unsigned*)((LAS unsigned char*)smem + OFF_XB);
  if (threadIdx.x < 4) xst[threadIdx.x] = 0u;
  __syncthreads();
  const XcdBarrier xb = xcd_barrier_post((unsigned*)(p.ws + WS_BAR), xst);
  PHASE(phase0(q));
  PHASE(convert_weights(q, 0));
  grid_seam(grid);
#pragma unroll 1
  for (int l = 0; l < NL_; ++l) {
    PHASE(phase_inproj(q));
    xcd_barrier(xb);
    PHASE(phase_mixer(q, l));
    xcd_barrier(xb);
    PHASE(phase_gemm_res(q, 0));
    xcd_barrier(xb);
    PHASE(ln_phase(q, q.in[7] + l * 1024, q.in[8] + l * 1024));
    xcd_barrier(xb);
    PHASE(phase_gemm_q(q));
    xcd_barrier(xb);
    PHASE(phase_gemm_s(q));
    xcd_barrier(xb);
    PHASE(phase_gemm_pv(q));
    xcd_barrier(xb);
    PHASE(phase_gemm_res(q, 1));
    xcd_barrier(xb);
    PHASE(ln_phase(q, q.in[12] + l * 1024, q.in[13] + l * 1024));
    xcd_barrier(xb);
    PHASE(phase_gemm_ff1(q));
    xcd_barrier(xb);
    PHASE(phase_gemm_res(q, 2));
    xcd_barrier(xb);
    PHASE(ln_phase(q, q.in[16] + l * 1024, q.in[17] + l * 1024));
    if (l + 1 < NL_) PHASE(convert_weights(q, l + 1));
    xcd_barrier(xb);
  }
}

extern "C" void kernel_launch(void* const* d_in, const int* in_sizes, int n_in, void* d_out, int out_size, void* d_ws,
                              size_t ws_size, hipStream_t stream) {
  static int grid_blocks = 0;
  if (grid_blocks == 0) {
    if (n_in != 18 || ws_size < WS_END) {
      fprintf(stderr, "kernel_launch: unexpected n_in %d or ws_size %zu (need %zu)\n", n_in, ws_size, (size_t)WS_END);
      grid_blocks = -1;
      return;
    }
    int dev = 0, cus = 0, per_cu = 0;
    hipGetDevice(&dev);
    hipDeviceGetAttribute(&cus, hipDeviceAttributeMultiprocessorCount, dev);
    if (hipFuncSetAttribute((const void*)mega, hipFuncAttributeMaxDynamicSharedMemorySize, LDS_BYTES) != hipSuccess)
      fprintf(stderr, "kernel_launch: hipFuncSetAttribute failed\n");
    if (hipOccupancyMaxActiveBlocksPerMultiprocessor(&per_cu, (const void*)mega, 512, LDS_BYTES) != hipSuccess || per_cu < 1)
      per_cu = 1;
    (void)hipGetLastError();
    grid_blocks = cus * per_cu;
  }
  if (grid_blocks < 0) return;
  if (hipMemsetAsync((char*)d_ws + WS_BAR, 0, XCD_BAR_WORDS * sizeof(unsigned), stream) != hipSuccess)
    fprintf(stderr, "kernel_launch: hipMemsetAsync of the barrier words failed\n");
  Params p{};
  for (int i = 0; i < 18; ++i) p.in[i] = (const float*)d_in[i];
  p.out = (float*)d_out;
  p.ws = (unsigned char*)d_ws;
  void* args[] = {&p};
  hipError_t e = hipLaunchCooperativeKernel((const void*)mega, dim3(grid_blocks), dim3(512), args, LDS_BYTES, stream);
  if (e != hipSuccess) fprintf(stderr, "cooperative launch failed: %s (grid %d)\n", hipGetErrorString(e), grid_blocks);
}
```

```cpp
#include <hip/hip_runtime.h>
#include <hip/hip_cooperative_groups.h>
#include <cstdio>
#include <cmath>
namespace cg = cooperative_groups;

#define DEVI __device__ __forceinline__
typedef unsigned short u16;
using bf16x8 = __attribute__((ext_vector_type(8))) short;
using f32x4 = __attribute__((ext_vector_type(4))) float;
using f32x16 = __attribute__((ext_vector_type(16))) float;
typedef __bf16 bf2_t __attribute__((ext_vector_type(2)));
typedef float fl2_t __attribute__((ext_vector_type(2)));
typedef _Float16 h2_t __attribute__((ext_vector_type(2)));

constexpr int T_ = 32768, S_ = 16384, D_ = 1024, NL_ = 4, PW = 2560;
constexpr int C_CB = 0, C_CC = 256, C_CH = 512, C_DQ = 768, C_DK = 1152, C_DV = 1216, C_IQ = 1280, C_IK = 1536,
              C_IW = 1568, C_CQ = 1600, C_CK = 1984;
constexpr float ALPHA_ = 1.6817928305074290f;
constexpr float LOG2E_ = 1.4426950408889634f;
constexpr size_t MiB = 1u << 20;
constexpr size_t WS_BAR = 4096;
constexpr size_t WS_CTL = 0, WS_X = 1 * MiB, WS_WT = WS_X + 64 * MiB, WS_MB = WS_WT + 32 * MiB, WS_KM = WS_MB + MiB,
                 WS_VTM = WS_KM + MiB, WS_ROPED = WS_VTM + MiB, WS_ROPEI = WS_ROPED + 2 * MiB, WS_IKC = WS_ROPEI + MiB,
                 WS_DKC = WS_IKC + 2 * MiB, WS_DVC = WS_DKC + 4 * MiB, WS_Z = WS_DVC + 4 * MiB,
                 WS_VT = WS_Z + 160 * MiB, WS_Y = WS_Z + 192 * MiB, WS_Q = WS_Z, WS_P = WS_Z + 64 * MiB,
                 WS_O = WS_Z + 128 * MiB, WS_H = WS_Z, WS_END = WS_Z + 256 * MiB;
constexpr size_t WT_IN = 0, WT_OUT = 3072 * 1024, WT_MQ = WT_OUT + 1024 * 1024, WT_KV = WT_MQ + 1024 * 1024,
                 WT_MO = WT_KV + 2048 * 1024, WT_FF1 = WT_MO + 1024 * 1024, WT_FF2 = WT_FF1 + 4096 * 1024;
constexpr int LDS_BYTES = 147456;
constexpr int OFF_RB = 131072, OFF_CNT = OFF_RB + 4608, OFF_IW = OFF_CNT + 256, OFF_MISC = OFF_IW + 512,
              OFF_RED = OFF_MISC + 256, OFF_XB = OFF_RED + 8192;
constexpr int CAND_CAP = 768;
#ifndef PROBE_TK
#define PROBE_TK 1
#endif
#ifndef PROBE_AT
#define PROBE_AT 1
#endif
#ifndef PROBE_BD
#define PROBE_BD 1
#endif

struct Params {
  const float* in[18];
  float* out;
  unsigned char* ws;
};
__constant__ const float INV8_[8] = {1.0f, 0.19392274f, 0.03760603f, 0.0072926646f, 0.0014142136f, 0.0002742482f, 5.3182957e-05f, 1.0313385e-05f};
__constant__ const float INV4_[4] = {1.0f, 0.03760603f, 0.0014142136f, 5.3182957e-05f};

DEVI int opaque_v(int x) { asm volatile("" : "+v"(x)); return x; }
DEVI int opaque_s(int x) { asm volatile("" : "+s"(x)); return x; }
template <class Tp> DEVI Tp* opaque_p(Tp* x) { asm volatile("" : "+s"(x)); return x; }
#define TIDX opaque_v((int)threadIdx.x)
#define BIDX opaque_s((int)blockIdx.x)
DEVI unsigned pack2(float a, float b) {
  fl2_t x = {a, b};
  bf2_t y = __builtin_convertvector(x, bf2_t);
  return __builtin_bit_cast(unsigned, y);
}
DEVI u16 f2bf(float a) { return (u16)(pack2(a, 0.f) & 0xffffu); }
DEVI float bf2f(u16 h) { return __uint_as_float(((unsigned)h) << 16); }
DEVI float bflo(unsigned w) { return __uint_as_float(w << 16); }
DEVI float bfhi(unsigned w) { return __uint_as_float(w & 0xffff0000u); }
DEVI bf16x8 ld8(const u16* p) { return __builtin_bit_cast(bf16x8, *(const uint4*)p); }
DEVI bf16x8 mk8(unsigned a, unsigned b, unsigned c, unsigned d) {
  uint4 v = make_uint4(a, b, c, d);
  return __builtin_bit_cast(bf16x8, v);
}

#define LAS __attribute__((address_space(3)))
typedef unsigned u32x4 __attribute__((ext_vector_type(4)));
constexpr int BK = 64, HALF = 128, HTB = HALF * BK * 2;
DEVI int lds_byte(int r, int c) {
  const int st = (r >> 4) * 2 + (c >> 5), rr = r & 15, cc = c & 31, ob = rr * 64 + cc * 2;
  return st * 1024 + (ob ^ (((ob >> 9) & 1) << 5));
}
DEVI void stage_rc(int b, int& R, int& C) {
  const int st = b / 1024, sb = b % 1024, swz = sb ^ (((sb >> 9) & 1) << 5);
  R = (st >> 1) * 16 + swz / 64;
  C = (st & 1) * 32 + (swz % 64) / 2;
}
DEVI int perm32(int rho) {
  const int n = rho >> 4, i = rho & 15;
  return 8 * (i >> 2) + 4 * n + (i & 3);
}
DEVI void tile_coord(int v, int nM, int nN, int& pm, int& pn) {
  const int nwg = nM * nN;
  const int q = nwg / 8, r = nwg % 8, xcd = v % 8, off = v / 8;
  const int w = (xcd < r ? xcd * (q + 1) : r * (q + 1) + (xcd - r) * q) + off;
  const int nig = 8 * nN, gid = w / nig, fm = gid * 8, gsz = min(nM - fm, 8);
  pm = fm + ((w % nig) % gsz);
  pn = (w % nig) / gsz;
}
struct GUnit { const char* a; const char* b; int pm, pn; };
struct Sched {
  const char* A; const char* B;
  size_t aStepM, aStepN, bStepN, bStepB;
  int nM, nN, G, c;
  DEVI bool next(int i, GUnit& u) const {
    const int L = i * G + c;
    if (L >= nM * nN) return false;
    int pm, pn;
    tile_coord(L, nM, nN, pm, pn);
    u.pm = pm; u.pn = pn;
    u.a = A + (size_t)pm * aStepM + (size_t)pn * aStepN;
    u.b = B + (size_t)pn * bStepN + (size_t)(pm >> 6) * bStepB;
    return true;
  }
};

template <int ACT>
struct EpiStore16 {
  static constexpr bool PERM = true;
  u16* C; int ldc;
  DEVI void operator()(f32x4 (&acc)[2][2][4][2], const GUnit& u, int wr, int wc, int fr, int fq) const {
    const int row0 = u.pm * 256 + wr * 64 + fr, col0 = u.pn * 256 + wc * 32 + 8 * fq;
#pragma unroll
    for (int ai = 0; ai < 2; ++ai)
#pragma unroll
      for (int m = 0; m < 4; ++m) {
        u16* rowp = C + (size_t)(row0 + ai * HALF + m * 16) * ldc + col0;
#pragma unroll
        for (int bj = 0; bj < 2; ++bj) {
          f32x4 v0 = acc[ai][bj][m][0], v1 = acc[ai][bj][m][1];
          if (ACT == 1) {
#pragma unroll
            for (int j = 0; j < 4; ++j) {
              const float a = fmaxf(v0[j], 0.f), b = fmaxf(v1[j], 0.f);
              v0[j] = a * a;
              v1[j] = b * b;
            }
          }
          u32x4 w;
          w.x = pack2(v0[0], v0[1]); w.y = pack2(v0[2], v0[3]); w.z = pack2(v1[0], v1[1]); w.w = pack2(v1[2], v1[3]);
          *(u32x4*)(rowp + bj * HALF) = w;
        }
      }
  }
};
struct EpiProj {
  static constexpr bool PERM = true;
  u16* C; const float* ropeD; const float* ropeI; u16* IKc; u16* DKc; u16* DVc;
  DEVI void operator()(f32x4 (&acc)[2][2][4][2], const GUnit& u, int wr, int wc, int fr, int fq) const {
    const int row0 = u.pm * 256 + wr * 64 + fr, col0 = u.pn * 256 + wc * 32 + 8 * fq;
#pragma unroll
    for (int ai = 0; ai < 2; ++ai)
#pragma unroll
      for (int m = 0; m < 4; ++m) {
        const int row = row0 + ai * HALF + m * 16;
        u16* rowp = C + (size_t)row * PW + col0;
#pragma unroll
        for (int bj = 0; bj < 2; ++bj) {
          f32x4 v0 = acc[ai][bj][m][0], v1 = acc[ai][bj][m][1];
          const int gg = u.pn * 256 + bj * HALF + wc * 32;
          if (gg >= C_DQ && gg < C_DV && (gg & 63) == 0) {
            const f32x4 c0 = *(const f32x4*)(ropeD + (size_t)row * 16), c1 = *(const f32x4*)(ropeD + (size_t)row * 16 + 4);
            const f32x4 s0 = *(const f32x4*)(ropeD + (size_t)row * 16 + 8), s1 = *(const f32x4*)(ropeD + (size_t)row * 16 + 12);
#pragma unroll
            for (int j = 0; j < 4; ++j) {
              const float p0 = __shfl_xor(v0[j], 16), p1 = __shfl_xor(v1[j], 16);
              const float a0 = (fq == 0) ? (v0[j] * c0[j] - p0 * s0[j]) : (v0[j] * c0[j] + p0 * s0[j]);
              const float a1 = (fq == 0) ? (v1[j] * c1[j] - p1 * s1[j]) : (v1[j] * c1[j] + p1 * s1[j]);
              v0[j] = (fq < 2) ? a0 : v0[j];
              v1[j] = (fq < 2) ? a1 : v1[j];
            }
          } else if (gg >= C_IQ && gg < C_IW) {
            const f32x4 cs = *(const f32x4*)(ropeI + (size_t)row * 8), sn = *(const f32x4*)(ropeI + (size_t)row * 8 + 4);
#pragma unroll
            for (int j = 0; j < 4; ++j) {
              const float x1 = v0[j], x2 = v1[j];
              v0[j] = (fq == 0) ? (x1 * cs[j] - x2 * sn[j]) : x1;
              v1[j] = (fq == 0) ? (x2 * cs[j] + x1 * sn[j]) : x2;
            }
          }
          u32x4 w;
          w.x = pack2(v0[0], v0[1]); w.y = pack2(v0[2], v0[3]); w.z = pack2(v1[0], v1[1]); w.w = pack2(v1[2], v1[3]);
          u16* dst = rowp + bj * HALF;
          if (gg == C_IK) dst = IKc + (size_t)row * 32 + 8 * fq;
          else if (gg >= C_DK && gg < C_DV) dst = DKc + (size_t)row * 64 + (gg - C_DK) + 8 * fq;
          else if (gg >= C_DV && gg < C_IQ) dst = DVc + (size_t)row * 64 + (gg - C_DV) + 8 * fq;
          *(u32x4*)dst = w;
        }
      }
  }
};
struct EpiRes {
  static constexpr bool PERM = false;
  float* R;
  DEVI void operator()(f32x4 (&acc)[2][2][4][2], const GUnit& u, int wr, int wc, int fr, int fq) const {
    const int row0 = u.pm * 256 + wr * 64 + fr, col0 = u.pn * 256 + wc * 32 + 4 * fq;
#pragma unroll
    for (int ai = 0; ai < 2; ++ai)
#pragma unroll
      for (int m = 0; m < 4; ++m) {
        float* rowp = R + (size_t)(row0 + ai * HALF + m * 16) * 1024 + col0;
#pragma unroll
        for (int bj = 0; bj < 2; ++bj)
#pragma unroll
          for (int n = 0; n < 2; ++n) {
            f32x4* q = (f32x4*)(rowp + bj * HALF + n * 16);
            const f32x4 old = *q;
            *q = old * ALPHA_ + acc[ai][bj][m][n];
          }
      }
  }
};
struct EpiSoftmax {
  static constexpr bool PERM = true;
  u16* C;
  DEVI void operator()(f32x4 (&acc)[2][2][4][2], const GUnit& u, int wr, int wc, int fr, int fq) const {
    extern __shared__ __attribute__((aligned(16))) unsigned char smem[];
    float* red = (float*)(smem + OFF_RED);
    const float sc2 = 0.0625f * LOG2E_;
#pragma unroll
    for (int ai = 0; ai < 2; ++ai)
#pragma unroll
      for (int m = 0; m < 4; ++m) {
        float mx = -__builtin_inff();
#pragma unroll
        for (int bj = 0; bj < 2; ++bj)
#pragma unroll
          for (int n = 0; n < 2; ++n)
#pragma unroll
            for (int j = 0; j < 4; ++j) mx = fmaxf(mx, acc[ai][bj][m][n][j]);
        mx = fmaxf(mx, __shfl_xor(mx, 16));
        mx = fmaxf(mx, __shfl_xor(mx, 32));
        float sum = 0.f;
#pragma unroll
        for (int bj = 0; bj < 2; ++bj)
#pragma unroll
          for (int n = 0; n < 2; ++n)
#pragma unroll
            for (int j = 0; j < 4; ++j) sum += __builtin_amdgcn_exp2f((acc[ai][bj][m][n][j] - mx) * sc2);
        sum += __shfl_xor(sum, 16);
        sum += __shfl_xor(sum, 32);
        if (fq == 0) *(float2*)(red + ((ai * HALF + wr * 64 + m * 16 + fr) * 4 + wc) * 2) = make_float2(mx, sum);
        __builtin_amdgcn_sched_barrier(0);
      }
    __syncthreads();
    u16* cbase = C + (size_t)(u.pm * 256 + wr * 64 + fr) * 1024 + u.pn * 256 + wc * 32 + 8 * fq;
#pragma unroll
    for (int ai = 0; ai < 2; ++ai)
#pragma unroll
      for (int m = 0; m < 4; ++m) {
        const int rl = ai * HALF + wr * 64 + m * 16 + fr;
        const f32x4 ra = *(const f32x4*)(red + rl * 8), rb = *(const f32x4*)(red + rl * 8 + 4);
        const float mx = fmaxf(fmaxf(ra[0], ra[2]), fmaxf(rb[0], rb[2]));
        const float L = ra[1] * __builtin_amdgcn_exp2f((ra[0] - mx) * sc2) + ra[3] * __builtin_amdgcn_exp2f((ra[2] - mx) * sc2) +
                        rb[1] * __builtin_amdgcn_exp2f((rb[0] - mx) * sc2) + rb[3] * __builtin_amdgcn_exp2f((rb[2] - mx) * sc2);
        const float inv = 1.f / L;
        u16* rowp = cbase + (size_t)(ai * HALF + m * 16) * 1024;
#pragma unroll
        for (int bj = 0; bj < 2; ++bj) {
          f32x4 v0 = acc[ai][bj][m][0], v1 = acc[ai][bj][m][1];
#pragma unroll
          for (int j = 0; j < 4; ++j) {
            v0[j] = __builtin_amdgcn_exp2f((v0[j] - mx) * sc2) * inv;
            v1[j] = __builtin_amdgcn_exp2f((v1[j] - mx) * sc2) * inv;
          }
          u32x4 w;
          w.x = pack2(v0[0], v0[1]); w.y = pack2(v0[2], v0[3]); w.z = pack2(v1[0], v1[1]); w.w = pack2(v1[2], v1[3]);
          *(u32x4*)(rowp + bj * HALF) = w;
        }
        __builtin_amdgcn_sched_barrier(0);
      }
    __syncthreads();
  }
};

template <class Epi>
DEVI void gemm_phase(const int lda, const int ldb, const int K, const Sched& S, const Epi& E) {
  extern __shared__ __attribute__((aligned(16))) unsigned char smem[];
  LAS unsigned char* lds = (LAS unsigned char*)smem;
  const int tid = TIDX, wid = __builtin_amdgcn_readfirstlane(tid >> 6), lane = tid & 63, wr = wid >> 2, wc = wid & 3,
            fr = lane & 15, fq = lane >> 4;
  const int nt = opaque_s(K) / BK;
  unsigned voffA[2], voffB[2];
#pragma unroll
  for (int i = 0; i < 2; ++i) {
    int R, C;
    stage_rc(tid * 16 + i * 8192, R, C);
    const int Rb = Epi::PERM ? ((R & ~31) + perm32(R & 31)) : R;
    voffA[i] = (unsigned)(R * lda + C) * 2u;
    voffB[i] = (unsigned)(Rb * ldb + C) * 2u;
  }
  const size_t kstep = (size_t)(BK * 2);
  const size_t hstepA = (size_t)HALF * lda * 2, hstepB = (size_t)HALF * ldb * 2;
  const unsigned ldsw = (unsigned)wid * 1024u;
  const int aoff = lds_byte(wr * 64 + fr, fq * 8), boff = lds_byte(wc * 32 + fr, fq * 8);
#define PG8_SA(b, h) (((b) * 2 + (h)) * HTB)
#define PG8_SB(b, h) ((4 + (b) * 2 + (h)) * HTB)
#define PG8_STAGE(bufoff, gbase, voff)                                                                                \
  do {                                                                                                                \
    _Pragma("unroll") for (int _i = 0; _i < 2; ++_i) __builtin_amdgcn_global_load_lds(                                \
        (const unsigned*)((const char*)(gbase) + (voff)[_i]), (LAS unsigned*)(lds + (bufoff) + ldsw + _i * 8192), 16, 0, 0); \
  } while (0)
#define PG8_LDA(dst, b, h)                                                                                            \
  do {                                                                                                                \
    _Pragma("unroll") for (int m = 0; m < 4; ++m) _Pragma("unroll") for (int k = 0; k < 2; ++k) dst[m][k] =           \
        *(const LAS bf16x8*)(lds + PG8_SA(b, h) + aoff + m * 2048 + k * 1024);                                        \
  } while (0)
#define PG8_LDB(dst, b, h)                                                                                            \
  do {                                                                                                                \
    _Pragma("unroll") for (int n = 0; n < 2; ++n) _Pragma("unroll") for (int k = 0; k < 2; ++k) dst[n][k] =           \
        *(const LAS bf16x8*)(lds + PG8_SB(b, h) + boff + n * 2048 + k * 1024);                                        \
  } while (0)
#define PG8_MMA(ai, bj, At, Bt)                                                                                       \
  do {                                                                                                                \
    __builtin_amdgcn_s_setprio(1);                                                                                    \
    _Pragma("unroll") for (int m = 0; m < 4; ++m) _Pragma("unroll") for (int n = 0; n < 2; ++n)                       \
        _Pragma("unroll") for (int k = 0; k < 2; ++k) acc[ai][bj][m][n] =                                             \
            __builtin_amdgcn_mfma_f32_16x16x32_bf16(Bt[n][k], At[m][k], acc[ai][bj][m][n], 0, 0, 0);                  \
    __builtin_amdgcn_s_setprio(0);                                                                                    \
  } while (0)
#define PG8_WAIT_V(n) asm volatile("s_waitcnt vmcnt(" #n ")" ::: "memory")
#define PG8_WAIT_L(n) asm volatile("s_waitcnt lgkmcnt(" #n ")" ::: "memory")
#define PG8_BAR __builtin_amdgcn_s_barrier()
#define PG8_SCHED __builtin_amdgcn_sched_barrier(0)
  GUnit cur, nxt;
  int ui = 0;
  if (S.next(0, cur)) {
    f32x4 acc[2][2][4][2];
#pragma unroll
    for (int a = 0; a < 2; ++a)
#pragma unroll
      for (int b = 0; b < 2; ++b)
#pragma unroll
        for (int m = 0; m < 4; ++m)
#pragma unroll
          for (int n = 0; n < 2; ++n) acc[a][b][m][n] = (f32x4){0.f, 0.f, 0.f, 0.f};
    bf16x8 At[4][2], B0[2][2], B1[2][2];
    const char* cA = cur.a;
    const char* cB = cur.b;
    PG8_WAIT_V(0);
    PG8_STAGE(PG8_SB(0, 0), cB, voffB); PG8_STAGE(PG8_SA(0, 0), cA, voffA);
    PG8_STAGE(PG8_SB(0, 1), cB + hstepB, voffB); PG8_STAGE(PG8_SA(0, 1), cA + hstepA, voffA);
    if (wr == 1) PG8_BAR;
    PG8_WAIT_V(4); PG8_BAR;
    PG8_STAGE(PG8_SB(1, 0), cB + kstep, voffB); PG8_STAGE(PG8_SA(1, 0), cA + kstep, voffA);
    PG8_STAGE(PG8_SB(1, 1), cB + hstepB + kstep, voffB);
    PG8_WAIT_V(6); PG8_BAR;
    for (;;) {
      const bool has_next = S.next(ui + 1, nxt);
      const char* nA = has_next ? nxt.a : cA;
      const char* nB = has_next ? nxt.b : cB;
      for (int t = 0; t < nt; t += 2) {
        const bool last = (t == nt - 2);
        const char* a1 = cA + (size_t)(t + 1) * kstep;
        const char* a2 = last ? nA : cA + (size_t)(t + 2) * kstep;
        const char* b2 = last ? nB : cB + (size_t)(t + 2) * kstep;
        const char* a3 = a2 + kstep;
        const char* b3 = b2 + kstep;
        PG8_LDB(B0, 0, 0); PG8_SCHED; PG8_LDA(At, 0, 0); PG8_STAGE(PG8_SA(1, 1), a1 + hstepA, voffA);
        PG8_WAIT_L(8); PG8_BAR; PG8_WAIT_L(0); PG8_MMA(0, 0, At, B0); PG8_BAR; PG8_SCHED;
        PG8_LDB(B1, 0, 1); PG8_STAGE(PG8_SB(0, 0), b2, voffB);
        PG8_BAR; PG8_WAIT_L(0); PG8_MMA(0, 1, At, B1); PG8_BAR;
        PG8_LDA(At, 0, 1); PG8_STAGE(PG8_SA(0, 0), a2, voffA);
        PG8_BAR; PG8_WAIT_L(0); PG8_MMA(1, 0, At, B0); PG8_BAR; PG8_SCHED;
        PG8_STAGE(PG8_SB(0, 1), b2 + hstepB, voffB);
        PG8_WAIT_V(6); PG8_BAR; PG8_MMA(1, 1, At, B1); PG8_BAR;
        PG8_LDB(B0, 1, 0); PG8_SCHED; PG8_LDA(At, 1, 0); PG8_STAGE(PG8_SA(0, 1), a2 + hstepA, voffA);
        PG8_WAIT_L(8); PG8_BAR; PG8_WAIT_L(0); PG8_MMA(0, 0, At, B0); PG8_BAR; PG8_SCHED;
        PG8_LDB(B1, 1, 1); PG8_STAGE(PG8_SB(1, 0), b3, voffB);
        PG8_BAR; PG8_WAIT_L(0); PG8_MMA(0, 1, At, B1); PG8_BAR;
        PG8_LDA(At, 1, 1); PG8_STAGE(PG8_SA(1, 0), a3, voffA);
        PG8_BAR; PG8_WAIT_L(0); PG8_MMA(1, 0, At, B0); PG8_BAR; PG8_SCHED;
        PG8_STAGE(PG8_SB(1, 1), b3 + hstepB, voffB);
        PG8_WAIT_V(6); PG8_BAR; PG8_MMA(1, 1, At, B1); PG8_BAR;
      }
      E(acc, cur, wr, wc, fr, fq);
      if (!has_next) break;
#pragma unroll
      for (int a = 0; a < 2; ++a)
#pragma unroll
        for (int b = 0; b < 2; ++b)
#pragma unroll
          for (int m = 0; m < 4; ++m)
#pragma unroll
            for (int n = 0; n < 2; ++n) acc[a][b][m][n] = (f32x4){0.f, 0.f, 0.f, 0.f};
      cur = nxt; cA = nA; cB = nB; ++ui;
    }
    PG8_WAIT_V(0);
    if (wr == 0) PG8_BAR;
    PG8_BAR;
  }
  __syncthreads();
#undef PG8_SA
#undef PG8_SB
#undef PG8_STAGE
#undef PG8_LDA
#undef PG8_LDB
#undef PG8_MMA
}

DEVI void sincos_acc(float ang, float& c, float& s) {
  const double TWO_PI = 6.283185307179586476925286766559;
  double a = (double)ang;
  double k = rint(a * (1.0 / TWO_PI));
  double r = a - k * TWO_PI;
  double r2 = r * r;
  double sn = 0.0, cs = 0.0;
  double ts = r, tc = 1.0;
#pragma unroll
  for (int n = 0; n < 12; ++n) {
    sn += ts;
    cs += tc;
    ts *= -r2 / (double)((2 * n + 2) * (2 * n + 3));
    tc *= -r2 / (double)((2 * n + 1) * (2 * n + 2));
  }
  c = (float)cs;
  s = (float)sn;
}

DEVI void phase0(const Params& p) {
  const int tid0 = TIDX, bid0 = BIDX;
  const long gtid = (long)bid0 * 512 + tid0, gsz = (long)gridDim.x * 512;
  {
    const float4* x4 = (const float4*)p.in[0];
    float4* r4 = (float4*)p.out;
    uint2* X2 = (uint2*)(p.ws + WS_X);
    for (long i = gtid; i < (long)T_ * D_ / 4; i += gsz) {
      float4 v = x4[i];
      r4[i] = v;
      X2[i] = make_uint2(pack2(v.x, v.y), pack2(v.z, v.w));
    }
    const float4* m4 = (const float4*)p.in[1];
    uint2* M2 = (uint2*)(p.ws + WS_MB);
    for (long i = gtid; i < 512L * 1024 / 4; i += gsz) {
      float4 v = m4[i];
      M2[i] = make_uint2(pack2(v.x, v.y), pack2(v.z, v.w));
    }
  }
  {
    const int* pos = (const int*)p.in[2];
    float* rd = (float*)(p.ws + WS_ROPED);
    float* ri = (float*)(p.ws + WS_ROPEI);
    for (long i = gtid; i < (long)T_ * 12; i += gsz) {
      const int t = (int)(i / 12), f = (int)(i % 12);
      const float ps = (float)pos[t];
      float c, s;
      if (f < 8) {
        sincos_acc(ps * INV8_[f], c, s);
        rd[t * 16 + f] = c;
        rd[t * 16 + 8 + f] = s;
      } else {
        sincos_acc(ps * INV4_[f - 8], c, s);
        ri[t * 8 + (f - 8)] = c;
        ri[t * 8 + 4 + (f - 8)] = s;
      }
    }
  }
  if (bid0 == 0 && tid0 < 64) ((unsigned*)(p.ws + WS_CTL))[tid0] = 0u;
}

DEVI int map_in(int nd) {
  if (nd < 1576) return nd;
  if (nd < 1600) return -1;
  if (nd < 2368) return nd - 24;
  if (nd < 2560) return -1;
  if (nd < 2944) return nd - 216;
  return -1;
}

DEVI void convert_weights(const Params& p, int l) {
  extern __shared__ __attribute__((aligned(16))) unsigned char smem[];
  float* lt = (float*)smem;
  u16* WT = (u16*)(p.ws + WS_WT);
  const int t = TIDX;
  for (int tile = BIDX; tile < 4096; tile += gridDim.x) {
    const float* src;
    u16* dst;
    int K, Nsrc, mode = 0, tl;
    if (tile < 768) { src = p.in[3] + (size_t)l * 1024 * 2728; dst = WT + WT_IN; K = 1024; Nsrc = 2728; mode = 1; tl = tile; }
    else if (tile < 1024) { src = p.in[6] + (size_t)l * 1024 * 1024; dst = WT + WT_OUT; K = 1024; Nsrc = 1024; tl = tile - 768; }
    else if (tile < 1280) { src = p.in[9] + (size_t)l * 1024 * 1024; dst = WT + WT_MQ; K = 1024; Nsrc = 1024; tl = tile - 1024; }
    else if (tile < 1792) { src = p.in[10] + (size_t)l * 1024 * 2048; dst = WT + WT_KV; K = 1024; Nsrc = 2048; tl = tile - 1280; }
    else if (tile < 2048) { src = p.in[11] + (size_t)l * 1024 * 1024; dst = WT + WT_MO; K = 1024; Nsrc = 1024; tl = tile - 1792; }
    else if (tile < 3072) { src = p.in[14] + (size_t)l * 1024 * 4096; dst = WT + WT_FF1; K = 1024; Nsrc = 4096; tl = tile - 2048; }
    else { src = p.in[15] + (size_t)l * 4096 * 1024; dst = WT + WT_FF2; K = 4096; Nsrc = 1024; tl = tile - 3072; }
    const int nkt = K / 64;
    const int nt = tl / nkt, kt = tl % nkt;
    {
      const int n = t & 63, k0 = t >> 6;
      const int nd = nt * 64 + n;
      const int ns = mode ? map_in(nd) : nd;
#pragma unroll
      for (int i = 0; i < 8; ++i) {
        const int k = k0 + 8 * i;
        lt[k * 65 + n] = (ns >= 0) ? src[(size_t)(kt * 64 + k) * Nsrc + ns] : 0.f;
      }
    }
    __syncthreads();
    {
      const int n2 = t >> 3, ks = (t & 7) * 8;
      uint4 o;
      o.x = pack2(lt[(ks + 0) * 65 + n2], lt[(ks + 1) * 65 + n2]);
      o.y = pack2(lt[(ks + 2) * 65 + n2], lt[(ks + 3) * 65 + n2]);
      o.z = pack2(lt[(ks + 4) * 65 + n2], lt[(ks + 5) * 65 + n2]);
      o.w = pack2(lt[(ks + 6) * 65 + n2], lt[(ks + 7) * 65 + n2]);
      *(uint4*)(dst + (size_t)(nt * 64 + n2) * K + kt * 64 + ks) = o;
    }
    __syncthreads();
  }
}

DEVI float wave_sum(float v) {
  v += __shfl_xor(v, 32);
  v += __shfl_xor(v, 16);
  v += __shfl_xor(v, 8);
  v += __shfl_xor(v, 4);
  v += __shfl_xor(v, 2);
  v += __shfl_xor(v, 1);
  return v;
}
DEVI void ln_phase(const Params& p, const float* g, const float* b) {
  const int tidl = TIDX;
  const int wave = tidl >> 6, lane = tidl & 63;
  float* R = p.out;
  u16* X = (u16*)(p.ws + WS_X);
  float4 gg[4], bb[4];
#pragma unroll
  for (int i = 0; i < 4; ++i) {
    gg[i] = ((const float4*)g)[lane + 64 * i];
    bb[i] = ((const float4*)b)[lane + 64 * i];
  }
  for (int row = BIDX * 8 + wave; row < T_; row += gridDim.x * 8) {
    float4* rp = (float4*)(R + (size_t)row * 1024);
    float4 v[4];
#pragma unroll
    for (int i = 0; i < 4; ++i) v[i] = rp[lane + 64 * i];
    float s = 0.f;
#pragma unroll
    for (int i = 0; i < 4; ++i) s += v[i].x + v[i].y + v[i].z + v[i].w;
    const float mu = wave_sum(s) * (1.f / 1024.f);
    float q = 0.f;
#pragma unroll
    for (int i = 0; i < 4; ++i) {
      v[i].x -= mu; v[i].y -= mu; v[i].z -= mu; v[i].w -= mu;
      q += v[i].x * v[i].x + v[i].y * v[i].y + v[i].z * v[i].z + v[i].w * v[i].w;
    }
    const float rs = rsqrtf(wave_sum(q) * (1.f / 1024.f) + 1e-5f);
    uint2* xp = (uint2*)(X + (size_t)row * 1024);
#pragma unroll
    for (int i = 0; i < 4; ++i) {
      float4 o;
      o.x = v[i].x * rs * gg[i].x + bb[i].x;
      o.y = v[i].y * rs * gg[i].y + bb[i].y;
      o.z = v[i].z * rs * gg[i].z + bb[i].z;
      o.w = v[i].w * rs * gg[i].w + bb[i].w;
      rp[lane + 64 * i] = o;
      xp[lane + 64 * i] = make_uint2(pack2(o.x, o.y), pack2(o.z, o.w));
    }
  }
}

DEVI unsigned mono_key(float s) {
  unsigned u = __float_as_uint(s);
  return (u & 0x80000000u) ? ~u : (u | 0x80000000u);
}

DEVI void dsa_unit(const Params& p, const int u) {
  extern __shared__ __attribute__((aligned(16))) unsigned char smem[];
  const int tid = TIDX, lane = tid & 63, wave = __builtin_amdgcn_readfirstlane(tid >> 6);
  const int c = 255 - (u >> 3), b = (u >> 2) & 1, sub = u & 3;
  const int tok0 = b * S_ + c * 64 + sub * 16;
  const int N = (c + 1) * 64;
  const u16* proj = (const u16*)(p.ws + WS_Z);
  u16* Y = (u16*)(p.ws + WS_Y);
  float* cand_s = (float*)smem;
  u16* cand_i = (u16*)(smem + 49152);
  unsigned* h2 = (unsigned*)(smem + 73728);
  float* mem_s = (float*)(smem + 73728);
  unsigned* mem_i = (unsigned*)(smem + 73728 + 8192);
  unsigned* bm = (unsigned*)(smem + 90112);
  u16* sel = (u16*)(smem + 122880);
  int* candcnt = (int*)(smem + OFF_CNT);
  int* tbin = candcnt + 16;
  int* tb2a = candcnt + 32;
  int* base2 = candcnt + 48;
  int* mcnt = (int*)(smem + OFF_MISC);
  int* flag = mcnt + 16;
  float* iwl = (float*)(smem + OFF_IW);

  if (c < 4) {
    for (int i = tid; i < 16 * 256; i += 512) sel[i] = (u16)(i & 255);
    __syncthreads();
  } else {
   for (int rep_tk = 0; rep_tk < PROBE_TK; ++rep_tk) {
    if (tid < 128) iwl[tid] = bf2f(proj[(size_t)(tok0 + (tid >> 3)) * PW + C_IW + (tid & 7)]) * 0.17677669529663687f;
    __syncthreads();
    const int rho = lane & 31, hh = lane >> 5;
    bf16x8 af[4][2];
    h2_t sg[4][8];
#pragma unroll
    for (int rt = 0; rt < 4; ++rt) {
      const int qi = 4 * rt + 2 * (rho >> 4) + ((rho >> 2) & 1);
      const int hd = (rho & 3) + 4 * ((rho >> 3) & 1);
      const float w = iwl[qi * 8 + hd];
#pragma unroll
      for (int s = 0; s < 2; ++s) {
        const uint4 raw = *(const uint4*)(proj + (size_t)(tok0 + qi) * PW + C_IQ + hd * 32 + 16 * s + 8 * hh);
        af[rt][s] = mk8(pack2(bflo(raw.x) * w, bfhi(raw.x) * w), pack2(bflo(raw.y) * w, bfhi(raw.y) * w),
                        pack2(bflo(raw.z) * w, bfhi(raw.z) * w), pack2(bflo(raw.w) * w, bfhi(raw.w) * w));
      }
#pragma unroll
      for (int i = 0; i < 16; ++i) {
        const float w2 = iwl[(4 * rt + 2 * (i >> 3) + hh) * 8 + (i & 7)];
        sg[rt][i >> 1][i & 1] = (w2 > 0.f) ? (_Float16)1.0f : (_Float16)(-1.0f);
      }
    }
    bf16x8 al[2];
    {
      const int ii = (rho & 3) + 4 * (rho >> 3), gq = (rho >> 2) & 1;
      const int qi = 2 * (ii & 7) + gq, part = ii >> 3;
#pragma unroll
      for (int s = 0; s < 2; ++s) {
        float v[8];
#pragma unroll
        for (int j = 0; j < 8; ++j) v[j] = 0.f;
#pragma unroll
        for (int hd = 0; hd < 8; ++hd) {
          const float w = iwl[qi * 8 + hd];
          const uint4 raw = *(const uint4*)(proj + (size_t)(tok0 + qi) * PW + C_IQ + hd * 32 + 16 * s + 8 * hh);
          const unsigned r0 = pack2(bflo(raw.x) * w, bfhi(raw.x) * w), r1 = pack2(bflo(raw.y) * w, bfhi(raw.y) * w),
                         r2 = pack2(bflo(raw.z) * w, bfhi(raw.z) * w), r3 = pack2(bflo(raw.w) * w, bfhi(raw.w) * w);
          v[0] += bflo(r0); v[1] += bfhi(r0); v[2] += bflo(r1); v[3] += bfhi(r1);
          v[4] += bflo(r2); v[5] += bfhi(r2); v[6] += bflo(r3); v[7] += bfhi(r3);
        }
        unsigned hi[4];
#pragma unroll
        for (int j = 0; j < 4; ++j) hi[j] = pack2(v[2 * j], v[2 * j + 1]);
        if (part) {
#pragma unroll
          for (int j = 0; j < 4; ++j) hi[j] = pack2(v[2 * j] - bflo(hi[j]), v[2 * j + 1] - bfhi(hi[j]));
        }
        al[s] = mk8(hi[0], hi[1], hi[2], hi[3]);
      }
    }
    const int ntile = N >> 5;
    const u16* ikbase = (const u16*)(p.ws + WS_IKC) + (size_t)b * S_ * 32;
    const int ikoff = (lane & 31) * 32 + 8 * hh;
    for (int attempt = 0; attempt < 2; ++attempt) {
      const int ss = (attempt == 0 && N >= 4096) ? 8 : 1;
      const unsigned rank_t = (ss == 8) ? 64u : 256u;
      {
        uint4* h4 = (uint4*)smem;
        const uint4 z = make_uint4(0, 0, 0, 0);
        for (int i = tid; i < 131072 / 16; i += 512) h4[i] = z;
      }
      if (tid < 64) candcnt[tid] = 0;
      if (tid < 32) mcnt[tid] = 0;
      __syncthreads();
      float Lf[8];
#pragma unroll
      for (int i = 0; i < 8; ++i) Lf[i] = 0.f;
      for (int pass = 0; pass < 2; ++pass) {
        const int st = (pass == 0) ? ss : 1;
        if (pass == 1) {
#pragma unroll
          for (int i = 0; i < 8; ++i) {
            const unsigned k0 = (unsigned)tbin[2 * i + hh];
            Lf[i] = __uint_as_float((k0 & 0x80000000u) ? (k0 & 0x7fffffffu) : ~k0);
          }
        }
#define IK_LOAD(B0, B1, KT)                                        \
  do {                                                             \
    B0 = ld8(ikbase + (size_t)(KT) * 1024 + ikoff);                \
    B1 = ld8(ikbase + (size_t)(KT) * 1024 + ikoff + 16);           \
  } while (0)
#define SCORE2(RT, CB0, CB1, S0, S1)                                                                               \
  do {                                                                                                             \
    f32x16 acc = {};                                                                                               \
    acc = __builtin_amdgcn_mfma_f32_32x32x16_bf16(af[RT][0], CB0, acc, 0, 0, 0);                                   \
    acc = __builtin_amdgcn_mfma_f32_32x32x16_bf16(af[RT][1], CB1, acc, 0, 0, 0);                                   \
    S0 = la[2 * (RT)] + la[2 * (RT) + 8];                                                                          \
    S1 = la[2 * (RT) + 1] + la[2 * (RT) + 9];                                                                      \
    _Pragma("unroll") for (int i = 0; i < 8; ++i)                                                                  \
        S0 = __builtin_fmaf(__builtin_fabsf(acc[i]), (float)sg[RT][i >> 1][i & 1], S0);                           \
    _Pragma("unroll") for (int i = 8; i < 16; ++i)                                                                 \
        S1 = __builtin_fmaf(__builtin_fabsf(acc[i]), (float)sg[RT][i >> 1][i & 1], S1);                           \
  } while (0)
#define HIST1(SC, QI)                                                                                              \
  do {                                                                                                             \
    const int bin = (int)(mono_key(SC) >> 20);                                                                     \
    atomicAdd((unsigned*)smem + (QI) * 2048 + (bin >> 1), 1u << ((bin & 1) * 16));                                 \
  } while (0)
#define TILE_HIST(CB0, CB1, KT)                                                                                    \
  do {                                                                                                             \
    f32x16 la = {};                                                                                                \
    la = __builtin_amdgcn_mfma_f32_32x32x16_bf16(al[0], CB0, la, 0, 0, 0);                                         \
    la = __builtin_amdgcn_mfma_f32_32x32x16_bf16(al[1], CB1, la, 0, 0, 0);                                         \
    _Pragma("unroll") for (int rt = 0; rt < 4; ++rt) {                                                             \
      float s0, s1;                                                                                                \
      SCORE2(rt, CB0, CB1, s0, s1);                                                                                \
      HIST1(s0, 4 * rt + hh);                                                                                      \
      HIST1(s1, 4 * rt + 2 + hh);                                                                                  \
    }                                                                                                              \
  } while (0)
#define TILE_COLLECT(CB0, CB1, KT)                                                                                 \
  do {                                                                                                             \
    const int key = (KT) * 32 + (lane & 31);                                                                       \
    f32x16 la = {};                                                                                                \
    la = __builtin_amdgcn_mfma_f32_32x32x16_bf16(al[0], CB0, la, 0, 0, 0);                                         \
    la = __builtin_amdgcn_mfma_f32_32x32x16_bf16(al[1], CB1, la, 0, 0, 0);                                         \
    _Pragma("unroll") for (int rp = 0; rp < 2; ++rp) {                                                             \
      float sa, sb, sc_, sd;                                                                                       \
      SCORE2(2 * rp, CB0, CB1, sa, sb);                                                                            \
      SCORE2(2 * rp + 1, CB0, CB1, sc_, sd);                                                                       \
      const int qa = 8 * rp + hh;                                                                                  \
      const bool pa = sa >= Lf[4 * rp], pb = sb >= Lf[4 * rp + 1], pc = sc_ >= Lf[4 * rp + 2], pd = sd >= Lf[4 * rp + 3]; \
      int oa = 0, ob = 0, oc = 0, od = 0;                                                                          \
      if (pa) oa = atomicAdd(&candcnt[qa], 1);                                                                     \
      if (pb) ob = atomicAdd(&candcnt[qa + 2], 1);                                                                 \
      if (pc) oc = atomicAdd(&candcnt[qa + 4], 1);                                                                 \
      if (pd) od = atomicAdd(&candcnt[qa + 6], 1);                                                                 \
      if (pa && oa < CAND_CAP) { cand_s[qa * CAND_CAP + oa] = sa; cand_i[qa * CAND_CAP + oa] = (u16)key; }         \
      if (pb && ob < CAND_CAP) { cand_s[(qa + 2) * CAND_CAP + ob] = sb; cand_i[(qa + 2) * CAND_CAP + ob] = (u16)key; } \
      if (pc && oc < CAND_CAP) { cand_s[(qa + 4) * CAND_CAP + oc] = sc_; cand_i[(qa + 4) * CAND_CAP + oc] = (u16)key; } \
      if (pd && od < CAND_CAP) { cand_s[(qa + 6) * CAND_CAP + od] = sd; cand_i[(qa + 6) * CAND_CAP + od] = (u16)key; } \
    }                                                                                                              \
  } while (0)
#define PIPE3(BODY)                                                                                                \
  do {                                                                                                             \
    int kt = wave * st;                                                                                            \
    const int step = 8 * st;                                                                                       \
    bf16x8 fa0 = {}, fa1 = {}, fb0 = {}, fb1 = {}, fc0 = {}, fc1 = {};                                             \
    const int ktl = ntile - 1;    \
    IK_LOAD(fa0, fa1, min(kt, ktl));                                                                               \
    IK_LOAD(fb0, fb1, min(kt + step, ktl));                                                                        \
    while (kt < ntile) {                                                                                           \
      IK_LOAD(fc0, fc1, min(kt + 2 * step, ktl));                                                                  \
      BODY(fa0, fa1, kt);                                                                                          \
      kt += step;                                                                                                  \
      if (kt >= ntile) break;                                                                                      \
      IK_LOAD(fa0, fa1, min(kt + 2 * step, ktl));                                                                  \
      BODY(fb0, fb1, kt);                                                                                          \
      kt += step;                                                                                                  \
      if (kt >= ntile) break;                                                                                      \
      IK_LOAD(fb0, fb1, min(kt + 2 * step, ktl));                                                                  \
      BODY(fc0, fc1, kt);                                                                                          \
      kt += step;                                                                                                  \
    }                                                                                                              \
  } while (0)
        if (pass == 0) PIPE3(TILE_HIST);
        else PIPE3(TILE_COLLECT);
#undef IK_LOAD
#undef SCORE2
#undef HIST1
#undef TILE_HIST
#undef TILE_COLLECT
#undef PIPE3
        __syncthreads();
        if (pass == 0) {
          const int qi = tid >> 5, seg = tid & 31;
          const unsigned* hq = (const unsigned*)smem + qi * 2048 + seg * 64;
          unsigned part = 0;
          for (int w = 0; w < 64; ++w) {
            const unsigned x = hq[(w + seg) & 63];
            part += (x & 0xffffu) + (x >> 16);
          }
          unsigned incl = part;
#pragma unroll
          for (int d = 1; d < 32; d <<= 1) {
            const unsigned o = __shfl_down(incl, d, 32);
            if (seg + d < 32) incl += o;
          }
          const unsigned above = incl - part;
          int mytb = -1;
          unsigned mykey = 0u;
          if (above < rank_t && incl >= rank_t) {
            unsigned cum = above, cb_ = 1u;
            for (int w = 63; w >= 0; --w) {
              const unsigned x = hq[w];
              const unsigned chi = x >> 16, clo = x & 0xffffu;
              if (cum + chi >= rank_t) { mytb = seg * 128 + 2 * w + 1; cb_ = chi; break; }
              cum += chi;
              if (cum + clo >= rank_t) { mytb = seg * 128 + 2 * w; cb_ = clo; break; }
              cum += clo;
            }
            unsigned sub = 0u;
            if (ss == 8) {
              const float ft = (float)(rank_t - cum) / (float)cb_;
              sub = (unsigned)fminf((1.f - ft) * 1048576.f, 1048575.f);
            }
            mykey = (((unsigned)mytb) << 20) + sub;
          }
          __syncthreads();
          {
            uint4* bz = (uint4*)(smem + 73728);
            for (int i = tid; i < 3072; i += 512) bz[i] = make_uint4(0, 0, 0, 0);
          }
          if (mytb >= 0) tbin[qi] = (int)mykey;
          __syncthreads();
        }
      }
      if (tid < 16) {
        const int cc = candcnt[tid];
        if (cc < 256 || cc > CAND_CAP) atomicOr((unsigned*)flag, 1u);
      }
      __syncthreads();
      const int bad = *(volatile int*)flag;
      __syncthreads();
      if (!bad) break;
    }
    {
      const int qi = tid >> 5, seg = tid & 31;
      const int C = min(candcnt[qi], CAND_CAP);
      unsigned prefix = 0u;
      unsigned kneed = 256u;
      const bool few = (C < 256);
#pragma unroll 1
      for (int d = 3; d >= 0; --d) {
        const int shift = 8 * d;
#pragma unroll
        for (int w = 0; w < 8; ++w) h2[qi * 256 + seg * 8 + w] = 0u;
        __syncthreads();
        for (int e = seg; e < C; e += 32) {
          const unsigned key = mono_key(cand_s[qi * CAND_CAP + e]);
          const bool match = (d == 3) || ((key >> (shift + 8)) == (prefix >> (shift + 8)));
          if (match) atomicAdd(&h2[qi * 256 + ((key >> shift) & 255u)], 1u);
        }
        __syncthreads();
        unsigned cnt8[8];
        unsigned part = 0;
#pragma unroll
        for (int w = 0; w < 8; ++w) {
          cnt8[w] = h2[qi * 256 + seg * 8 + w];
          part += cnt8[w];
        }
        unsigned incl = part;
#pragma unroll
        for (int dd = 1; dd < 32; dd <<= 1) {
          const unsigned o = __shfl_down(incl, dd, 32);
          if (seg + dd < 32) incl += o;
        }
        const unsigned above = incl - part;
        if (above < kneed && incl >= kneed) {
          unsigned cum = above;
          int t2 = -1;
#pragma unroll
          for (int w = 7; w >= 0; --w) {
            if (t2 < 0) {
              if (cum + cnt8[w] >= kneed) t2 = seg * 8 + w;
              else cum += cnt8[w];
            }
          }
          tb2a[qi] = t2;
          base2[qi] = (int)cum;
        }
        __syncthreads();
        if (!few) {
          prefix |= ((unsigned)tb2a[qi]) << shift;
          kneed -= (unsigned)base2[qi];
        }
      }
      for (int e = seg; e < C; e += 32) {
        const float s = cand_s[qi * CAND_CAP + e];
        const unsigned id = cand_i[qi * CAND_CAP + e];
        const unsigned key = mono_key(s);
        if (few || key > prefix) atomicOr(&bm[qi * 512 + (id >> 5)], 1u << (id & 31));
        else if (key == prefix) {
          const int pos = atomicAdd(&mcnt[qi], 1);
          if (pos < 128) { mem_s[qi * 128 + pos] = s; mem_i[qi * 128 + pos] = id; }
        }
      }
      __syncthreads();
      const int M = min(mcnt[qi], 128);
      const int need = (int)kneed;
      for (int e = seg; e < M; e += 32) {
        const unsigned id = mem_i[qi * 128 + e];
        int rank = 0;
        for (int f = 0; f < M; ++f) rank += (mem_i[qi * 128 + f] < id) ? 1 : 0;
        if (rank < need) atomicOr(&bm[qi * 512 + (id >> 5)], 1u << (id & 31));
      }
      __syncthreads();
      const unsigned* bq = bm + qi * 512 + seg * 16;
      int cnt = 0;
#pragma unroll
      for (int w = 0; w < 16; ++w) cnt += __popc(bq[w]);
      int inc2 = cnt;
#pragma unroll
      for (int d = 1; d < 32; d <<= 1) {
        const int o = __shfl_up(inc2, d, 32);
        if (seg >= d) inc2 += o;
      }
      int pos = inc2 - cnt;
      for (int w = 0; w < 16; ++w) {
        unsigned x = bq[w];
        while (x) {
          const int bit = __ffs(x) - 1;
          x &= x - 1;
          if (pos < 256) sel[qi * 256 + pos] = (u16)((seg * 16 + w) * 32 + bit);
          ++pos;
        }
      }
      if (seg == 31) {
        for (int q2 = pos; q2 < 256; ++q2) sel[qi * 256 + q2] = 0;
      }
    }
    __syncthreads();
   }
  }

  {
    const int n = (N < 256) ? N : 256;
    const int nt16 = n >> 4;
    const int hc = lane & 15, g4 = lane >> 4;
    u16* Vs = (u16*)(smem + wave * 9216);
    const float sc2 = 0.125f * LOG2E_;
    for (int e2 = 0; e2 < 2 * PROBE_AT; ++e2) {
      const int e = e2 & 1;
      const int qq = wave * 2 + e;
      const size_t tok = (size_t)tok0 + qq;
      bf16x8 qf[2];
#pragma unroll
      for (int s = 0; s < 2; ++s) {
        bf16x8 z = {};
        qf[s] = (hc < 6) ? ld8(proj + tok * PW + C_DQ + hc * 64 + 32 * s + 8 * g4) : z;
      }
      f32x4 st[16];
#pragma unroll
      for (int kt = 0; kt < 16; ++kt) {
        if (kt < nt16) {
          const int key = sel[qq * 256 + kt * 16 + hc] & 16383;
          const u16* kp = (const u16*)(p.ws + WS_DKC) + (size_t)(b * S_ + key) * 64 + 8 * g4;
          const bf16x8 a0 = ld8(kp), a1 = ld8(kp + 32);
          f32x4 a = {};
          a = __builtin_amdgcn_mfma_f32_16x16x32_bf16(a0, qf[0], a, 0, 0, 0);
          a = __builtin_amdgcn_mfma_f32_16x16x32_bf16(a1, qf[1], a, 0, 0, 0);
          st[kt] = a;
        } else {
          const float ninf = -__builtin_inff();
          st[kt] = f32x4{ninf, ninf, ninf, ninf};
        }
      }
      float mx = -__builtin_inff();
#pragma unroll
      for (int kt = 0; kt < 16; ++kt)
#pragma unroll
        for (int i = 0; i < 4; ++i) mx = fmaxf(mx, st[kt][i]);
      mx = fmaxf(mx, __shfl_xor(mx, 16));
      mx = fmaxf(mx, __shfl_xor(mx, 32));
      float ls = 0.f;
#pragma unroll
      for (int kt = 0; kt < 16; ++kt)
#pragma unroll
        for (int i = 0; i < 4; ++i) {
          const float pv = __builtin_amdgcn_exp2f((st[kt][i] - mx) * sc2);
          st[kt][i] = pv;
          ls += pv;
        }
      ls += __shfl_xor(ls, 16);
      ls += __shfl_xor(ls, 32);
      f32x4 o[4] = {};
#pragma unroll
      for (int ch = 0; ch < 4; ++ch) {
        if (ch * 64 < n) {
#pragma unroll
          for (int it = 0; it < 8; ++it) {
            const int slot = ch * 64 + it * 8 + (lane >> 3);
            const int key = sel[qq * 256 + slot] & 16383;
            const uint4 v = *(const uint4*)((const u16*)(p.ws + WS_DVC) + (size_t)(b * S_ + key) * 64 + 8 * (lane & 7));
            *(uint4*)(Vs + (it * 8 + (lane >> 3)) * 72 + 8 * (lane & 7)) = v;
          }
          asm volatile("s_waitcnt lgkmcnt(0)" ::: "memory");
#pragma unroll
          for (int tt = 0; tt < 2; ++tt) {
            const int t2 = (ch * 2 + tt) * 2;
            const bf16x8 pb = mk8(pack2(st[t2][0], st[t2][1]), pack2(st[t2][2], st[t2][3]),
                                  pack2(st[t2 + 1][0], st[t2 + 1][1]), pack2(st[t2 + 1][2], st[t2 + 1][3]));
#pragma unroll
            for (int dt = 0; dt < 4; ++dt) {
              bf16x8 va;
#pragma unroll
              for (int j = 0; j < 8; ++j)
                va[j] = (short)Vs[(32 * tt + 16 * (j >> 2) + 4 * g4 + (j & 3)) * 72 + 16 * dt + hc];
              o[dt] = __builtin_amdgcn_mfma_f32_16x16x32_bf16(va, pb, o[dt], 0, 0, 0);
            }
          }
          asm volatile("s_waitcnt lgkmcnt(0)" ::: "memory");
        }
      }
      const float inv = 1.f / ls;
      if (hc < 6) {
#pragma unroll
        for (int dt = 0; dt < 4; ++dt) {
          uint2 w2 = make_uint2(pack2(o[dt][0] * inv, o[dt][1] * inv), pack2(o[dt][2] * inv, o[dt][3] * inv));
          *(uint2*)(Y + tok * 1024 + 256 + hc * 64 + 16 * dt + 4 * g4) = w2;
        }
      }
    }
  }
  __syncthreads();
}

DEVI void band_unit(const Params& p, const int U) {
  extern __shared__ __attribute__((aligned(16))) unsigned char smem[];
  const int tid = TIDX, lane = tid & 63, wave = tid >> 6;
  const int wu = U * 8 + wave;
  const int qh = wu & 1, h = (wu >> 1) % 6, bc = wu / 12, c = bc & 255, b = bc >> 8;
  const int r = lane & 31, g = lane >> 5;
  const u16* proj = (const u16*)(p.ws + WS_Z);
  const u16* Vt = (const u16*)(p.ws + WS_VT);
  u16* Y = (u16*)(p.ws + WS_Y);
  const float* rb = (const float*)(smem + OFF_RB) + h * 192;
  const size_t tokq = (size_t)b * S_ + c * 64 + qh * 32 + r;
  bf16x8 qf[4];
#pragma unroll
  for (int s = 0; s < 4; ++s) qf[s] = ld8(proj + tokq * PW + C_CQ + h * 64 + 16 * s + 8 * g);
  const int c0 = (c >= 8) ? (c - 8) : 0;
  const int kt0 = c0 * 2, kt1 = (c + 1) * 2;
  const int pr = (r & 16) | ((r & 4) << 1) | ((r & 8) >> 1) | (r & 3);
  const int qpos = c * 64 + qh * 32 + r;
  const float SC2 = 0.125f * LOG2E_;
  f32x16 o0 = {}, o1 = {};
  float m = -1e30f, ls = 0.f;
  for (int kt = kt0; kt < kt1; ++kt) {
    const u16* kp = proj + (size_t)(b * S_ + kt * 32 + pr) * PW + C_CK + h * 64 + 8 * g;
    const bf16x8 k0 = ld8(kp), k1 = ld8(kp + 16), k2 = ld8(kp + 32), k3 = ld8(kp + 48);
    const u16* vp = Vt + (size_t)(h * 64 + r) * T_ + (size_t)b * S_ + kt * 32 + 8 * g;
    const bf16x8 v00 = ld8(vp), v01 = ld8(vp + 16), v10 = ld8(vp + (size_t)32 * T_), v11 = ld8(vp + (size_t)32 * T_ + 16);
    f32x16 s = {};
    s = __builtin_amdgcn_mfma_f32_32x32x16_bf16(k0, qf[0], s, 0, 0, 0);
    s = __builtin_amdgcn_mfma_f32_32x32x16_bf16(k1, qf[1], s, 0, 0, 0);
    s = __builtin_amdgcn_mfma_f32_32x32x16_bf16(k2, qf[2], s, 0, 0, 0);
    s = __builtin_amdgcn_mfma_f32_32x32x16_bf16(k3, qf[3], s, 0, 0, 0);
    float tm = -1e30f;
    const int kb = kt * 32 + 8 * g;
#pragma unroll
    for (int i = 0; i < 16; ++i) {
      int rel = qpos - (kb + 16 * (i >> 3) + (i & 7));
      rel = min(max(rel, -63), 128) + 63;
      const float v = s[i] * SC2 + rb[rel];
      s[i] = v;
      tm = fmaxf(tm, v);
    }
    tm = fmaxf(tm, __shfl_xor(tm, 32));
    const float mn = fmaxf(m, tm);
    const float al = __builtin_amdgcn_exp2f(m - mn);
    m = mn;
    float psum = 0.f;
#pragma unroll
    for (int i = 0; i < 16; ++i) {
      const float pv = __builtin_amdgcn_exp2f(s[i] - mn);
      s[i] = pv;
      psum += pv;
    }
    ls = ls * al + psum;
#pragma unroll
    for (int i = 0; i < 16; ++i) {
      o0[i] *= al;
      o1[i] *= al;
    }
    const bf16x8 pb0 = mk8(pack2(s[0], s[1]), pack2(s[2], s[3]), pack2(s[4], s[5]), pack2(s[6], s[7]));
    const bf16x8 pb1 = mk8(pack2(s[8], s[9]), pack2(s[10], s[11]), pack2(s[12], s[13]), pack2(s[14], s[15]));
    o0 = __builtin_amdgcn_mfma_f32_32x32x16_bf16(v00, pb0, o0, 0, 0, 0);
    o0 = __builtin_amdgcn_mfma_f32_32x32x16_bf16(v01, pb1, o0, 0, 0, 0);
    o1 = __builtin_amdgcn_mfma_f32_32x32x16_bf16(v10, pb0, o1, 0, 0, 0);
    o1 = __builtin_amdgcn_mfma_f32_32x32x16_bf16(v11, pb1, o1, 0, 0, 0);
  }
  ls += __shfl_xor(ls, 32);
  const float inv = 1.f / ls;
  u16* yp = Y + tokq * 1024 + 640 + h * 64 + 4 * g;
#pragma unroll
  for (int i4 = 0; i4 < 4; ++i4) {
    *(uint2*)(yp + 8 * i4) = make_uint2(pack2(o0[4 * i4] * inv, o0[4 * i4 + 1] * inv), pack2(o0[4 * i4 + 2] * inv, o0[4 * i4 + 3] * inv));
    *(uint2*)(yp + 32 + 8 * i4) = make_uint2(pack2(o1[4 * i4] * inv, o1[4 * i4 + 1] * inv), pack2(o1[4 * i4 + 2] * inv, o1[4 * i4 + 3] * inv));
  }
}

DEVI void conv_unit(const Params& p, const int l, const int U) {
  const u16* proj = (const u16*)(p.ws + WS_Z);
  u16* Y = (u16*)(p.ws + WS_Y);
  const float* cw = p.in[4] + (size_t)l * 3 * 256;
#pragma unroll 1
  for (int it = 0; it < 8; ++it) {
    const int item = TIDX + 512 * it;
    const int tok = U * 128 + (item >> 5), cg8 = (item & 31) * 8;
    const int s = tok & (S_ - 1);
    const uint4 cb = *(const uint4*)(proj + (size_t)tok * PW + C_CB + cg8);
    float acc[8];
#pragma unroll
    for (int e = 0; e < 8; ++e) acc[e] = 0.f;
#pragma unroll
    for (int j = 0; j < 3; ++j) {
      const int dt = 2 - j;
      if (s - dt >= 0) {
        const uint4 cc = *(const uint4*)(proj + (size_t)(tok - dt) * PW + C_CC + cg8);
        const uint4 ch = *(const uint4*)(proj + (size_t)(tok - dt) * PW + C_CH + cg8);
        const float4 w0 = *(const float4*)(cw + j * 256 + cg8);
        const float4 w1 = *(const float4*)(cw + j * 256 + cg8 + 4);
        acc[0] += w0.x * bflo(cc.x) * bflo(ch.x);
        acc[1] += w0.y * bfhi(cc.x) * bfhi(ch.x);
        acc[2] += w0.z * bflo(cc.y) * bflo(ch.y);
        acc[3] += w0.w * bfhi(cc.y) * bfhi(ch.y);
        acc[4] += w1.x * bflo(cc.z) * bflo(ch.z);
        acc[5] += w1.y * bfhi(cc.z) * bfhi(ch.z);
        acc[6] += w1.z * bflo(cc.w) * bflo(ch.w);
        acc[7] += w1.w * bfhi(cc.w) * bfhi(ch.w);
      }
    }
    uint4 o;
    o.x = pack2(bflo(cb.x) * acc[0], bfhi(cb.x) * acc[1]);
    o.y = pack2(bflo(cb.y) * acc[2], bfhi(cb.y) * acc[3]);
    o.z = pack2(bflo(cb.z) * acc[4], bfhi(cb.z) * acc[5]);
    o.w = pack2(bflo(cb.w) * acc[6], bfhi(cb.w) * acc[7]);
    *(uint4*)(Y + (size_t)tok * 1024 + cg8) = o;
  }
}

DEVI void memkv_unit(const Params& p, const int u) {
  const u16* WT = (const u16*)(p.ws + WS_WT);
  const u16* Mb = (const u16*)(p.ws + WS_MB);
  Sched S{};
  S.nM = 1; S.nN = 1; S.G = 1; S.c = 0;
  if (u < 8) {
    const int pm = u >> 2, pn = u & 3;
    S.A = (const char*)(Mb + (size_t)pm * 256 * 1024);
    S.B = (const char*)(WT + WT_KV + (size_t)pn * 256 * 1024);
    EpiStore16<0> E{(u16*)(p.ws + WS_KM) + (size_t)pm * 256 * 1024 + pn * 256, 1024};
    gemm_phase(1024, 1024, 1024, S, E);
  } else {
    const int v = u - 8, pm = v >> 1, pn = v & 1;
    S.A = (const char*)(WT + WT_KV + (size_t)(1024 + pm * 256) * 1024);
    S.B = (const char*)(Mb + (size_t)pn * 256 * 1024);
    EpiStore16<0> E{(u16*)(p.ws + WS_VTM) + (size_t)pm * 256 * 512 + pn * 256, 512};
    gemm_phase(1024, 1024, 1024, S, E);
  }
}

constexpr int NU_KV = 16, NU_DSA = 2048, NU_BAND = 768, NU_CONV = 256;
DEVI void phase_mixer(const Params& p, const int l) {
  extern __shared__ __attribute__((aligned(16))) unsigned char smem[];
  const int tid = TIDX;
  float* rb = (float*)(smem + OFF_RB);
  for (int i = tid; i < 6 * 192; i += 512) rb[i] = p.in[5][(size_t)l * 6 * 192 + i] * LOG2E_;
  const int G = (int)gridDim.x, bid = BIDX;
  __syncthreads();
  if (bid >= G - NU_KV) memkv_unit(p, bid - (G - NU_KV));
  const int NU = NU_DSA + NU_BAND + NU_CONV;
  for (int rnd = 0;; ++rnd) {
    const int base = rnd * G;
    if (base >= NU) break;
    const int u = base + ((rnd & 1) ? (G - 1 - bid) : bid);
    if (u < NU) {
      if (u < NU_DSA) dsa_unit(p, u);
      else if (u < NU_DSA + NU_BAND) { for (int rb_ = 0; rb_ < PROBE_BD; ++rb_) band_unit(p, u - NU_DSA); }
      else conv_unit(p, l, u - NU_DSA - NU_BAND);
    }
    __syncthreads();
  }
}

DEVI Sched mk_sched(const void* A, const void* B, size_t aStepM, size_t bStepN, int nM, int nN) {
  Sched S{};
  S.A = (const char*)A; S.B = (const char*)B;
  S.aStepM = aStepM; S.aStepN = 0; S.bStepN = bStepN; S.bStepB = 0;
  S.nM = nM; S.nN = nN; S.G = (int)gridDim.x; S.c = BIDX;
  return S;
}
DEVI void phase_inproj(const Params& p) {
  const u16* X = (const u16*)(p.ws + WS_X);
  const u16* WT = (const u16*)(p.ws + WS_WT) + WT_IN;
  {
    const Sched S = mk_sched(X, WT, 256 * 1024 * 2, 256 * 1024 * 2, 128, 10);
    EpiProj E{(u16*)(p.ws + WS_Z), (const float*)(p.ws + WS_ROPED), (const float*)(p.ws + WS_ROPEI), (u16*)(p.ws + WS_IKC),
              (u16*)(p.ws + WS_DKC), (u16*)(p.ws + WS_DVC)};
    gemm_phase(1024, 1024, 1024, S, E);
  }
  {
    const Sched S = mk_sched(WT + (size_t)2560 * 1024, X, 256 * 1024 * 2, 256 * 1024 * 2, 2, 128);
    EpiStore16<0> E{(u16*)(p.ws + WS_VT), T_};
    gemm_phase(1024, 1024, 1024, S, E);
  }
}
DEVI void phase_gemm_res(const Params& p, const int which) {
  const u16* A = (const u16*)(p.ws + (which == 0 ? WS_Y : (which == 1 ? WS_O : WS_H)));
  const u16* W = (const u16*)(p.ws + WS_WT) + (which == 0 ? WT_OUT : (which == 1 ? WT_MO : WT_FF2));
  const int K = (which == 2) ? 4096 : 1024;
  const Sched S = mk_sched(A, W, (size_t)256 * K * 2, (size_t)256 * K * 2, 128, 4);
  EpiRes E{p.out};
  gemm_phase(K, K, K, S, E);
}
DEVI void phase_gemm_q(const Params& p) {
  const Sched S = mk_sched(p.ws + WS_X, (const u16*)(p.ws + WS_WT) + WT_MQ, 256 * 1024 * 2, 256 * 1024 * 2, 128, 4);
  EpiStore16<0> E{(u16*)(p.ws + WS_Q), 1024};
  gemm_phase(1024, 1024, 1024, S, E);
}
DEVI void phase_gemm_s(const Params& p) {
  Sched S = mk_sched(p.ws + WS_Q, p.ws + WS_KM, 256 * 1024 * 2, 256 * 2, 128, 4);
  S.aStepN = 256 * 2;
  S.bStepB = 256 * 1024 * 2;
  EpiSoftmax E{(u16*)(p.ws + WS_P)};
  gemm_phase(1024, 1024, 256, S, E);
}
DEVI void phase_gemm_pv(const Params& p) {
  Sched S = mk_sched(p.ws + WS_P, p.ws + WS_VTM, 256 * 1024 * 2, 256 * 512 * 2, 128, 4);
  S.aStepN = 256 * 2;
  S.bStepB = 256 * 2;
  EpiStore16<0> E{(u16*)(p.ws + WS_O), 1024};
  gemm_phase(1024, 512, 256, S, E);
}
DEVI void phase_gemm_ff1(const Params& p) {
  const Sched S = mk_sched(p.ws + WS_X, (const u16*)(p.ws + WS_WT) + WT_FF1, 256 * 1024 * 2, 256 * 1024 * 2, 128, 16);
  EpiStore16<1> E{(u16*)(p.ws + WS_H), 4096};
  gemm_phase(1024, 1024, 1024, S, E);
}

#define XB_TMO      128
#define XB_XCNT(j)  (256  + 64 * (j))
#define XB_XSUB(j)  (1280 + 64 * (j))
#define XB_XGEN(j)  (2304 + 64 * (j))
#define XB_TOP      3328
#define XB_TOPGEN   3392
#define XCD_BAR_WORDS 3456
#define XB_SPIN_CAP (1u << 18)
DEVI unsigned xb_ld(unsigned* p) { return __hip_atomic_load(p, __ATOMIC_RELAXED, __HIP_MEMORY_SCOPE_AGENT); }
DEVI unsigned xb_add(unsigned* p, unsigned v) { return __hip_atomic_fetch_add(p, v, __ATOMIC_RELAXED, __HIP_MEMORY_SCOPE_AGENT); }
DEVI unsigned xb_xcc_id() { return (unsigned)__builtin_amdgcn_s_getreg((3 << 11) | 20) & 0xFu; }
#define XB_SPIN(cond, bar) do { unsigned _sp = 0; while (cond) { __builtin_amdgcn_s_sleep(1); \
    if ((++_sp & 255u) == 0u) { if (xb_ld(&(bar)[XB_TMO])) break; if (_sp > XB_SPIN_CAP) { atomicAdd(&(bar)[XB_TMO], 1u); break; } } } } while (0)
struct XcdBarrier { unsigned* bar; unsigned x; volatile LAS unsigned* st; };
DEVI XcdBarrier xcd_barrier_post(unsigned* bar, volatile LAS unsigned* st) {
  XcdBarrier b; b.bar = bar; b.x = xb_xcc_id(); b.st = st;
  if (threadIdx.x == 0) (void)xb_add(&bar[XB_XCNT(b.x)], 1u);
  return b;
}
DEVI void xcd_barrier_complete(unsigned* bar, unsigned x, unsigned& nloc, unsigned& nx) {
  const unsigned G = gridDim.x * gridDim.y * gridDim.z;
  unsigned sum, cnt, mine, sp = 0u;
  for (;;) {
    sum = 0u; cnt = 0u; mine = 0u;
#pragma unroll
    for (unsigned j = 0; j < 16; ++j) { const unsigned c = xb_ld(&bar[XB_XCNT(j)]); sum += c; cnt += (c > 0u) ? 1u : 0u; mine = (j == x) ? c : mine; }
    if (sum == G) break;
    __builtin_amdgcn_s_sleep(1);
    if ((++sp & 255u) == 0u) { if (xb_ld(&bar[XB_TMO])) break; if (sp > XB_SPIN_CAP) { atomicAdd(&bar[XB_TMO], 1u); break; } }
  }
  nloc = mine > 0u ? mine : 1u; nx = cnt > 0u ? cnt : 1u;
}
DEVI void xcd_barrier(const XcdBarrier& b) {
  asm volatile("s_waitcnt vmcnt(0)" ::: "memory");
  __syncthreads();
  if (threadIdx.x == 0) {
    unsigned* bar = b.bar;
    __builtin_amdgcn_s_waitcnt(0);
    unsigned nloc = b.st[0], nx = b.st[1];
    if (nloc == 0u) { xcd_barrier_complete(bar, b.x, nloc, nx); b.st[0] = nloc; b.st[1] = nx; }
    const unsigned old = xb_add(&bar[XB_XSUB(b.x)], 1u);
    const unsigned gen = old / nloc;
    if (old + 1u == (gen + 1u) * nloc) {
      __builtin_amdgcn_fence(__ATOMIC_RELEASE, "agent");
      asm volatile("s_waitcnt vmcnt(0)" ::: "memory");
      const unsigned og = xb_add(&bar[XB_TOP], 1u);
      const unsigned tg = og / nx;
      if (og + 1u == (tg + 1u) * nx) xb_add(&bar[XB_TOPGEN], 1u);
      else XB_SPIN(xb_ld(&bar[XB_TOPGEN]) == tg, bar);
      __builtin_amdgcn_fence(__ATOMIC_ACQUIRE, "agent");
      xb_add(&bar[XB_XGEN(b.x)], 1u);
      asm volatile("s_waitcnt vmcnt(0)" ::: "memory");
    } else {
      XB_SPIN(xb_ld(&bar[XB_XGEN(b.x)]) == gen, bar);
      __builtin_amdgcn_fence(__ATOMIC_ACQUIRE, "agent");
      asm volatile("s_waitcnt vmcnt(0)" ::: "memory");
    }
  }
  __syncthreads();
}

DEVI void grid_seam(cg::grid_group& grid) {
  asm volatile("s_waitcnt vmcnt(0) lgkmcnt(0)" ::: "memory");
  __builtin_amdgcn_fence(__ATOMIC_RELEASE, "agent");
  asm volatile("s_waitcnt vmcnt(0)" ::: "memory");
  grid.sync();
  __builtin_amdgcn_fence(__ATOMIC_ACQUIRE, "agent");
  asm volatile("s_waitcnt vmcnt(0)" ::: "memory");
  __builtin_amdgcn_fence(__ATOMIC_RELEASE, "agent");
  asm volatile("s_waitcnt vmcnt(0)" ::: "memory");
  grid.sync();
  __builtin_amdgcn_fence(__ATOMIC_ACQUIRE, "agent");
  asm volatile("s_waitcnt vmcnt(0)" ::: "memory");
}
#define PHASE(stmt)                  \
  do {                               \
    Params q = p;                    \
    const int _z = opaque_s(0);      \
    q.ws = p.ws + _z;                \
    q.out = p.out + _z;              \
    stmt;                            \
  } while (0)
__global__ void __launch_bounds__(512, 2) mega(Params p) {
  cg::grid_group grid = cg::this_grid();
  extern __shared__ __attribute__((aligned(16))) unsigned char smem[];
  volatile LAS unsigned* xst = (volatile LAS unsigned*)((LAS unsigned char*)smem + OFF_XB);
  if (threadIdx.x < 4) xst[threadIdx.x] = 0u;
  __syncthreads();
  const XcdBarrier xb = xcd_barrier_post((unsigned*)(p.ws + WS_BAR), xst);
  PHASE(phase0(q));
  PHASE(convert_weights(q, 0));
  grid_seam(grid);
#pragma unroll 1
  for (int l = 0; l < NL_; ++l) {
    PHASE(phase_inproj(q));
    xcd_barrier(xb);
    PHASE(phase_mixer(q, l));
    xcd_barrier(xb);
    PHASE(phase_gemm_res(q, 0));
    xcd_barrier(xb);
    PHASE(ln_phase(q, q.in[7] + l * 1024, q.in[8] + l * 1024));
    xcd_barrier(xb);
    PHASE(phase_gemm_q(q));
    xcd_barrier(xb);
    PHASE(phase_gemm_s(q));
    xcd_barrier(xb);
    PHASE(phase_gemm_pv(q));
    xcd_barrier(xb);
    PHASE(phase_gemm_res(q, 1));
    xcd_barrier(xb);
    PHASE(ln_phase(q, q.in[12] + l * 1024, q.in[13] + l * 1024));
    xcd_barrier(xb);
    PHASE(phase_gemm_ff1(q));
    xcd_barrier(xb);
    PHASE(phase_gemm_res(q, 2));
    xcd_barrier(xb);
    PHASE(ln_phase(q, q.in[16] + l * 1024, q.in[17] + l * 1024));
    if (l + 1 < NL_) PHASE(convert_weights(q, l + 1));
    xcd_barrier(xb);
  }
}

extern "C" void kernel_launch(void* const* d_in, const int* in_sizes, int n_in, void* d_out, int out_size, void* d_ws,
                              size_t ws_size, hipStream_t stream) {
  static int grid_blocks = 0;
  if (grid_blocks == 0) {
    if (n_in != 18 || ws_size < WS_END) {
      fprintf(stderr, "kernel_launch: unexpected n_in %d or ws_size %zu (need %zu)\n", n_in, ws_size, (size_t)WS_END);
      grid_blocks = -1;
      return;
    }
    int dev = 0, cus = 0, per_cu = 0;
    hipGetDevice(&dev);
    hipDeviceGetAttribute(&cus, hipDeviceAttributeMultiprocessorCount, dev);
    if (hipFuncSetAttribute((const void*)mega, hipFuncAttributeMaxDynamicSharedMemorySize, LDS_BYTES) != hipSuccess)
      fprintf(stderr, "kernel_launch: hipFuncSetAttribute failed\n");
    if (hipOccupancyMaxActiveBlocksPerMultiprocessor(&per_cu, (const void*)mega, 512, LDS_BYTES) != hipSuccess || per_cu < 1)
      per_cu = 1;
    (void)hipGetLastError();
    grid_blocks = cus * per_cu;
  }
  if (grid_blocks < 0) return;
  if (hipMemsetAsync((char*)d_ws + WS_BAR, 0, XCD_BAR_WORDS * sizeof(unsigned), stream) != hipSuccess)
    fprintf(stderr, "kernel_launch: hipMemsetAsync of the barrier words failed\n");
  Params p{};
  for (int i = 0; i < 18; ++i) p.in[i] = (const float*)d_in[i];
  p.out = (float*)d_out;
  p.ws = (unsigned char*)d_ws;
  void* args[] = {&p};
  hipError_t e = hipLaunchCooperativeKernel((const void*)mega, dim3(grid_blocks), dim3(512), args, LDS_BYTES, stream);
  if (e != hipSuccess) fprintf(stderr, "cooperative launch failed: %s (grid %d)\n", hipGetErrorString(e), grid_blocks);
}
```

```cpp
#include <hip/hip_runtime.h>
#include <hip/hip_cooperative_groups.h>
#include <cstdio>
#include <cmath>
namespace cg = cooperative_groups;

#define DEVI __device__ __forceinline__
typedef unsigned short u16;
using bf16x8 = __attribute__((ext_vector_type(8))) short;
using f32x4 = __attribute__((ext_vector_type(4))) float;
using f32x16 = __attribute__((ext_vector_type(16))) float;
typedef __bf16 bf2_t __attribute__((ext_vector_type(2)));
typedef float fl2_t __attribute__((ext_vector_type(2)));
typedef _Float16 h2_t __attribute__((ext_vector_type(2)));
typedef short s4_t __attribute__((ext_vector_type(4)));

constexpr int T_ = 32768, S_ = 16384, D_ = 1024, NL_ = 4, PW = 2560;
constexpr int C_CB = 0, C_CC = 256, C_CH = 512, C_DQ = 768, C_DK = 1152, C_DV = 1216, C_IQ = 1280, C_IK = 1536,
              C_IW = 1568, C_CQ = 1600, C_CK = 1984;
constexpr float ALPHA_ = 1.6817928305074290f;
constexpr float LOG2E_ = 1.4426950408889634f;
constexpr size_t MiB = 1u << 20;
constexpr size_t WS_BAR = 4096;
constexpr size_t WS_CTL = 0, WS_X = 1 * MiB, WS_WT = WS_X + 64 * MiB, WS_MB = WS_WT + 32 * MiB, WS_KM = WS_MB + MiB,
                 WS_VTM = WS_KM + MiB, WS_ROPED = WS_VTM + MiB, WS_ROPEI = WS_ROPED + 2 * MiB, WS_IKC = WS_ROPEI + MiB,
                 WS_DKC = WS_IKC + 2 * MiB, WS_DVC = WS_DKC + 4 * MiB, WS_Z = WS_DVC + 4 * MiB,
                 WS_VT = WS_Z + 160 * MiB, WS_Y = WS_Z + 192 * MiB, WS_Q = WS_Z, WS_P = WS_Z + 64 * MiB,
                 WS_O = WS_Z + 128 * MiB, WS_H = WS_Z, WS_END = WS_Z + 256 * MiB;
constexpr size_t WT_IN = 0, WT_OUT = 3072 * 1024, WT_MQ = WT_OUT + 1024 * 1024, WT_KV = WT_MQ + 1024 * 1024,
                 WT_MO = WT_KV + 2048 * 1024, WT_FF1 = WT_MO + 1024 * 1024, WT_FF2 = WT_FF1 + 4096 * 1024;
constexpr int LDS_BYTES = 147456;
constexpr int OFF_RB = 131072, OFF_CNT = OFF_RB + 4608, OFF_IW = OFF_CNT + 256, OFF_MISC = OFF_IW + 512,
              OFF_RED = OFF_MISC + 256, OFF_XB = OFF_RED + 8192;
constexpr int CAND_CAP = 768;
#ifndef PROBE_TK
#define PROBE_TK 1
#endif
#ifndef PROBE_AT
#define PROBE_AT 1
#endif
#ifndef PROBE_BD
#define PROBE_BD 1
#endif

struct Params {
  const float* in[18];
  float* out;
  unsigned char* ws;
};
__constant__ const float INV8_[8] = {1.0f, 0.19392274f, 0.03760603f, 0.0072926646f, 0.0014142136f, 0.0002742482f, 5.3182957e-05f, 1.0313385e-05f};
__constant__ const float INV4_[4] = {1.0f, 0.03760603f, 0.0014142136f, 5.3182957e-05f};

DEVI int opaque_v(int x) { asm volatile("" : "+v"(x)); return x; }
DEVI int opaque_s(int x) { asm volatile("" : "+s"(x)); return x; }
template <class Tp> DEVI Tp* opaque_p(Tp* x) { asm volatile("" : "+s"(x)); return x; }
#define TIDX opaque_v((int)threadIdx.x)
#define BIDX opaque_s((int)blockIdx.x)
DEVI unsigned pack2(float a, float b) {
  fl2_t x = {a, b};
  bf2_t y = __builtin_convertvector(x, bf2_t);
  return __builtin_bit_cast(unsigned, y);
}
DEVI u16 f2bf(float a) { return (u16)(pack2(a, 0.f) & 0xffffu); }
DEVI float bf2f(u16 h) { return __uint_as_float(((unsigned)h) << 16); }
DEVI float bflo(unsigned w) { return __uint_as_float(w << 16); }
DEVI float bfhi(unsigned w) { return __uint_as_float(w & 0xffff0000u); }
DEVI bf16x8 ld8(const u16* p) { return __builtin_bit_cast(bf16x8, *(const uint4*)p); }
DEVI bf16x8 mk8(unsigned a, unsigned b, unsigned c, unsigned d) {
  uint4 v = make_uint4(a, b, c, d);
  return __builtin_bit_cast(bf16x8, v);
}

#define LAS __attribute__((address_space(3)))
typedef unsigned u32x4 __attribute__((ext_vector_type(4)));
constexpr int BK = 64, HALF = 128, HTB = HALF * BK * 2;
DEVI int lds_byte(int r, int c) {
  const int st = (r >> 4) * 2 + (c >> 5), rr = r & 15, cc = c & 31, ob = rr * 64 + cc * 2;
  return st * 1024 + (ob ^ (((ob >> 9) & 1) << 5));
}
DEVI void stage_rc(int b, int& R, int& C) {
  const int st = b / 1024, sb = b % 1024, swz = sb ^ (((sb >> 9) & 1) << 5);
  R = (st >> 1) * 16 + swz / 64;
  C = (st & 1) * 32 + (swz % 64) / 2;
}
DEVI int perm32(int rho) {
  const int n = rho >> 4, i = rho & 15;
  return 8 * (i >> 2) + 4 * n + (i & 3);
}
DEVI void tile_coord(int v, int nM, int nN, int& pm, int& pn) {
  const int nwg = nM * nN;
  const int q = nwg / 8, r = nwg % 8, xcd = v % 8, off = v / 8;
  const int w = (xcd < r ? xcd * (q + 1) : r * (q + 1) + (xcd - r) * q) + off;
  const int nig = 8 * nN, gid = w / nig, fm = gid * 8, gsz = min(nM - fm, 8);
  pm = fm + ((w % nig) % gsz);
  pn = (w % nig) / gsz;
}
struct GUnit { const char* a; const char* b; int pm, pn; };
struct Sched {
  const char* A; const char* B;
  size_t aStepM, aStepN, bStepN, bStepB;
  int nM, nN, G, c;
  DEVI bool next(int i, GUnit& u) const {
    const int L = i * G + c;
    if (L >= nM * nN) return false;
    int pm, pn;
    tile_coord(L, nM, nN, pm, pn);
    u.pm = pm; u.pn = pn;
    u.a = A + (size_t)pm * aStepM + (size_t)pn * aStepN;
    u.b = B + (size_t)pn * bStepN + (size_t)(pm >> 6) * bStepB;
    return true;
  }
};

template <int ACT>
struct EpiStore16 {
  static constexpr bool PERM = true;
  u16* C; int ldc;
  DEVI void operator()(f32x4 (&acc)[2][2][4][2], const GUnit& u, int wr, int wc, int fr, int fq) const {
    const int row0 = u.pm * 256 + wr * 64 + fr, col0 = u.pn * 256 + wc * 32 + 8 * fq;
#pragma unroll
    for (int ai = 0; ai < 2; ++ai)
#pragma unroll
      for (int m = 0; m < 4; ++m) {
        u16* rowp = C + (size_t)(row0 + ai * HALF + m * 16) * ldc + col0;
#pragma unroll
        for (int bj = 0; bj < 2; ++bj) {
          f32x4 v0 = acc[ai][bj][m][0], v1 = acc[ai][bj][m][1];
          if (ACT == 1) {
#pragma unroll
            for (int j = 0; j < 4; ++j) {
              const float a = fmaxf(v0[j], 0.f), b = fmaxf(v1[j], 0.f);
              v0[j] = a * a;
              v1[j] = b * b;
            }
          }
          u32x4 w;
          w.x = pack2(v0[0], v0[1]); w.y = pack2(v0[2], v0[3]); w.z = pack2(v1[0], v1[1]); w.w = pack2(v1[2], v1[3]);
          *(u32x4*)(rowp + bj * HALF) = w;
        }
      }
  }
};
struct EpiProj {
  static constexpr bool PERM = true;
  u16* C; const float* ropeD; const float* ropeI; u16* IKc; u16* DKc; u16* DVc;
  DEVI void operator()(f32x4 (&acc)[2][2][4][2], const GUnit& u, int wr, int wc, int fr, int fq) const {
    const int row0 = u.pm * 256 + wr * 64 + fr, col0 = u.pn * 256 + wc * 32 + 8 * fq;
#pragma unroll
    for (int ai = 0; ai < 2; ++ai)
#pragma unroll
      for (int m = 0; m < 4; ++m) {
        const int row = row0 + ai * HALF + m * 16;
        u16* rowp = C + (size_t)row * PW + col0;
#pragma unroll
        for (int bj = 0; bj < 2; ++bj) {
          f32x4 v0 = acc[ai][bj][m][0], v1 = acc[ai][bj][m][1];
          const int gg = u.pn * 256 + bj * HALF + wc * 32;
          if (gg >= C_DQ && gg < C_DV && (gg & 63) == 0) {
            const f32x4 c0 = *(const f32x4*)(ropeD + (size_t)row * 16), c1 = *(const f32x4*)(ropeD + (size_t)row * 16 + 4);
            const f32x4 s0 = *(const f32x4*)(ropeD + (size_t)row * 16 + 8), s1 = *(const f32x4*)(ropeD + (size_t)row * 16 + 12);
#pragma unroll
            for (int j = 0; j < 4; ++j) {
              const float p0 = __shfl_xor(v0[j], 16), p1 = __shfl_xor(v1[j], 16);
              const float a0 = (fq == 0) ? (v0[j] * c0[j] - p0 * s0[j]) : (v0[j] * c0[j] + p0 * s0[j]);
              const float a1 = (fq == 0) ? (v1[j] * c1[j] - p1 * s1[j]) : (v1[j] * c1[j] + p1 * s1[j]);
              v0[j] = (fq < 2) ? a0 : v0[j];
              v1[j] = (fq < 2) ? a1 : v1[j];
            }
          } else if (gg >= C_IQ && gg < C_IW) {
            const f32x4 cs = *(const f32x4*)(ropeI + (size_t)row * 8), sn = *(const f32x4*)(ropeI + (size_t)row * 8 + 4);
#pragma unroll
            for (int j = 0; j < 4; ++j) {
              const float x1 = v0[j], x2 = v1[j];
              v0[j] = (fq == 0) ? (x1 * cs[j] - x2 * sn[j]) : x1;
              v1[j] = (fq == 0) ? (x2 * cs[j] + x1 * sn[j]) : x2;
            }
          }
          u32x4 w;
          w.x = pack2(v0[0], v0[1]); w.y = pack2(v0[2], v0[3]); w.z = pack2(v1[0], v1[1]); w.w = pack2(v1[2], v1[3]);
          u16* dst = rowp + bj * HALF;
          if (gg == C_IK) dst = IKc + (size_t)row * 32 + 8 * fq;
          else if (gg >= C_DK && gg < C_DV) dst = DKc + (size_t)row * 64 + (gg - C_DK) + 8 * fq;
          else if (gg >= C_DV && gg < C_IQ) dst = DVc + (size_t)row * 64 + (gg - C_DV) + 8 * fq;
          *(u32x4*)dst = w;
        }
      }
  }
};
struct EpiRes {
  static constexpr bool PERM = false;
  float* R;
  DEVI void operator()(f32x4 (&acc)[2][2][4][2], const GUnit& u, int wr, int wc, int fr, int fq) const {
    const int row0 = u.pm * 256 + wr * 64 + fr, col0 = u.pn * 256 + wc * 32 + 4 * fq;
#pragma unroll
    for (int ai = 0; ai < 2; ++ai)
#pragma unroll
      for (int m = 0; m < 4; ++m) {
        float* rowp = R + (size_t)(row0 + ai * HALF + m * 16) * 1024 + col0;
#pragma unroll
        for (int bj = 0; bj < 2; ++bj)
#pragma unroll
          for (int n = 0; n < 2; ++n) {
            f32x4* q = (f32x4*)(rowp + bj * HALF + n * 16);
            const f32x4 old = *q;
            *q = old * ALPHA_ + acc[ai][bj][m][n];
          }
      }
  }
};
struct EpiSoftmax {
  static constexpr bool PERM = true;
  u16* C;
  DEVI void operator()(f32x4 (&acc)[2][2][4][2], const GUnit& u, int wr, int wc, int fr, int fq) const {
    extern __shared__ __attribute__((aligned(16))) unsigned char smem[];
    float* red = (float*)(smem + OFF_RED);
    const float sc2 = 0.0625f * LOG2E_;
#pragma unroll
    for (int ai = 0; ai < 2; ++ai)
#pragma unroll
      for (int m = 0; m < 4; ++m) {
        float mx = -__builtin_inff();
#pragma unroll
        for (int bj = 0; bj < 2; ++bj)
#pragma unroll
          for (int n = 0; n < 2; ++n)
#pragma unroll
            for (int j = 0; j < 4; ++j) mx = fmaxf(mx, acc[ai][bj][m][n][j]);
        mx = fmaxf(mx, __shfl_xor(mx, 16));
        mx = fmaxf(mx, __shfl_xor(mx, 32));
        float sum = 0.f;
#pragma unroll
        for (int bj = 0; bj < 2; ++bj)
#pragma unroll
          for (int n = 0; n < 2; ++n)
#pragma unroll
            for (int j = 0; j < 4; ++j) sum += __builtin_amdgcn_exp2f((acc[ai][bj][m][n][j] - mx) * sc2);
        sum += __shfl_xor(sum, 16);
        sum += __shfl_xor(sum, 32);
        if (fq == 0) *(float2*)(red + ((ai * HALF + wr * 64 + m * 16 + fr) * 4 + wc) * 2) = make_float2(mx, sum);
        __builtin_amdgcn_sched_barrier(0);
      }
    __syncthreads();
    u16* cbase = C + (size_t)(u.pm * 256 + wr * 64 + fr) * 1024 + u.pn * 256 + wc * 32 + 8 * fq;
#pragma unroll
    for (int ai = 0; ai < 2; ++ai)
#pragma unroll
      for (int m = 0; m < 4; ++m) {
        const int rl = ai * HALF + wr * 64 + m * 16 + fr;
        const f32x4 ra = *(const f32x4*)(red + rl * 8), rb = *(const f32x4*)(red + rl * 8 + 4);
        const float mx = fmaxf(fmaxf(ra[0], ra[2]), fmaxf(rb[0], rb[2]));
        const float L = ra[1] * __builtin_amdgcn_exp2f((ra[0] - mx) * sc2) + ra[3] * __builtin_amdgcn_exp2f((ra[2] - mx) * sc2) +
                        rb[1] * __builtin_amdgcn_exp2f((rb[0] - mx) * sc2) + rb[3] * __builtin_amdgcn_exp2f((rb[2] - mx) * sc2);
        const float inv = 1.f / L;
        u16* rowp = cbase + (size_t)(ai * HALF + m * 16) * 1024;
#pragma unroll
        for (int bj = 0; bj < 2; ++bj) {
          f32x4 v0 = acc[ai][bj][m][0], v1 = acc[ai][bj][m][1];
#pragma unroll
          for (int j = 0; j < 4; ++j) {
            v0[j] = __builtin_amdgcn_exp2f((v0[j] - mx) * sc2) * inv;
            v1[j] = __builtin_amdgcn_exp2f((v1[j] - mx) * sc2) * inv;
          }
          u32x4 w;
          w.x = pack2(v0[0], v0[1]); w.y = pack2(v0[2], v0[3]); w.z = pack2(v1[0], v1[1]); w.w = pack2(v1[2], v1[3]);
          *(u32x4*)(rowp + bj * HALF) = w;
        }
        __builtin_amdgcn_sched_barrier(0);
      }
    __syncthreads();
  }
};

template <class Epi>
DEVI void gemm_phase(const int lda, const int ldb, const int K, const Sched& S, const Epi& E) {
  extern __shared__ __attribute__((aligned(16))) unsigned char smem[];
  LAS unsigned char* lds = (LAS unsigned char*)smem;
  const int tid = TIDX, wid = __builtin_amdgcn_readfirstlane(tid >> 6), lane = tid & 63, wr = wid >> 2, wc = wid & 3,
            fr = lane & 15, fq = lane >> 4;
  const int nt = opaque_s(K) / BK;
  unsigned voffA[2], voffB[2];
#pragma unroll
  for (int i = 0; i < 2; ++i) {
    int R, C;
    stage_rc(tid * 16 + i * 8192, R, C);
    const int Rb = Epi::PERM ? ((R & ~31) + perm32(R & 31)) : R;
    voffA[i] = (unsigned)(R * lda + C) * 2u;
    voffB[i] = (unsigned)(Rb * ldb + C) * 2u;
  }
  const size_t kstep = (size_t)(BK * 2);
  const size_t hstepA = (size_t)HALF * lda * 2, hstepB = (size_t)HALF * ldb * 2;
  const unsigned ldsw = (unsigned)wid * 1024u;
  const int aoff = lds_byte(wr * 64 + fr, fq * 8), boff = lds_byte(wc * 32 + fr, fq * 8);
#define PG8_SA(b, h) (((b) * 2 + (h)) * HTB)
#define PG8_SB(b, h) ((4 + (b) * 2 + (h)) * HTB)
#define PG8_STAGE(bufoff, gbase, voff)                                                                                \
  do {                                                                                                                \
    _Pragma("unroll") for (int _i = 0; _i < 2; ++_i) __builtin_amdgcn_global_load_lds(                                \
        (const unsigned*)((const char*)(gbase) + (voff)[_i]), (LAS unsigned*)(lds + (bufoff) + ldsw + _i * 8192), 16, 0, 0); \
  } while (0)
#define PG8_LDA(dst, b, h)                                                                                            \
  do {                                                                                                                \
    _Pragma("unroll") for (int m = 0; m < 4; ++m) _Pragma("unroll") for (int k = 0; k < 2; ++k) dst[m][k] =           \
        *(const LAS bf16x8*)(lds + PG8_SA(b, h) + aoff + m * 2048 + k * 1024);                                        \
  } while (0)
#define PG8_LDB(dst, b, h)                                                                                            \
  do {                                                                                                                \
    _Pragma("unroll") for (int n = 0; n < 2; ++n) _Pragma("unroll") for (int k = 0; k < 2; ++k) dst[n][k] =           \
        *(const LAS bf16x8*)(lds + PG8_SB(b, h) + boff + n * 2048 + k * 1024);                                        \
  } while (0)
#define PG8_MMA(ai, bj, At, Bt)                                                                                       \
  do {                                                                                                                \
    __builtin_amdgcn_s_setprio(1);                                                                                    \
    _Pragma("unroll") for (int m = 0; m < 4; ++m) _Pragma("unroll") for (int n = 0; n < 2; ++n)                       \
        _Pragma("unroll") for (int k = 0; k < 2; ++k) acc[ai][bj][m][n] =                                             \
            __builtin_amdgcn_mfma_f32_16x16x32_bf16(Bt[n][k], At[m][k], acc[ai][bj][m][n], 0, 0, 0);                  \
    __builtin_amdgcn_s_setprio(0);                                                                                    \
  } while (0)
#define PG8_WAIT_V(n) asm volatile("s_waitcnt vmcnt(" #n ")" ::: "memory")
#define PG8_WAIT_L(n) asm volatile("s_waitcnt lgkmcnt(" #n ")" ::: "memory")
#define PG8_BAR __builtin_amdgcn_s_barrier()
#define PG8_SCHED __builtin_amdgcn_sched_barrier(0)
  GUnit cur, nxt;
  int ui = 0;
  if (S.next(0, cur)) {
    f32x4 acc[2][2][4][2];
#pragma unroll
    for (int a = 0; a < 2; ++a)
#pragma unroll
      for (int b = 0; b < 2; ++b)
#pragma unroll
        for (int m = 0; m < 4; ++m)
#pragma unroll
          for (int n = 0; n < 2; ++n) acc[a][b][m][n] = (f32x4){0.f, 0.f, 0.f, 0.f};
    bf16x8 At[4][2], B0[2][2], B1[2][2];
    const char* cA = cur.a;
    const char* cB = cur.b;
    PG8_WAIT_V(0);
    PG8_STAGE(PG8_SB(0, 0), cB, voffB); PG8_STAGE(PG8_SA(0, 0), cA, voffA);
    PG8_STAGE(PG8_SB(0, 1), cB + hstepB, voffB); PG8_STAGE(PG8_SA(0, 1), cA + hstepA, voffA);
    if (wr == 1) PG8_BAR;
    PG8_WAIT_V(4); PG8_BAR;
    PG8_STAGE(PG8_SB(1, 0), cB + kstep, voffB); PG8_STAGE(PG8_SA(1, 0), cA + kstep, voffA);
    PG8_STAGE(PG8_SB(1, 1), cB + hstepB + kstep, voffB);
    PG8_WAIT_V(6); PG8_BAR;
    for (;;) {
      const bool has_next = S.next(ui + 1, nxt);
      const char* nA = has_next ? nxt.a : cA;
      const char* nB = has_next ? nxt.b : cB;
      for (int t = 0; t < nt; t += 2) {
        const bool last = (t == nt - 2);
        const char* a1 = cA + (size_t)(t + 1) * kstep;
        const char* a2 = last ? nA : cA + (size_t)(t + 2) * kstep;
        const char* b2 = last ? nB : cB + (size_t)(t + 2) * kstep;
        const char* a3 = a2 + kstep;
        const char* b3 = b2 + kstep;
        PG8_LDB(B0, 0, 0); PG8_SCHED; PG8_LDA(At, 0, 0); PG8_STAGE(PG8_SA(1, 1), a1 + hstepA, voffA);
        PG8_WAIT_L(8); PG8_BAR; PG8_WAIT_L(0); PG8_MMA(0, 0, At, B0); PG8_BAR; PG8_SCHED;
        PG8_LDB(B1, 0, 1); PG8_STAGE(PG8_SB(0, 0), b2, voffB);
        PG8_BAR; PG8_WAIT_L(0); PG8_MMA(0, 1, At, B1); PG8_BAR;
        PG8_LDA(At, 0, 1); PG8_STAGE(PG8_SA(0, 0), a2, voffA);
        PG8_BAR; PG8_WAIT_L(0); PG8_MMA(1, 0, At, B0); PG8_BAR; PG8_SCHED;
        PG8_STAGE(PG8_SB(0, 1), b2 + hstepB, voffB);
        PG8_WAIT_V(6); PG8_BAR; PG8_MMA(1, 1, At, B1); PG8_BAR;
        PG8_LDB(B0, 1, 0); PG8_SCHED; PG8_LDA(At, 1, 0); PG8_STAGE(PG8_SA(0, 1), a2 + hstepA, voffA);
        PG8_WAIT_L(8); PG8_BAR; PG8_WAIT_L(0); PG8_MMA(0, 0, At, B0); PG8_BAR; PG8_SCHED;
        PG8_LDB(B1, 1, 1); PG8_STAGE(PG8_SB(1, 0), b3, voffB);
        PG8_BAR; PG8_WAIT_L(0); PG8_MMA(0, 1, At, B1); PG8_BAR;
        PG8_LDA(At, 1, 1); PG8_STAGE(PG8_SA(1, 0), a3, voffA);
        PG8_BAR; PG8_WAIT_L(0); PG8_MMA(1, 0, At, B0); PG8_BAR; PG8_SCHED;
        PG8_STAGE(PG8_SB(1, 1), b3 + hstepB, voffB);
        PG8_WAIT_V(6); PG8_BAR; PG8_MMA(1, 1, At, B1); PG8_BAR;
      }
      E(acc, cur, wr, wc, fr, fq);
      if (!has_next) break;
#pragma unroll
      for (int a = 0; a < 2; ++a)
#pragma unroll
        for (int b = 0; b < 2; ++b)
#pragma unroll
          for (int m = 0; m < 4; ++m)
#pragma unroll
            for (int n = 0; n < 2; ++n) acc[a][b][m][n] = (f32x4){0.f, 0.f, 0.f, 0.f};
      cur = nxt; cA = nA; cB = nB; ++ui;
    }
    PG8_WAIT_V(0);
    if (wr == 0) PG8_BAR;
    PG8_BAR;
  }
  __syncthreads();
#undef PG8_SA
#undef PG8_SB
#undef PG8_STAGE
#undef PG8_LDA
#undef PG8_LDB
#undef PG8_MMA
}

DEVI void sincos_acc(float ang, float& c, float& s) {
  const double TWO_PI = 6.283185307179586476925286766559;
  double a = (double)ang;
  double k = rint(a * (1.0 / TWO_PI));
  double r = a - k * TWO_PI;
  double r2 = r * r;
  double sn = 0.0, cs = 0.0;
  double ts = r, tc = 1.0;
#pragma unroll
  for (int n = 0; n < 12; ++n) {
    sn += ts;
    cs += tc;
    ts *= -r2 / (double)((2 * n + 2) * (2 * n + 3));
    tc *= -r2 / (double)((2 * n + 1) * (2 * n + 2));
  }
  c = (float)cs;
  s = (float)sn;
}

DEVI void phase0(const Params& p) {
  const int tid0 = TIDX, bid0 = BIDX;
  const long gtid = (long)bid0 * 512 + tid0, gsz = (long)gridDim.x * 512;
  {
    const float4* x4 = (const float4*)p.in[0];
    float4* r4 = (float4*)p.out;
    uint2* X2 = (uint2*)(p.ws + WS_X);
    for (long i = gtid; i < (long)T_ * D_ / 4; i += gsz) {
      float4 v = x4[i];
      r4[i] = v;
      X2[i] = make_uint2(pack2(v.x, v.y), pack2(v.z, v.w));
    }
    const float4* m4 = (const float4*)p.in[1];
    uint2* M2 = (uint2*)(p.ws + WS_MB);
    for (long i = gtid; i < 512L * 1024 / 4; i += gsz) {
      float4 v = m4[i];
      M2[i] = make_uint2(pack2(v.x, v.y), pack2(v.z, v.w));
    }
  }
  {
    const int* pos = (const int*)p.in[2];
    float* rd = (float*)(p.ws + WS_ROPED);
    float* ri = (float*)(p.ws + WS_ROPEI);
    for (long i = gtid; i < (long)T_ * 12; i += gsz) {
      const int t = (int)(i / 12), f = (int)(i % 12);
      const float ps = (float)pos[t];
      float c, s;
      if (f < 8) {
        sincos_acc(ps * INV8_[f], c, s);
        rd[t * 16 + f] = c;
        rd[t * 16 + 8 + f] = s;
      } else {
        sincos_acc(ps * INV4_[f - 8], c, s);
        ri[t * 8 + (f - 8)] = c;
        ri[t * 8 + 4 + (f - 8)] = s;
      }
    }
  }
  if (bid0 == 0 && tid0 < 64) ((unsigned*)(p.ws + WS_CTL))[tid0] = 0u;
}

DEVI int map_in(int nd) {
  if (nd < 1576) return nd;
  if (nd < 1600) return -1;
  if (nd < 2368) return nd - 24;
  if (nd < 2560) return -1;
  if (nd < 2944) return nd - 216;
  return -1;
}

DEVI void convert_weights(const Params& p, int l) {
  extern __shared__ __attribute__((aligned(16))) unsigned char smem[];
  float* lt = (float*)smem;
  u16* WT = (u16*)(p.ws + WS_WT);
  const int t = TIDX;
  for (int tile = BIDX; tile < 4096; tile += gridDim.x) {
    const float* src;
    u16* dst;
    int K, Nsrc, mode = 0, tl;
    if (tile < 768) { src = p.in[3] + (size_t)l * 1024 * 2728; dst = WT + WT_IN; K = 1024; Nsrc = 2728; mode = 1; tl = tile; }
    else if (tile < 1024) { src = p.in[6] + (size_t)l * 1024 * 1024; dst = WT + WT_OUT; K = 1024; Nsrc = 1024; tl = tile - 768; }
    else if (tile < 1280) { src = p.in[9] + (size_t)l * 1024 * 1024; dst = WT + WT_MQ; K = 1024; Nsrc = 1024; tl = tile - 1024; }
    else if (tile < 1792) { src = p.in[10] + (size_t)l * 1024 * 2048; dst = WT + WT_KV; K = 1024; Nsrc = 2048; tl = tile - 1280; }
    else if (tile < 2048) { src = p.in[11] + (size_t)l * 1024 * 1024; dst = WT + WT_MO; K = 1024; Nsrc = 1024; tl = tile - 1792; }
    else if (tile < 3072) { src = p.in[14] + (size_t)l * 1024 * 4096; dst = WT + WT_FF1; K = 1024; Nsrc = 4096; tl = tile - 2048; }
    else { src = p.in[15] + (size_t)l * 4096 * 1024; dst = WT + WT_FF2; K = 4096; Nsrc = 1024; tl = tile - 3072; }
    const int nkt = K / 64;
    const int nt = tl / nkt, kt = tl % nkt;
    {
      const int n = t & 63, k0 = t >> 6;
      const int nd = nt * 64 + n;
      const int ns = mode ? map_in(nd) : nd;
#pragma unroll
      for (int i = 0; i < 8; ++i) {
        const int k = k0 + 8 * i;
        lt[k * 65 + n] = (ns >= 0) ? src[(size_t)(kt * 64 + k) * Nsrc + ns] : 0.f;
      }
    }
    __syncthreads();
    {
      const int n2 = t >> 3, ks = (t & 7) * 8;
      uint4 o;
      o.x = pack2(lt[(ks + 0) * 65 + n2], lt[(ks + 1) * 65 + n2]);
      o.y = pack2(lt[(ks + 2) * 65 + n2], lt[(ks + 3) * 65 + n2]);
      o.z = pack2(lt[(ks + 4) * 65 + n2], lt[(ks + 5) * 65 + n2]);
      o.w = pack2(lt[(ks + 6) * 65 + n2], lt[(ks + 7) * 65 + n2]);
      *(uint4*)(dst + (size_t)(nt * 64 + n2) * K + kt * 64 + ks) = o;
    }
    __syncthreads();
  }
}

DEVI float wave_sum(float v) {
  v += __shfl_xor(v, 32);
  v += __shfl_xor(v, 16);
  v += __shfl_xor(v, 8);
  v += __shfl_xor(v, 4);
  v += __shfl_xor(v, 2);
  v += __shfl_xor(v, 1);
  return v;
}
DEVI void ln_phase(const Params& p, const float* g, const float* b) {
  const int tidl = TIDX;
  const int wave = tidl >> 6, lane = tidl & 63;
  float* R = p.out;
  u16* X = (u16*)(p.ws + WS_X);
  float4 gg[4], bb[4];
#pragma unroll
  for (int i = 0; i < 4; ++i) {
    gg[i] = ((const float4*)g)[lane + 64 * i];
    bb[i] = ((const float4*)b)[lane + 64 * i];
  }
  for (int row = BIDX * 8 + wave; row < T_; row += gridDim.x * 8) {
    float4* rp = (float4*)(R + (size_t)row * 1024);
    float4 v[4];
#pragma unroll
    for (int i = 0; i < 4; ++i) v[i] = rp[lane + 64 * i];
    float s = 0.f;
#pragma unroll
    for (int i = 0; i < 4; ++i) s += v[i].x + v[i].y + v[i].z + v[i].w;
    const float mu = wave_sum(s) * (1.f / 1024.f);
    float q = 0.f;
#pragma unroll
    for (int i = 0; i < 4; ++i) {
      v[i].x -= mu; v[i].y -= mu; v[i].z -= mu; v[i].w -= mu;
      q += v[i].x * v[i].x + v[i].y * v[i].y + v[i].z * v[i].z + v[i].w * v[i].w;
    }
    const float rs = rsqrtf(wave_sum(q) * (1.f / 1024.f) + 1e-5f);
    uint2* xp = (uint2*)(X + (size_t)row * 1024);
#pragma unroll
    for (int i = 0; i < 4; ++i) {
      float4 o;
      o.x = v[i].x * rs * gg[i].x + bb[i].x;
      o.y = v[i].y * rs * gg[i].y + bb[i].y;
      o.z = v[i].z * rs * gg[i].z + bb[i].z;
      o.w = v[i].w * rs * gg[i].w + bb[i].w;
      rp[lane + 64 * i] = o;
      xp[lane + 64 * i] = make_uint2(pack2(o.x, o.y), pack2(o.z, o.w));
    }
  }
}

DEVI unsigned mono_key(float s) {
  unsigned u = __float_as_uint(s);
  return (u & 0x80000000u) ? ~u : (u | 0x80000000u);
}

DEVI void dsa_unit(const Params& p, const int u) {
  extern __shared__ __attribute__((aligned(16))) unsigned char smem[];
  const int tid = TIDX, lane = tid & 63, wave = __builtin_amdgcn_readfirstlane(tid >> 6);
  const int c = 255 - (u >> 3), b = (u >> 2) & 1, sub = u & 3;
  const int tok0 = b * S_ + c * 64 + sub * 16;
  const int N = (c + 1) * 64;
  const u16* proj = (const u16*)(p.ws + WS_Z);
  u16* Y = (u16*)(p.ws + WS_Y);
  float* cand_s = (float*)smem;
  u16* cand_i = (u16*)(smem + 49152);
  unsigned* h2 = (unsigned*)(smem + 73728);
  float* mem_s = (float*)(smem + 73728);
  unsigned* mem_i = (unsigned*)(smem + 73728 + 8192);
  unsigned* bm = (unsigned*)(smem + 90112);
  u16* sel = (u16*)(smem + 122880);
  int* candcnt = (int*)(smem + OFF_CNT);
  int* tbin = candcnt + 16;
  int* tb2a = candcnt + 32;
  int* base2 = candcnt + 48;
  int* mcnt = (int*)(smem + OFF_MISC);
  int* flag = mcnt + 16;
  float* iwl = (float*)(smem + OFF_IW);

  if (c < 4) {
    for (int i = tid; i < 16 * 256; i += 512) sel[i] = (u16)(i & 255);
    __syncthreads();
  } else {
   for (int rep_tk = 0; rep_tk < PROBE_TK; ++rep_tk) {
    if (tid < 128) iwl[tid] = bf2f(proj[(size_t)(tok0 + (tid >> 3)) * PW + C_IW + (tid & 7)]) * 0.17677669529663687f;
    __syncthreads();
    const int rho = lane & 31, hh = lane >> 5;
    bf16x8 af[4][2];
    h2_t sg[4][8];
#pragma unroll
    for (int rt = 0; rt < 4; ++rt) {
      const int qi = 4 * rt + 2 * (rho >> 4) + ((rho >> 2) & 1);
      const int hd = (rho & 3) + 4 * ((rho >> 3) & 1);
      const float w = iwl[qi * 8 + hd];
#pragma unroll
      for (int s = 0; s < 2; ++s) {
        const uint4 raw = *(const uint4*)(proj + (size_t)(tok0 + qi) * PW + C_IQ + hd * 32 + 16 * s + 8 * hh);
        af[rt][s] = mk8(pack2(bflo(raw.x) * w, bfhi(raw.x) * w), pack2(bflo(raw.y) * w, bfhi(raw.y) * w),
                        pack2(bflo(raw.z) * w, bfhi(raw.z) * w), pack2(bflo(raw.w) * w, bfhi(raw.w) * w));
      }
#pragma unroll
      for (int i = 0; i < 16; ++i) {
        const float w2 = iwl[(4 * rt + 2 * (i >> 3) + hh) * 8 + (i & 7)];
        sg[rt][i >> 1][i & 1] = (w2 > 0.f) ? (_Float16)1.0f : (_Float16)(-1.0f);
      }
    }
    bf16x8 al[2];
    {
      const int ii = (rho & 3) + 4 * (rho >> 3), gq = (rho >> 2) & 1;
      const int qi = 2 * (ii & 7) + gq, part = ii >> 3;
#pragma unroll
      for (int s = 0; s < 2; ++s) {
        float v[8];
#pragma unroll
        for (int j = 0; j < 8; ++j) v[j] = 0.f;
#pragma unroll
        for (int hd = 0; hd < 8; ++hd) {
          const float w = iwl[qi * 8 + hd];
          const uint4 raw = *(const uint4*)(proj + (size_t)(tok0 + qi) * PW + C_IQ + hd * 32 + 16 * s + 8 * hh);
          const unsigned r0 = pack2(bflo(raw.x) * w, bfhi(raw.x) * w), r1 = pack2(bflo(raw.y) * w, bfhi(raw.y) * w),
                         r2 = pack2(bflo(raw.z) * w, bfhi(raw.z) * w), r3 = pack2(bflo(raw.w) * w, bfhi(raw.w) * w);
          v[0] += bflo(r0); v[1] += bfhi(r0); v[2] += bflo(r1); v[3] += bfhi(r1);
          v[4] += bflo(r2); v[5] += bfhi(r2); v[6] += bflo(r3); v[7] += bfhi(r3);
        }
        unsigned hi[4];
#pragma unroll
        for (int j = 0; j < 4; ++j) hi[j] = pack2(v[2 * j], v[2 * j + 1]);
        if (part) {
#pragma unroll
          for (int j = 0; j < 4; ++j) hi[j] = pack2(v[2 * j] - bflo(hi[j]), v[2 * j + 1] - bfhi(hi[j]));
        }
        al[s] = mk8(hi[0], hi[1], hi[2], hi[3]);
      }
    }
    const int ntile = N >> 5;
    const u16* ikbase = (const u16*)(p.ws + WS_IKC) + (size_t)b * S_ * 32;
    const int ikoff = (lane & 31) * 32 + 8 * hh;
    for (int attempt = 0; attempt < 2; ++attempt) {
      const int ss = (attempt == 0 && N >= 4096) ? 8 : 1;
      const unsigned rank_t = (ss == 8) ? 64u : 256u;
      {
        uint4* h4 = (uint4*)smem;
        const uint4 z = make_uint4(0, 0, 0, 0);
        for (int i = tid; i < 131072 / 16; i += 512) h4[i] = z;
      }
      if (tid < 64) candcnt[tid] = 0;
      if (tid < 32) mcnt[tid] = 0;
      __syncthreads();
      float Lf[8];
#pragma unroll
      for (int i = 0; i < 8; ++i) Lf[i] = 0.f;
      for (int pass = 0; pass < 2; ++pass) {
        const int st = (pass == 0) ? ss : 1;
        if (pass == 1) {
#pragma unroll
          for (int i = 0; i < 8; ++i) {
            const unsigned k0 = (unsigned)tbin[2 * i + hh];
            Lf[i] = __uint_as_float((k0 & 0x80000000u) ? (k0 & 0x7fffffffu) : ~k0);
          }
        }
#define IK_LOAD(B0, B1, KT)                                        \
  do {                                                             \
    B0 = ld8(ikbase + (size_t)(KT) * 1024 + ikoff);                \
    B1 = ld8(ikbase + (size_t)(KT) * 1024 + ikoff + 16);           \
  } while (0)
#define SCORE2(RT, CB0, CB1, S0, S1)                                                                               \
  do {                                                                                                             \
    f32x16 acc = {};                                                                                               \
    acc = __builtin_amdgcn_mfma_f32_32x32x16_bf16(af[RT][0], CB0, acc, 0, 0, 0);                                   \
    acc = __builtin_amdgcn_mfma_f32_32x32x16_bf16(af[RT][1], CB1, acc, 0, 0, 0);                                   \
    S0 = la[2 * (RT)] + la[2 * (RT) + 8];                                                                          \
    S1 = la[2 * (RT) + 1] + la[2 * (RT) + 9];                                                                      \
    _Pragma("unroll") for (int i = 0; i < 8; ++i)                                                                  \
        S0 = __builtin_fmaf(__builtin_fabsf(acc[i]), (float)sg[RT][i >> 1][i & 1], S0);                           \
    _Pragma("unroll") for (int i = 8; i < 16; ++i)                                                                 \
        S1 = __builtin_fmaf(__builtin_fabsf(acc[i]), (float)sg[RT][i >> 1][i & 1], S1);                           \
  } while (0)
#define HIST1(SC, QI)                                                                                              \
  do {                                                                                                             \
    const int bin = (int)(mono_key(SC) >> 20);                                                                     \
    atomicAdd((unsigned*)smem + (QI) * 2048 + (bin >> 1), 1u << ((bin & 1) * 16));                                 \
  } while (0)
#define TILE_HIST(CB0, CB1, KT)                                                                                    \
  do {                                                                                                             \
    f32x16 la = {};                                                                                                \
    la = __builtin_amdgcn_mfma_f32_32x32x16_bf16(al[0], CB0, la, 0, 0, 0);                                         \
    la = __builtin_amdgcn_mfma_f32_32x32x16_bf16(al[1], CB1, la, 0, 0, 0);                                         \
    _Pragma("unroll") for (int rt = 0; rt < 4; ++rt) {                                                             \
      float s0, s1;                                                                                                \
      SCORE2(rt, CB0, CB1, s0, s1);                                                                                \
      HIST1(s0, 4 * rt + hh);                                                                                      \
      HIST1(s1, 4 * rt + 2 + hh);                                                                                  \
    }                                                                                                              \
  } while (0)
#define TILE_COLLECT(CB0, CB1, KT)                                                                                 \
  do {                                                                                                             \
    const int key = (KT) * 32 + (lane & 31);                                                                       \
    f32x16 la = {};                                                                                                \
    la = __builtin_amdgcn_mfma_f32_32x32x16_bf16(al[0], CB0, la, 0, 0, 0);                                         \
    la = __builtin_amdgcn_mfma_f32_32x32x16_bf16(al[1], CB1, la, 0, 0, 0);                                         \
    _Pragma("unroll") for (int rp = 0; rp < 2; ++rp) {                                                             \
      float sa, sb, sc_, sd;                                                                                       \
      SCORE2(2 * rp, CB0, CB1, sa, sb);                                                                            \
      SCORE2(2 * rp + 1, CB0, CB1, sc_, sd);                                                                       \
      const int qa = 8 * rp + hh;                                                                                  \
      const bool pa = sa >= Lf[4 * rp], pb = sb >= Lf[4 * rp + 1], pc = sc_ >= Lf[4 * rp + 2], pd = sd >= Lf[4 * rp + 3]; \
      int oa = 0, ob = 0, oc = 0, od = 0;                                                                          \
      if (pa) oa = atomicAdd(&candcnt[qa], 1);                                                                     \
      if (pb) ob = atomicAdd(&candcnt[qa + 2], 1);                                                                 \
      if (pc) oc = atomicAdd(&candcnt[qa + 4], 1);                                                                 \
      if (pd) od = atomicAdd(&candcnt[qa + 6], 1);                                                                 \
      if (pa && oa < CAND_CAP) { cand_s[qa * CAND_CAP + oa] = sa; cand_i[qa * CAND_CAP + oa] = (u16)key; }         \
      if (pb && ob < CAND_CAP) { cand_s[(qa + 2) * CAND_CAP + ob] = sb; cand_i[(qa + 2) * CAND_CAP + ob] = (u16)key; } \
      if (pc && oc < CAND_CAP) { cand_s[(qa + 4) * CAND_CAP + oc] = sc_; cand_i[(qa + 4) * CAND_CAP + oc] = (u16)key; } \
      if (pd && od < CAND_CAP) { cand_s[(qa + 6) * CAND_CAP + od] = sd; cand_i[(qa + 6) * CAND_CAP + od] = (u16)key; } \
    }                                                                                                              \
  } while (0)
#define PIPE3(BODY)                                                                                                \
  do {                                                                                                             \
    int kt = wave * st;                                                                                            \
    const int step = 8 * st;                                                                                       \
    bf16x8 fa0 = {}, fa1 = {}, fb0 = {}, fb1 = {}, fc0 = {}, fc1 = {};                                             \
    const int ktl = ntile - 1;    \
    IK_LOAD(fa0, fa1, min(kt, ktl));                                                                               \
    IK_LOAD(fb0, fb1, min(kt + step, ktl));                                                                        \
    while (kt < ntile) {                                                                                           \
      IK_LOAD(fc0, fc1, min(kt + 2 * step, ktl));                                                                  \
      BODY(fa0, fa1, kt);                                                                                          \
      kt += step;                                                                                                  \
      if (kt >= ntile) break;                                                                                      \
      IK_LOAD(fa0, fa1, min(kt + 2 * step, ktl));                                                                  \
      BODY(fb0, fb1, kt);                                                                                          \
      kt += step;                                                                                                  \
      if (kt >= ntile) break;                                                                                      \
      IK_LOAD(fb0, fb1, min(kt + 2 * step, ktl));                                                                  \
      BODY(fc0, fc1, kt);                                                                                          \
      kt += step;                                                                                                  \
    }                                                                                                              \
  } while (0)
        if (pass == 0) PIPE3(TILE_HIST);
        else PIPE3(TILE_COLLECT);
#undef IK_LOAD
#undef SCORE2
#undef HIST1
#undef TILE_HIST
#undef TILE_COLLECT
#undef PIPE3
        __syncthreads();
        if (pass == 0) {
          const int qi = tid >> 5, seg = tid & 31;
          const unsigned* hq = (const unsigned*)smem + qi * 2048 + seg * 64;
          unsigned part = 0;
          for (int w = 0; w < 64; ++w) {
            const unsigned x = hq[(w + seg) & 63];
            part += (x & 0xffffu) + (x >> 16);
          }
          unsigned incl = part;
#pragma unroll
          for (int d = 1; d < 32; d <<= 1) {
            const unsigned o = __shfl_down(incl, d, 32);
            if (seg + d < 32) incl += o;
          }
          const unsigned above = incl - part;
          const unsigned long long segbal = __ballot((above < rank_t) && (incl >= rank_t));
          const int sh32 = (lane & 32);
          const unsigned segmask = (unsigned)(segbal >> sh32);
          const int sstar = segmask ? (__ffs(segmask) - 1) : 0;
          const unsigned above_s = __shfl(above, sh32 + sstar, 64);
          const unsigned* hs = (const unsigned*)smem + qi * 2048 + sstar * 64 + seg * 2;
          const unsigned x0 = hs[0], x1 = hs[1];
          const unsigned b0 = x0 & 0xffffu, b1 = x0 >> 16, b2 = x1 & 0xffffu, b3 = x1 >> 16;
          const unsigned p4 = b0 + b1 + b2 + b3;
          unsigned inc4 = p4;
#pragma unroll
          for (int d = 1; d < 32; d <<= 1) {
            const unsigned o = __shfl_down(inc4, d, 32);
            if (seg + d < 32) inc4 += o;
          }
          const unsigned ab4 = above_s + inc4 - p4;
          int mytb = -1;
          unsigned mykey = 0u;
          if (segmask && ab4 < rank_t && ab4 + p4 >= rank_t) {
            unsigned cum = ab4, cb_ = 1u;
            int bsel;
            if (cum + b3 >= rank_t) { bsel = 3; cb_ = b3; }
            else { cum += b3;
              if (cum + b2 >= rank_t) { bsel = 2; cb_ = b2; }
              else { cum += b2;
                if (cum + b1 >= rank_t) { bsel = 1; cb_ = b1; }
                else { cum += b1; bsel = 0; cb_ = b0; } } }
            mytb = sstar * 128 + seg * 4 + bsel;
            unsigned sub = 0u;
            if (ss == 8) {
              const float ft = (float)(rank_t - cum) / (float)cb_;
              sub = (unsigned)fminf((1.f - ft) * 1048576.f, 1048575.f);
            }
            mykey = (((unsigned)mytb) << 20) + sub;
          }
          __syncthreads();
          {
            uint4* bz = (uint4*)(smem + 73728);
            for (int i = tid; i < 3072; i += 512) bz[i] = make_uint4(0, 0, 0, 0);
          }
          if (mytb >= 0) tbin[qi] = (int)mykey;
          __syncthreads();
        }
      }
      if (tid < 16) {
        const int cc = candcnt[tid];
        if (cc < 256 || cc > CAND_CAP) atomicOr((unsigned*)flag, 1u);
      }
      __syncthreads();
      const int bad = *(volatile int*)flag;
      __syncthreads();
      if (!bad) break;
    }
#pragma unroll 1
    for (int e = 0; e < 2; ++e) {
      const int qi = 2 * wave + e;
      const int C = min(candcnt[qi], CAND_CAP);
      unsigned* hq = h2 + qi * 256;
      unsigned prefix = 0u, kneed = 256u;
      const bool few = (C < 256);
      unsigned ck[12], cid[12];
#pragma unroll
      for (int j = 0; j < 12; ++j) {
        const int i = lane + 64 * j;
        const bool in = i < C;
        ck[j] = in ? mono_key(cand_s[qi * CAND_CAP + (in ? i : 0)]) : 0u;
        cid[j] = in ? (unsigned)cand_i[qi * CAND_CAP + (in ? i : 0)] : 0xffffffffu;
      }
#pragma unroll 1
      for (int d = 3; d >= 0; --d) {
        const int shift = 8 * d;
        *(uint4*)(hq + lane * 4) = make_uint4(0, 0, 0, 0);
        __builtin_amdgcn_wave_barrier();
#pragma unroll
        for (int j = 0; j < 12; ++j) {
          const bool match = (cid[j] != 0xffffffffu) && ((d == 3) || ((ck[j] >> (shift + 8)) == (prefix >> (shift + 8))));
          if (match) atomicAdd(&hq[(ck[j] >> shift) & 255u], 1u);
        }
        __builtin_amdgcn_wave_barrier();
        const uint4 c4 = *(const uint4*)(hq + lane * 4);
        const unsigned part = c4.x + c4.y + c4.z + c4.w;
        unsigned incl = part;
#pragma unroll
        for (int dd = 1; dd < 64; dd <<= 1) {
          const unsigned o = __shfl_down(incl, dd, 64);
          if (lane + dd < 64) incl += o;
        }
        const unsigned above = incl - part;
        const bool mine = (above < kneed) && (incl >= kneed);
        unsigned dg = 0u, cum = above;
        if (mine) {
          if (cum + c4.w >= kneed) dg = lane * 4 + 3;
          else { cum += c4.w;
            if (cum + c4.z >= kneed) dg = lane * 4 + 2;
            else { cum += c4.z;
              if (cum + c4.y >= kneed) dg = lane * 4 + 1;
              else { cum += c4.y; dg = lane * 4; } } }
        }
        const unsigned long long bal = __ballot(mine);
        const int src = (bal != 0ull) ? (__ffsll((long long)bal) - 1) : 0;
        dg = __shfl(dg, src, 64);
        cum = __shfl(cum, src, 64);
        if (!few) { prefix |= dg << shift; kneed -= cum; }
        __builtin_amdgcn_wave_barrier();
      }
#pragma unroll
      for (int j = 0; j < 12; ++j) {
        const unsigned id = cid[j];
        if (id != 0xffffffffu) {
          if (few || ck[j] > prefix) atomicOr(&bm[qi * 512 + (id >> 5)], 1u << (id & 31));
          else if (ck[j] == prefix) {
            const int pos = atomicAdd(&mcnt[qi], 1);
            if (pos < 128) hq[pos] = id;
          }
        }
      }
      __builtin_amdgcn_wave_barrier();
      const int M = min(*(volatile int*)&mcnt[qi], 128);
      const int need = (int)kneed;
      for (int i = lane; i < M; i += 64) {
        const unsigned id = hq[i];
        int rank = 0;
        for (int f = 0; f < M; ++f) rank += (hq[f] < id) ? 1 : 0;
        if (rank < need) atomicOr(&bm[qi * 512 + (id >> 5)], 1u << (id & 31));
      }
      __builtin_amdgcn_wave_barrier();
      const unsigned* bq = bm + qi * 512 + lane * 8;
      const uint4 w0 = *(const uint4*)bq, w1 = *(const uint4*)(bq + 4);
      const unsigned ww[8] = {w0.x, w0.y, w0.z, w0.w, w1.x, w1.y, w1.z, w1.w};
      int cnt = 0;
#pragma unroll
      for (int w = 0; w < 8; ++w) cnt += __popc(ww[w]);
      int inc2 = cnt;
#pragma unroll
      for (int dd = 1; dd < 64; dd <<= 1) {
        const int o = __shfl_up(inc2, dd, 64);
        if (lane >= dd) inc2 += o;
      }
      int pos = inc2 - cnt;
#pragma unroll
      for (int w = 0; w < 8; ++w) {
        unsigned x = ww[w];
        while (x) {
          const int bit = __ffs(x) - 1;
          x &= x - 1;
          if (pos < 256) sel[qi * 256 + pos] = (u16)((lane * 8 + w) * 32 + bit);
          ++pos;
        }
      }
      if (lane == 63) {
        for (int q2 = pos; q2 < 256; ++q2) sel[qi * 256 + q2] = 0;
      }
    }
    __syncthreads();
   }
  }

  {
    const int n = (N < 256) ? N : 256;
    const int nt16 = n >> 4;
    const int hc = lane & 15, g4 = lane >> 4;
    u16* Vs = (u16*)(smem + wave * 9216);
    const float sc2 = 0.125f * LOG2E_;
    for (int e2 = 0; e2 < 2 * PROBE_AT; ++e2) {
      const int e = e2 & 1;
      const int qq = wave * 2 + e;
      const size_t tok = (size_t)tok0 + qq;
      bf16x8 qf[2];
#pragma unroll
      for (int s = 0; s < 2; ++s) {
        bf16x8 z = {};
        qf[s] = (hc < 6) ? ld8(proj + tok * PW + C_DQ + hc * 64 + 32 * s + 8 * g4) : z;
      }
      f32x4 st[16];
#pragma unroll
      for (int kt = 0; kt < 16; ++kt) {
        if (kt < nt16) {
          const int key = sel[qq * 256 + kt * 16 + hc] & 16383;
          const u16* kp = (const u16*)(p.ws + WS_DKC) + (size_t)(b * S_ + key) * 64 + 8 * g4;
          const bf16x8 a0 = ld8(kp), a1 = ld8(kp + 32);
          f32x4 a = {};
          a = __builtin_amdgcn_mfma_f32_16x16x32_bf16(a0, qf[0], a, 0, 0, 0);
          a = __builtin_amdgcn_mfma_f32_16x16x32_bf16(a1, qf[1], a, 0, 0, 0);
          st[kt] = a;
        } else {
          const float ninf = -__builtin_inff();
          st[kt] = f32x4{ninf, ninf, ninf, ninf};
        }
      }
      float mx = -__builtin_inff();
#pragma unroll
      for (int kt = 0; kt < 16; ++kt)
#pragma unroll
        for (int i = 0; i < 4; ++i) mx = fmaxf(mx, st[kt][i]);
      mx = fmaxf(mx, __shfl_xor(mx, 16));
      mx = fmaxf(mx, __shfl_xor(mx, 32));
      float ls = 0.f;
#pragma unroll
      for (int kt = 0; kt < 16; ++kt)
#pragma unroll
        for (int i = 0; i < 4; ++i) {
          const float pv = __builtin_amdgcn_exp2f((st[kt][i] - mx) * sc2);
          st[kt][i] = pv;
          ls += pv;
        }
      ls += __shfl_xor(ls, 16);
      ls += __shfl_xor(ls, 32);
      f32x4 o[4] = {};
      const u16* dvc = (const u16*)(p.ws + WS_DVC) + (size_t)b * S_ * 64 + 8 * (lane & 7);
      uint4 vr0, vr1, vr2, vr3, vr4, vr5, vr6, vr7;
#define VGATHER(VR, IT, CH) VR = *(const uint4*)(dvc + (size_t)(sel[qq * 256 + (CH) * 64 + (IT) * 8 + (lane >> 3)] & 16383) * 64)
#define VPARK(VR, IT) *(uint4*)(Vs + ((IT) * 8 + (lane >> 3)) * 72 + 8 * (lane & 7)) = VR
      VGATHER(vr0, 0, 0); VGATHER(vr1, 1, 0); VGATHER(vr2, 2, 0); VGATHER(vr3, 3, 0);
      VGATHER(vr4, 4, 0); VGATHER(vr5, 5, 0); VGATHER(vr6, 6, 0); VGATHER(vr7, 7, 0);
      const int traddr = ((4 * g4 + ((lane & 15) >> 2)) * 72 + 4 * (lane & 3)) * 2;
#pragma unroll
      for (int ch = 0; ch < 4; ++ch) {
        if (ch * 64 < n) {
          VPARK(vr0, 0); VPARK(vr1, 1); VPARK(vr2, 2); VPARK(vr3, 3); VPARK(vr4, 4); VPARK(vr5, 5); VPARK(vr6, 6); VPARK(vr7, 7);
          if (ch < 3 && (ch + 1) * 64 < n) {
            VGATHER(vr0, 0, ch + 1); VGATHER(vr1, 1, ch + 1); VGATHER(vr2, 2, ch + 1); VGATHER(vr3, 3, ch + 1);
            VGATHER(vr4, 4, ch + 1); VGATHER(vr5, 5, ch + 1); VGATHER(vr6, 6, ch + 1); VGATHER(vr7, 7, ch + 1);
          }
          asm volatile("s_waitcnt lgkmcnt(0)" ::: "memory");
#pragma unroll
          for (int tt = 0; tt < 2; ++tt) {
            const int t2 = (ch * 2 + tt) * 2;
            const bf16x8 pb = mk8(pack2(st[t2][0], st[t2][1]), pack2(st[t2][2], st[t2][3]),
                                  pack2(st[t2 + 1][0], st[t2 + 1][1]), pack2(st[t2 + 1][2], st[t2 + 1][3]));
#pragma unroll
            for (int dt = 0; dt < 4; ++dt) {
              const LAS unsigned char* ta = (const LAS unsigned char*)smem + wave * 9216 + traddr + (32 * tt) * 144 + 32 * dt;
              const s4_t lo = __builtin_amdgcn_ds_read_tr16_b64_v4i16((LAS s4_t*)ta);
              const s4_t hi = __builtin_amdgcn_ds_read_tr16_b64_v4i16((LAS s4_t*)(ta + 16 * 144));
              bf16x8 va;
              va[0] = lo[0]; va[1] = lo[1]; va[2] = lo[2]; va[3] = lo[3];
              va[4] = hi[0]; va[5] = hi[1]; va[6] = hi[2]; va[7] = hi[3];
              o[dt] = __builtin_amdgcn_mfma_f32_16x16x32_bf16(va, pb, o[dt], 0, 0, 0);
            }
          }
          asm volatile("s_waitcnt lgkmcnt(0)" ::: "memory");
        }
      }
#undef VGATHER
#undef VPARK
      const float inv = 1.f / ls;
      if (hc < 6) {
#pragma unroll
        for (int dt = 0; dt < 4; ++dt) {
          uint2 w2 = make_uint2(pack2(o[dt][0] * inv, o[dt][1] * inv), pack2(o[dt][2] * inv, o[dt][3] * inv));
          *(uint2*)(Y + tok * 1024 + 256 + hc * 64 + 16 * dt + 4 * g4) = w2;
        }
      }
    }
  }
  __syncthreads();
}

DEVI void band_unit(const Params& p, const int U) {
  extern __shared__ __attribute__((aligned(16))) unsigned char smem[];
  const int tid = TIDX, lane = tid & 63, wave = tid >> 6;
  const int wu = U * 8 + wave;
  const int qh = wu & 1, h = (wu >> 1) % 6, bc = wu / 12, c = bc & 255, b = bc >> 8;
  const int r = lane & 31, g = lane >> 5;
  const u16* proj = (const u16*)(p.ws + WS_Z);
  const u16* Vt = (const u16*)(p.ws + WS_VT);
  u16* Y = (u16*)(p.ws + WS_Y);
  const float* rb = (const float*)(smem + OFF_RB) + h * 192;
  const size_t tokq = (size_t)b * S_ + c * 64 + qh * 32 + r;
  bf16x8 qf[4];
#pragma unroll
  for (int s = 0; s < 4; ++s) qf[s] = ld8(proj + tokq * PW + C_CQ + h * 64 + 16 * s + 8 * g);
  const int c0 = (c >= 8) ? (c - 8) : 0;
  const int kt0 = c0 * 2, kt1 = (c + 1) * 2;
  const int pr = (r & 16) | ((r & 4) << 1) | ((r & 8) >> 1) | (r & 3);
  const int qpos = c * 64 + qh * 32 + r;
  const float SC2 = 0.125f * LOG2E_;
  f32x16 o0 = {}, o1 = {};
  float m = -1e30f, ls = 0.f;
  for (int kt = kt0; kt < kt1; ++kt) {
    const u16* kp = proj + (size_t)(b * S_ + kt * 32 + pr) * PW + C_CK + h * 64 + 8 * g;
    const bf16x8 k0 = ld8(kp), k1 = ld8(kp + 16), k2 = ld8(kp + 32), k3 = ld8(kp + 48);
    const u16* vp = Vt + (size_t)(h * 64 + r) * T_ + (size_t)b * S_ + kt * 32 + 8 * g;
    const bf16x8 v00 = ld8(vp), v01 = ld8(vp + 16), v10 = ld8(vp + (size_t)32 * T_), v11 = ld8(vp + (size_t)32 * T_ + 16);
    f32x16 s = {};
    s = __builtin_amdgcn_mfma_f32_32x32x16_bf16(k0, qf[0], s, 0, 0, 0);
    s = __builtin_amdgcn_mfma_f32_32x32x16_bf16(k1, qf[1], s, 0, 0, 0);
    s = __builtin_amdgcn_mfma_f32_32x32x16_bf16(k2, qf[2], s, 0, 0, 0);
    s = __builtin_amdgcn_mfma_f32_32x32x16_bf16(k3, qf[3], s, 0, 0, 0);
    float tm = -1e30f;
    const int kb = kt * 32 + 8 * g;
#pragma unroll
    for (int i = 0; i < 16; ++i) {
      int rel = qpos - (kb + 16 * (i >> 3) + (i & 7));
      rel = min(max(rel, -63), 128) + 63;
      const float v = s[i] * SC2 + rb[rel];
      s[i] = v;
      tm = fmaxf(tm, v);
    }
    tm = fmaxf(tm, __shfl_xor(tm, 32));
    const float mn = fmaxf(m, tm);
    const float al = __builtin_amdgcn_exp2f(m - mn);
    m = mn;
    float psum = 0.f;
#pragma unroll
    for (int i = 0; i < 16; ++i) {
      const float pv = __builtin_amdgcn_exp2f(s[i] - mn);
      s[i] = pv;
      psum += pv;
    }
    ls = ls * al + psum;
#pragma unroll
    for (int i = 0; i < 16; ++i) {
      o0[i] *= al;
      o1[i] *= al;
    }
    const bf16x8 pb0 = mk8(pack2(s[0], s[1]), pack2(s[2], s[3]), pack2(s[4], s[5]), pack2(s[6], s[7]));
    const bf16x8 pb1 = mk8(pack2(s[8], s[9]), pack2(s[10], s[11]), pack2(s[12], s[13]), pack2(s[14], s[15]));
    o0 = __builtin_amdgcn_mfma_f32_32x32x16_bf16(v00, pb0, o0, 0, 0, 0);
    o0 = __builtin_amdgcn_mfma_f32_32x32x16_bf16(v01, pb1, o0, 0, 0, 0);
    o1 = __builtin_amdgcn_mfma_f32_32x32x16_bf16(v10, pb0, o1, 0, 0, 0);
    o1 = __builtin_amdgcn_mfma_f32_32x32x16_bf16(v11, pb1, o1, 0, 0, 0);
  }
  ls += __shfl_xor(ls, 32);
  const float inv = 1.f / ls;
  u16* yp = Y + tokq * 1024 + 640 + h * 64 + 4 * g;
#pragma unroll
  for (int i4 = 0; i4 < 4; ++i4) {
    *(uint2*)(yp + 8 * i4) = make_uint2(pack2(o0[4 * i4] * inv, o0[4 * i4 + 1] * inv), pack2(o0[4 * i4 + 2] * inv, o0[4 * i4 + 3] * inv));
    *(uint2*)(yp + 32 + 8 * i4) = make_uint2(pack2(o1[4 * i4] * inv, o1[4 * i4 + 1] * inv), pack2(o1[4 * i4 + 2] * inv, o1[4 * i4 + 3] * inv));
  }
}

DEVI void conv_unit(const Params& p, const int l, const int U) {
  const u16* proj = (const u16*)(p.ws + WS_Z);
  u16* Y = (u16*)(p.ws + WS_Y);
  const float* cw = p.in[4] + (size_t)l * 3 * 256;
#pragma unroll 1
  for (int it = 0; it < 8; ++it) {
    const int item = TIDX + 512 * it;
    const int tok = U * 128 + (item >> 5), cg8 = (item & 31) * 8;
    const int s = tok & (S_ - 1);
    const uint4 cb = *(const uint4*)(proj + (size_t)tok * PW + C_CB + cg8);
    float acc[8];
#pragma unroll
    for (int e = 0; e < 8; ++e) acc[e] = 0.f;
#pragma unroll
    for (int j = 0; j < 3; ++j) {
      const int dt = 2 - j;
      if (s - dt >= 0) {
        const uint4 cc = *(const uint4*)(proj + (size_t)(tok - dt) * PW + C_CC + cg8);
        const uint4 ch = *(const uint4*)(proj + (size_t)(tok - dt) * PW + C_CH + cg8);
        const float4 w0 = *(const float4*)(cw + j * 256 + cg8);
        const float4 w1 = *(const float4*)(cw + j * 256 + cg8 + 4);
        acc[0] += w0.x * bflo(cc.x) * bflo(ch.x);
        acc[1] += w0.y * bfhi(cc.x) * bfhi(ch.x);
        acc[2] += w0.z * bflo(cc.y) * bflo(ch.y);
        acc[3] += w0.w * bfhi(cc.y) * bfhi(ch.y);
        acc[4] += w1.x * bflo(cc.z) * bflo(ch.z);
        acc[5] += w1.y * bfhi(cc.z) * bfhi(ch.z);
        acc[6] += w1.z * bflo(cc.w) * bflo(ch.w);
        acc[7] += w1.w * bfhi(cc.w) * bfhi(ch.w);
      }
    }
    uint4 o;
    o.x = pack2(bflo(cb.x) * acc[0], bfhi(cb.x) * acc[1]);
    o.y = pack2(bflo(cb.y) * acc[2], bfhi(cb.y) * acc[3]);
    o.z = pack2(bflo(cb.z) * acc[4], bfhi(cb.z) * acc[5]);
    o.w = pack2(bflo(cb.w) * acc[6], bfhi(cb.w) * acc[7]);
    *(uint4*)(Y + (size_t)tok * 1024 + cg8) = o;
  }
}

DEVI void memkv_unit(const Params& p, const int u) {
  const u16* WT = (const u16*)(p.ws + WS_WT);
  const u16* Mb = (const u16*)(p.ws + WS_MB);
  Sched S{};
  S.nM = 1; S.nN = 1; S.G = 1; S.c = 0;
  if (u < 8) {
    const int pm = u >> 2, pn = u & 3;
    S.A = (const char*)(Mb + (size_t)pm * 256 * 1024);
    S.B = (const char*)(WT + WT_KV + (size_t)pn * 256 * 1024);
    EpiStore16<0> E{(u16*)(p.ws + WS_KM) + (size_t)pm * 256 * 1024 + pn * 256, 1024};
    gemm_phase(1024, 1024, 1024, S, E);
  } else {
    const int v = u - 8, pm = v >> 1, pn = v & 1;
    S.A = (const char*)(WT + WT_KV + (size_t)(1024 + pm * 256) * 1024);
    S.B = (const char*)(Mb + (size_t)pn * 256 * 1024);
    EpiStore16<0> E{(u16*)(p.ws + WS_VTM) + (size_t)pm * 256 * 512 + pn * 256, 512};
    gemm_phase(1024, 1024, 1024, S, E);
  }
}

constexpr int NU_KV = 16, NU_DSA = 2048, NU_BAND = 768, NU_CONV = 256;
DEVI void phase_mixer(const Params& p, const int l) {
  extern __shared__ __attribute__((aligned(16))) unsigned char smem[];
  const int tid = TIDX;
  float* rb = (float*)(smem + OFF_RB);
  for (int i = tid; i < 6 * 192; i += 512) rb[i] = p.in[5][(size_t)l * 6 * 192 + i] * LOG2E_;
  const int G = (int)gridDim.x, bid = BIDX;
  __syncthreads();
  if (bid >= G - NU_KV) memkv_unit(p, bid - (G - NU_KV));
  const int NU = NU_DSA + NU_BAND + NU_CONV;
  for (int rnd = 0;; ++rnd) {
    const int base = rnd * G;
    if (base >= NU) break;
    const int u = base + ((rnd & 1) ? (G - 1 - bid) : bid);
    if (u < NU) {
      if (u < NU_DSA) dsa_unit(p, u);
      else if (u < NU_DSA + NU_BAND) { for (int rb_ = 0; rb_ < PROBE_BD; ++rb_) band_unit(p, u - NU_DSA); }
      else conv_unit(p, l, u - NU_DSA - NU_BAND);
    }
    __syncthreads();
  }
}

DEVI Sched mk_sched(const void* A, const void* B, size_t aStepM, size_t bStepN, int nM, int nN) {
  Sched S{};
  S.A = (const char*)A; S.B = (const char*)B;
  S.aStepM = aStepM; S.aStepN = 0; S.bStepN = bStepN; S.bStepB = 0;
  S.nM = nM; S.nN = nN; S.G = (int)gridDim.x; S.c = BIDX;
  return S;
}
DEVI void phase_inproj(const Params& p) {
  const u16* X = (const u16*)(p.ws + WS_X);
  const u16* WT = (const u16*)(p.ws + WS_WT) + WT_IN;
  {
    const Sched S = mk_sched(X, WT, 256 * 1024 * 2, 256 * 1024 * 2, 128, 10);
    EpiProj E{(u16*)(p.ws + WS_Z), (const float*)(p.ws + WS_ROPED), (const float*)(p.ws + WS_ROPEI), (u16*)(p.ws + WS_IKC),
              (u16*)(p.ws + WS_DKC), (u16*)(p.ws + WS_DVC)};
    gemm_phase(1024, 1024, 1024, S, E);
  }
  {
    const Sched S = mk_sched(WT + (size_t)2560 * 1024, X, 256 * 1024 * 2, 256 * 1024 * 2, 2, 128);
    EpiStore16<0> E{(u16*)(p.ws + WS_VT), T_};
    gemm_phase(1024, 1024, 1024, S, E);
  }
}
DEVI void phase_gemm_res(const Params& p, const int which) {
  const u16* A = (const u16*)(p.ws + (which == 0 ? WS_Y : (which == 1 ? WS_O : WS_H)));
  const u16* W = (const u16*)(p.ws + WS_WT) + (which == 0 ? WT_OUT : (which == 1 ? WT_MO : WT_FF2));
  const int K = (which == 2) ? 4096 : 1024;
  const Sched S = mk_sched(A, W, (size_t)256 * K * 2, (size_t)256 * K * 2, 128, 4);
  EpiRes E{p.out};
  gemm_phase(K, K, K, S, E);
}
DEVI void phase_gemm_q(const Params& p) {
  const Sched S = mk_sched(p.ws + WS_X, (const u16*)(p.ws + WS_WT) + WT_MQ, 256 * 1024 * 2, 256 * 1024 * 2, 128, 4);
  EpiStore16<0> E{(u16*)(p.ws + WS_Q), 1024};
  gemm_phase(1024, 1024, 1024, S, E);
}
DEVI void phase_gemm_s(const Params& p) {
  Sched S = mk_sched(p.ws + WS_Q, p.ws + WS_KM, 256 * 1024 * 2, 256 * 2, 128, 4);
  S.aStepN = 256 * 2;
  S.bStepB = 256 * 1024 * 2;
  EpiSoftmax E{(u16*)(p.ws + WS_P)};
  gemm_phase(1024, 1024, 256, S, E);
}
DEVI void phase_gemm_pv(const Params& p) {
  Sched S = mk_sched(p.ws + WS_P, p.ws + WS_VTM, 256 * 1024 * 2, 256 * 512 * 2, 128, 4);
  S.aStepN = 256 * 2;
  S.bStepB = 256 * 2;
  EpiStore16<0> E{(u16*)(p.ws + WS_O), 1024};
  gemm_phase(1024, 512, 256, S, E);
}
DEVI void phase_gemm_ff1(const Params& p) {
  const Sched S = mk_sched(p.ws + WS_X, (const u16*)(p.ws + WS_WT) + WT_FF1, 256 * 1024 * 2, 256 * 1024 * 2, 128, 16);
  EpiStore16<1> E{(u16*)(p.ws + WS_H), 4096};
  gemm_phase(1024, 1024, 1024, S, E);
}

#define XB_TMO      128
#define XB_XCNT(j)  (256  + 64 * (j))
#define XB_XSUB(j)  (1280 + 64 * (j))
#define XB_XGEN(j)  (2304 + 64 * (j))
#define XB_TOP      3328
#define XB_TOPGEN   3392
#define XCD_BAR_WORDS 3456
#define XB_SPIN_CAP (1u << 18)
DEVI unsigned xb_ld(unsigned* p) { return __hip_atomic_load(p, __ATOMIC_RELAXED, __HIP_MEMORY_SCOPE_AGENT); }
DEVI unsigned xb_add(unsigned* p, unsigned v) { return __hip_atomic_fetch_add(p, v, __ATOMIC_RELAXED, __HIP_MEMORY_SCOPE_AGENT); }
DEVI unsigned xb_xcc_id() { return (unsigned)__builtin_amdgcn_s_getreg((3 << 11) | 20) & 0xFu; }
#define XB_SPIN(cond, bar) do { unsigned _sp = 0; while (cond) { __builtin_amdgcn_s_sleep(1); \
    if ((++_sp & 255u) == 0u) { if (xb_ld(&(bar)[XB_TMO])) break; if (_sp > XB_SPIN_CAP) { atomicAdd(&(bar)[XB_TMO], 1u); break; } } } } while (0)
struct XcdBarrier { unsigned* bar; unsigned x; volatile LAS unsigned* st; };
DEVI XcdBarrier xcd_barrier_post(unsigned* bar, volatile LAS unsigned* st) {
  XcdBarrier b; b.bar = bar; b.x = xb_xcc_id(); b.st = st;
  if (threadIdx.x == 0) (void)xb_add(&bar[XB_XCNT(b.x)], 1u);
  return b;
}
DEVI void xcd_barrier_complete(unsigned* bar, unsigned x, unsigned& nloc, unsigned& nx) {
  const unsigned G = gridDim.x * gridDim.y * gridDim.z;
  unsigned sum, cnt, mine, sp = 0u;
  for (;;) {
    sum = 0u; cnt = 0u; mine = 0u;
#pragma unroll
    for (unsigned j = 0; j < 16; ++j) { const unsigned c = xb_ld(&bar[XB_XCNT(j)]); sum += c; cnt += (c > 0u) ? 1u : 0u; mine = (j == x) ? c : mine; }
    if (sum == G) break;
    __builtin_amdgcn_s_sleep(1);
    if ((++sp & 255u) == 0u) { if (xb_ld(&bar[XB_TMO])) break; if (sp > XB_SPIN_CAP) { atomicAdd(&bar[XB_TMO], 1u); break; } }
  }
  nloc = mine > 0u ? mine : 1u; nx = cnt > 0u ? cnt : 1u;
}
DEVI void xcd_barrier(const XcdBarrier& b) {
  asm volatile("s_waitcnt vmcnt(0)" ::: "memory");
  __syncthreads();
  if (threadIdx.x == 0) {
    unsigned* bar = b.bar;
    __builtin_amdgcn_s_waitcnt(0);
    unsigned nloc = b.st[0], nx = b.st[1];
    if (nloc == 0u) { xcd_barrier_complete(bar, b.x, nloc, nx); b.st[0] = nloc; b.st[1] = nx; }
    const unsigned old = xb_add(&bar[XB_XSUB(b.x)], 1u);
    const unsigned gen = old / nloc;
    if (old + 1u == (gen + 1u) * nloc) {
      __builtin_amdgcn_fence(__ATOMIC_RELEASE, "agent");
      asm volatile("s_waitcnt vmcnt(0)" ::: "memory");
      const unsigned og = xb_add(&bar[XB_TOP], 1u);
      const unsigned tg = og / nx;
      if (og + 1u == (tg + 1u) * nx) xb_add(&bar[XB_TOPGEN], 1u);
      else XB_SPIN(xb_ld(&bar[XB_TOPGEN]) == tg, bar);
      __builtin_amdgcn_fence(__ATOMIC_ACQUIRE, "agent");
      xb_add(&bar[XB_XGEN(b.x)], 1u);
      asm volatile("s_waitcnt vmcnt(0)" ::: "memory");
    } else {
      XB_SPIN(xb_ld(&bar[XB_XGEN(b.x)]) == gen, bar);
      __builtin_amdgcn_fence(__ATOMIC_ACQUIRE, "agent");
      asm volatile("s_waitcnt vmcnt(0)" ::: "memory");
    }
  }
  __syncthreads();
}

DEVI void grid_seam(cg::grid_group& grid) {
  asm volatile("s_waitcnt vmcnt(0) lgkmcnt(0)" ::: "memory");
  __builtin_amdgcn_fence(__ATOMIC_RELEASE, "agent");
  asm volatile("s_waitcnt vmcnt(0)" ::: "memory");
  grid.sync();
  __builtin_amdgcn_fence(__ATOMIC_ACQUIRE, "agent");
  asm volatile("s_waitcnt vmcnt(0)" ::: "memory");
  __builtin_amdgcn_fence(__ATOMIC_RELEASE, "agent");
  asm volatile("s_waitcnt vmcnt(0)" ::: "memory");
  grid.sync();
  __builtin_amdgcn_fence(__ATOMIC_ACQUIRE, "agent");
  asm volatile("s_waitcnt vmcnt(0)" ::: "memory");
}
#define PHASE(stmt)                  \
  do {                               \
    Params q = p;                    \
    const int _z = opaque_s(0);      \
    q.ws = p.ws + _z;                \
    q.out = p.out + _z;              \
    stmt;                            \
  } while (0)
__global__ void __launch_bounds__(512, 2) mega(Params p) {
  cg::grid_group grid = cg::this_grid();
  extern __shared__ __attribute__((aligned(16))) unsigned char smem[];
  volatile LAS unsigned* xst = (volatile LAS unsigned*)((LAS unsigned char*)smem + OFF_XB);
  if (threadIdx.x < 4) xst[threadIdx.x] = 0u;
  __syncthreads();
  const XcdBarrier xb = xcd_barrier_post((unsigned*)(p.ws + WS_BAR), xst);
  PHASE(phase0(q));
  PHASE(convert_weights(q, 0));
  grid_seam(grid);
#pragma unroll 1
  for (int l = 0; l < NL_; ++l) {
    PHASE(phase_inproj(q));
    xcd_barrier(xb);
    PHASE(phase_mixer(q, l));
    xcd_barrier(xb);
    PHASE(phase_gemm_res(q, 0));
    xcd_barrier(xb);
    PHASE(ln_phase(q, q.in[7] + l * 1024, q.in[8] + l * 1024));
    xcd_barrier(xb);
    PHASE(phase_gemm_q(q));
    xcd_barrier(xb);
    PHASE(phase_gemm_s(q));
    xcd_barrier(xb);
    PHASE(phase_gemm_pv(q));
    xcd_barrier(xb);
    PHASE(phase_gemm_res(q, 1));
    xcd_barrier(xb);
    PHASE(ln_phase(q, q.in[12] + l * 1024, q.in[13] + l * 1024));
    xcd_barrier(xb);
    PHASE(phase_gemm_ff1(q));
    xcd_barrier(xb);
    PHASE(phase_gemm_res(q, 2));
    xcd_barrier(xb);
    PHASE(ln_phase(q, q.in[16] + l * 1024, q.in[17] + l * 1024));
    if (l + 1 < NL_) PHASE(convert_weights(q, l + 1));
    xcd_barrier(xb);
  }
}

extern "C" void kernel_launch(void* const* d_in, const int* in_sizes, int n_in, void* d_out, int out_size, void* d_ws,
                              size_t ws_size, hipStream_t stream) {
  static int grid_blocks = 0;
  if (grid_blocks == 0) {
    if (n_in != 18 || ws_size < WS_END) {
      fprintf(stderr, "kernel_launch: unexpected n_in %d or ws_size %zu (need %zu)\n", n_in, ws_size, (size_t)WS_END);
      grid_blocks = -1;
      return;
    }
    int dev = 0, cus = 0, per_cu = 0;
    hipGetDevice(&dev);
    hipDeviceGetAttribute(&cus, hipDeviceAttributeMultiprocessorCount, dev);
    if (hipFuncSetAttribute((const void*)mega, hipFuncAttributeMaxDynamicSharedMemorySize, LDS_BYTES) != hipSuccess)
      fprintf(stderr, "kernel_launch: hipFuncSetAttribute failed\n");
    if (hipOccupancyMaxActiveBlocksPerMultiprocessor(&per_cu, (const void*)mega, 512, LDS_BYTES) != hipSuccess || per_cu < 1)
      per_cu = 1;
    (void)hipGetLastError();
    grid_blocks = cus * per_cu;
  }
  if (grid_blocks < 0) return;
  if (hipMemsetAsync((char*)d_ws + WS_BAR, 0, XCD_BAR_WORDS * sizeof(unsigned), stream) != hipSuccess)
    fprintf(stderr, "kernel_launch: hipMemsetAsync of the barrier words failed\n");
  Params p{};
  for (int i = 0; i < 18; ++i) p.in[i] = (const float*)d_in[i];
  p.out = (float*)d_out;
  p.ws = (unsigned char*)d_ws;
  void* args[] = {&p};
  hipError_t e = hipLaunchCooperativeKernel((const void*)mega, dim3(grid_blocks), dim3(512), args, LDS_BYTES, stream);
  if (e != hipSuccess) fprintf(stderr, "cooperative launch failed: %s (grid %d)\n", hipGetErrorString(e), grid_blocks);
}
```

```cpp
#include <hip/hip_runtime.h>
#include <hip/hip_cooperative_groups.h>
#include <cstdio>
#include <cmath>
namespace cg = cooperative_groups;

#define DEVI __device__ __forceinline__
typedef unsigned short u16;
using bf16x8 = __attribute__((ext_vector_type(8))) short;
using f32x4 = __attribute__((ext_vector_type(4))) float;
using f32x16 = __attribute__((ext_vector_type(16))) float;
typedef __bf16 bf2_t __attribute__((ext_vector_type(2)));
typedef float fl2_t __attribute__((ext_vector_type(2)));
typedef _Float16 h2_t __attribute__((ext_vector_type(2)));
typedef short s4_t __attribute__((ext_vector_type(4)));

constexpr int T_ = 32768, S_ = 16384, D_ = 1024, NL_ = 4, PW = 2560;
constexpr int C_CB = 0, C_CC = 256, C_CH = 512, C_DQ = 768, C_DK = 1152, C_DV = 1216, C_IQ = 1280, C_IK = 1536,
              C_IW = 1568, C_CQ = 1600, C_CK = 1984;
constexpr float ALPHA_ = 1.6817928305074290f;
constexpr float LOG2E_ = 1.4426950408889634f;
constexpr size_t MiB = 1u << 20;
constexpr size_t WS_BAR = 4096;
constexpr size_t WS_CTL = 0, WS_X = 1 * MiB, WS_WT = WS_X + 64 * MiB, WS_MB = WS_WT + 32 * MiB, WS_KM = WS_MB + MiB,
                 WS_VTM = WS_KM + MiB, WS_ROPED = WS_VTM + MiB, WS_ROPEI = WS_ROPED + 2 * MiB, WS_IKC = WS_ROPEI + MiB,
                 WS_DKC = WS_IKC + 2 * MiB, WS_DVC = WS_DKC + 4 * MiB, WS_Z = WS_DVC + 4 * MiB,
                 WS_VT = WS_Z + 160 * MiB, WS_Y = WS_Z + 192 * MiB, WS_Q = WS_Z, WS_P = WS_Z + 64 * MiB,
                 WS_O = WS_Z + 128 * MiB, WS_H = WS_Z, WS_END = WS_Z + 256 * MiB;
constexpr size_t WT_IN = 0, WT_OUT = 3072 * 1024, WT_MQ = WT_OUT + 1024 * 1024, WT_KV = WT_MQ + 1024 * 1024,
                 WT_MO = WT_KV + 2048 * 1024, WT_FF1 = WT_MO + 1024 * 1024, WT_FF2 = WT_FF1 + 4096 * 1024;
constexpr int LDS_BYTES = 147456;
constexpr int OFF_RB = 131072, OFF_CNT = OFF_RB + 4608, OFF_IW = OFF_CNT + 256, OFF_MISC = OFF_IW + 512,
              OFF_RED = OFF_MISC + 256, OFF_XB = OFF_RED + 8192;
constexpr int CAND_CAP = 768;
#ifndef PROBE_TK
#define PROBE_TK 1
#endif
#ifndef PROBE_AT
#define PROBE_AT 1
#endif
#ifndef PROBE_BD
#define PROBE_BD 1
#endif

struct Params {
  const float* in[18];
  float* out;
  unsigned char* ws;
};
__constant__ const float INV8_[8] = {1.0f, 0.19392274f, 0.03760603f, 0.0072926646f, 0.0014142136f, 0.0002742482f, 5.3182957e-05f, 1.0313385e-05f};
__constant__ const float INV4_[4] = {1.0f, 0.03760603f, 0.0014142136f, 5.3182957e-05f};

DEVI int opaque_v(int x) { asm volatile("" : "+v"(x)); return x; }
DEVI int opaque_s(int x) { asm volatile("" : "+s"(x)); return x; }
template <class Tp> DEVI Tp* opaque_p(Tp* x) { asm volatile("" : "+s"(x)); return x; }
#define TIDX opaque_v((int)threadIdx.x)
#define BIDX opaque_s((int)blockIdx.x)
DEVI unsigned pack2(float a, float b) {
  fl2_t x = {a, b};
  bf2_t y = __builtin_convertvector(x, bf2_t);
  return __builtin_bit_cast(unsigned, y);
}
DEVI u16 f2bf(float a) { return (u16)(pack2(a, 0.f) & 0xffffu); }
DEVI float bf2f(u16 h) { return __uint_as_float(((unsigned)h) << 16); }
DEVI float bflo(unsigned w) { return __uint_as_float(w << 16); }
DEVI float bfhi(unsigned w) { return __uint_as_float(w & 0xffff0000u); }
DEVI bf16x8 ld8(const u16* p) { return __builtin_bit_cast(bf16x8, *(const uint4*)p); }
DEVI bf16x8 mk8(unsigned a, unsigned b, unsigned c, unsigned d) {
  uint4 v = make_uint4(a, b, c, d);
  return __builtin_bit_cast(bf16x8, v);
}

#define LAS __attribute__((address_space(3)))
typedef unsigned u32x4 __attribute__((ext_vector_type(4)));
constexpr int BK = 64, HALF = 128, HTB = HALF * BK * 2;
DEVI int lds_byte(int r, int c) {
  const int st = (r >> 4) * 2 + (c >> 5), rr = r & 15, cc = c & 31, ob = rr * 64 + cc * 2;
  return st * 1024 + (ob ^ (((ob >> 9) & 1) << 5));
}
DEVI void stage_rc(int b, int& R, int& C) {
  const int st = b / 1024, sb = b % 1024, swz = sb ^ (((sb >> 9) & 1) << 5);
  R = (st >> 1) * 16 + swz / 64;
  C = (st & 1) * 32 + (swz % 64) / 2;
}
DEVI int perm32(int rho) {
  const int n = rho >> 4, i = rho & 15;
  return 8 * (i >> 2) + 4 * n + (i & 3);
}
DEVI void tile_coord(int v, int nM, int nN, int& pm, int& pn) {
  const int nwg = nM * nN;
  const int q = nwg / 8, r = nwg % 8, xcd = v % 8, off = v / 8;
  const int w = (xcd < r ? xcd * (q + 1) : r * (q + 1) + (xcd - r) * q) + off;
  const int nig = 8 * nN, gid = w / nig, fm = gid * 8, gsz = min(nM - fm, 8);
  pm = fm + ((w % nig) % gsz);
  pn = (w % nig) / gsz;
}
struct GUnit { const char* a; const char* b; int pm, pn; };
struct Sched {
  const char* A; const char* B;
  size_t aStepM, aStepN, bStepN, bStepB;
  int nM, nN, G, c;
  DEVI bool next(int i, GUnit& u) const {
    const int L = i * G + c;
    if (L >= nM * nN) return false;
    int pm, pn;
    tile_coord(L, nM, nN, pm, pn);
    u.pm = pm; u.pn = pn;
    u.a = A + (size_t)pm * aStepM + (size_t)pn * aStepN;
    u.b = B + (size_t)pn * bStepN + (size_t)(pm >> 6) * bStepB;
    return true;
  }
};

template <int ACT>
struct EpiStore16 {
  static constexpr bool PERM = true;
  u16* C; int ldc;
  DEVI void operator()(f32x4 (&acc)[2][2][4][2], const GUnit& u, int wr, int wc, int fr, int fq) const {
    const int row0 = u.pm * 256 + wr * 64 + fr, col0 = u.pn * 256 + wc * 32 + 8 * fq;
#pragma unroll
    for (int ai = 0; ai < 2; ++ai)
#pragma unroll
      for (int m = 0; m < 4; ++m) {
        u16* rowp = C + (size_t)(row0 + ai * HALF + m * 16) * ldc + col0;
#pragma unroll
        for (int bj = 0; bj < 2; ++bj) {
          f32x4 v0 = acc[ai][bj][m][0], v1 = acc[ai][bj][m][1];
          if (ACT == 1) {
#pragma unroll
            for (int j = 0; j < 4; ++j) {
              const float a = fmaxf(v0[j], 0.f), b = fmaxf(v1[j], 0.f);
              v0[j] = a * a;
              v1[j] = b * b;
            }
          }
          u32x4 w;
          w.x = pack2(v0[0], v0[1]); w.y = pack2(v0[2], v0[3]); w.z = pack2(v1[0], v1[1]); w.w = pack2(v1[2], v1[3]);
          *(u32x4*)(rowp + bj * HALF) = w;
        }
      }
  }
};
struct EpiProj {
  static constexpr bool PERM = true;
  u16* C; const float* ropeD; const float* ropeI; u16* IKc; u16* DKc; u16* DVc;
  DEVI void operator()(f32x4 (&acc)[2][2][4][2], const GUnit& u, int wr, int wc, int fr, int fq) const {
    const int row0 = u.pm * 256 + wr * 64 + fr, col0 = u.pn * 256 + wc * 32 + 8 * fq;
#pragma unroll
    for (int ai = 0; ai < 2; ++ai)
#pragma unroll
      for (int m = 0; m < 4; ++m) {
        const int row = row0 + ai * HALF + m * 16;
        u16* rowp = C + (size_t)row * PW + col0;
#pragma unroll
        for (int bj = 0; bj < 2; ++bj) {
          f32x4 v0 = acc[ai][bj][m][0], v1 = acc[ai][bj][m][1];
          const int gg = u.pn * 256 + bj * HALF + wc * 32;
          if (gg >= C_DQ && gg < C_DV && (gg & 63) == 0) {
            const f32x4 c0 = *(const f32x4*)(ropeD + (size_t)row * 16), c1 = *(const f32x4*)(ropeD + (size_t)row * 16 + 4);
            const f32x4 s0 = *(const f32x4*)(ropeD + (size_t)row * 16 + 8), s1 = *(const f32x4*)(ropeD + (size_t)row * 16 + 12);
#pragma unroll
            for (int j = 0; j < 4; ++j) {
              const float p0 = __shfl_xor(v0[j], 16), p1 = __shfl_xor(v1[j], 16);
              const float a0 = (fq == 0) ? (v0[j] * c0[j] - p0 * s0[j]) : (v0[j] * c0[j] + p0 * s0[j]);
              const float a1 = (fq == 0) ? (v1[j] * c1[j] - p1 * s1[j]) : (v1[j] * c1[j] + p1 * s1[j]);
              v0[j] = (fq < 2) ? a0 : v0[j];
              v1[j] = (fq < 2) ? a1 : v1[j];
            }
          } else if (gg >= C_IQ && gg < C_IW) {
            const f32x4 cs = *(const f32x4*)(ropeI + (size_t)row * 8), sn = *(const f32x4*)(ropeI + (size_t)row * 8 + 4);
#pragma unroll
            for (int j = 0; j < 4; ++j) {
              const float x1 = v0[j], x2 = v1[j];
              v0[j] = (fq == 0) ? (x1 * cs[j] - x2 * sn[j]) : x1;
              v1[j] = (fq == 0) ? (x2 * cs[j] + x1 * sn[j]) : x2;
            }
          }
          u32x4 w;
          w.x = pack2(v0[0], v0[1]); w.y = pack2(v0[2], v0[3]); w.z = pack2(v1[0], v1[1]); w.w = pack2(v1[2], v1[3]);
          u16* dst = rowp + bj * HALF;
          if (gg == C_IK) dst = IKc + (size_t)row * 32 + 8 * fq;
          else if (gg >= C_DK && gg < C_DV) dst = DKc + (size_t)row * 64 + (gg - C_DK) + 8 * fq;
          else if (gg >= C_DV && gg < C_IQ) dst = DVc + (size_t)row * 64 + (gg - C_DV) + 8 * fq;
          *(u32x4*)dst = w;
        }
      }
  }
};
struct EpiRes {
  static constexpr bool PERM = false;
  float* R; const u16* Xres; const float* xin;
  DEVI void operator()(f32x4 (&acc)[2][2][4][2], const GUnit& u, int wr, int wc, int fr, int fq) const {
    const int row0 = u.pm * 256 + wr * 64 + fr, col0 = u.pn * 256 + wc * 32 + 4 * fq;
#pragma unroll
    for (int ai = 0; ai < 2; ++ai)
#pragma unroll
      for (int m = 0; m < 4; ++m) {
        const size_t ro = (size_t)(row0 + ai * HALF + m * 16) * 1024 + col0;
#pragma unroll
        for (int bj = 0; bj < 2; ++bj)
#pragma unroll
          for (int n = 0; n < 2; ++n) {
            const size_t o = ro + bj * HALF + n * 16;
            f32x4 old;
            if (xin) old = *(const f32x4*)(xin + o);
            else {
              const uint2 xr = *(const uint2*)(Xres + o);
              old = (f32x4){bflo(xr.x), bfhi(xr.x), bflo(xr.y), bfhi(xr.y)};
            }
            *(f32x4*)(R + o) = old * ALPHA_ + acc[ai][bj][m][n];
          }
      }
  }
};
struct EpiSoftmax {
  static constexpr bool PERM = true;
  u16* C;
  DEVI void operator()(f32x4 (&acc)[2][2][4][2], const GUnit& u, int wr, int wc, int fr, int fq) const {
    extern __shared__ __attribute__((aligned(16))) unsigned char smem[];
    float* red = (float*)(smem + OFF_RED);
    const float sc2 = 0.0625f * LOG2E_;
#pragma unroll
    for (int ai = 0; ai < 2; ++ai)
#pragma unroll
      for (int m = 0; m < 4; ++m) {
        float mx = -__builtin_inff();
#pragma unroll
        for (int bj = 0; bj < 2; ++bj)
#pragma unroll
          for (int n = 0; n < 2; ++n)
#pragma unroll
            for (int j = 0; j < 4; ++j) mx = fmaxf(mx, acc[ai][bj][m][n][j]);
        mx = fmaxf(mx, __shfl_xor(mx, 16));
        mx = fmaxf(mx, __shfl_xor(mx, 32));
        float sum = 0.f;
#pragma unroll
        for (int bj = 0; bj < 2; ++bj)
#pragma unroll
          for (int n = 0; n < 2; ++n)
#pragma unroll
            for (int j = 0; j < 4; ++j) sum += __builtin_amdgcn_exp2f((acc[ai][bj][m][n][j] - mx) * sc2);
        sum += __shfl_xor(sum, 16);
        sum += __shfl_xor(sum, 32);
        if (fq == 0) *(float2*)(red + ((ai * HALF + wr * 64 + m * 16 + fr) * 4 + wc) * 2) = make_float2(mx, sum);
        __builtin_amdgcn_sched_barrier(0);
      }
    __syncthreads();
    u16* cbase = C + (size_t)(u.pm * 256 + wr * 64 + fr) * 1024 + u.pn * 256 + wc * 32 + 8 * fq;
#pragma unroll
    for (int ai = 0; ai < 2; ++ai)
#pragma unroll
      for (int m = 0; m < 4; ++m) {
        const int rl = ai * HALF + wr * 64 + m * 16 + fr;
        const f32x4 ra = *(const f32x4*)(red + rl * 8), rb = *(const f32x4*)(red + rl * 8 + 4);
        const float mx = fmaxf(fmaxf(ra[0], ra[2]), fmaxf(rb[0], rb[2]));
        const float L = ra[1] * __builtin_amdgcn_exp2f((ra[0] - mx) * sc2) + ra[3] * __builtin_amdgcn_exp2f((ra[2] - mx) * sc2) +
                        rb[1] * __builtin_amdgcn_exp2f((rb[0] - mx) * sc2) + rb[3] * __builtin_amdgcn_exp2f((rb[2] - mx) * sc2);
        const float inv = 1.f / L;
        u16* rowp = cbase + (size_t)(ai * HALF + m * 16) * 1024;
#pragma unroll
        for (int bj = 0; bj < 2; ++bj) {
          f32x4 v0 = acc[ai][bj][m][0], v1 = acc[ai][bj][m][1];
#pragma unroll
          for (int j = 0; j < 4; ++j) {
            v0[j] = __builtin_amdgcn_exp2f((v0[j] - mx) * sc2) * inv;
            v1[j] = __builtin_amdgcn_exp2f((v1[j] - mx) * sc2) * inv;
          }
          u32x4 w;
          w.x = pack2(v0[0], v0[1]); w.y = pack2(v0[2], v0[3]); w.z = pack2(v1[0], v1[1]); w.w = pack2(v1[2], v1[3]);
          *(u32x4*)(rowp + bj * HALF) = w;
        }
        __builtin_amdgcn_sched_barrier(0);
      }
    __syncthreads();
  }
};

template <class Epi>
DEVI void gemm_phase(const int lda, const int ldb, const int K, const Sched& S, const Epi& E) {
  extern __shared__ __attribute__((aligned(16))) unsigned char smem[];
  LAS unsigned char* lds = (LAS unsigned char*)smem;
  const int tid = TIDX, wid = __builtin_amdgcn_readfirstlane(tid >> 6), lane = tid & 63, wr = wid >> 2, wc = wid & 3,
            fr = lane & 15, fq = lane >> 4;
  const int nt = opaque_s(K) / BK;
  unsigned voffA[2], voffB[2];
#pragma unroll
  for (int i = 0; i < 2; ++i) {
    int R, C;
    stage_rc(tid * 16 + i * 8192, R, C);
    const int Rb = Epi::PERM ? ((R & ~31) + perm32(R & 31)) : R;
    voffA[i] = (unsigned)(R * lda + C) * 2u;
    voffB[i] = (unsigned)(Rb * ldb + C) * 2u;
  }
  const size_t kstep = (size_t)(BK * 2);
  const size_t hstepA = (size_t)HALF * lda * 2, hstepB = (size_t)HALF * ldb * 2;
  const unsigned ldsw = (unsigned)wid * 1024u;
  const int aoff = lds_byte(wr * 64 + fr, fq * 8), boff = lds_byte(wc * 32 + fr, fq * 8);
#define PG8_SA(b, h) (((b) * 2 + (h)) * HTB)
#define PG8_SB(b, h) ((4 + (b) * 2 + (h)) * HTB)
#define PG8_STAGE(bufoff, gbase, voff)                                                                                \
  do {                                                                                                                \
    _Pragma("unroll") for (int _i = 0; _i < 2; ++_i) __builtin_amdgcn_global_load_lds(                                \
        (const unsigned*)((const char*)(gbase) + (voff)[_i]), (LAS unsigned*)(lds + (bufoff) + ldsw + _i * 8192), 16, 0, 0); \
  } while (0)
#define PG8_LDA(dst, b, h)                                                                                            \
  do {                                                                                                                \
    _Pragma("unroll") for (int m = 0; m < 4; ++m) _Pragma("unroll") for (int k = 0; k < 2; ++k) dst[m][k] =           \
        *(const LAS bf16x8*)(lds + PG8_SA(b, h) + aoff + m * 2048 + k * 1024);                                        \
  } while (0)
#define PG8_LDB(dst, b, h)                                                                                            \
  do {                                                                                                                \
    _Pragma("unroll") for (int n = 0; n < 2; ++n) _Pragma("unroll") for (int k = 0; k < 2; ++k) dst[n][k] =           \
        *(const LAS bf16x8*)(lds + PG8_SB(b, h) + boff + n * 2048 + k * 1024);                                        \
  } while (0)
#define PG8_MMA(ai, bj, At, Bt)                                                                                       \
  do {                                                                                                                \
    __builtin_amdgcn_s_setprio(1);                                                                                    \
    _Pragma("unroll") for (int m = 0; m < 4; ++m) _Pragma("unroll") for (int n = 0; n < 2; ++n)                       \
        _Pragma("unroll") for (int k = 0; k < 2; ++k) acc[ai][bj][m][n] =                                             \
            __builtin_amdgcn_mfma_f32_16x16x32_bf16(Bt[n][k], At[m][k], acc[ai][bj][m][n], 0, 0, 0);                  \
    __builtin_amdgcn_s_setprio(0);                                                                                    \
  } while (0)
#define PG8_WAIT_V(n) asm volatile("s_waitcnt vmcnt(" #n ")" ::: "memory")
#define PG8_WAIT_L(n) asm volatile("s_waitcnt lgkmcnt(" #n ")" ::: "memory")
#define PG8_BAR __builtin_amdgcn_s_barrier()
#define PG8_SCHED __builtin_amdgcn_sched_barrier(0)
  GUnit cur, nxt;
  int ui = 0;
  if (S.next(0, cur)) {
    f32x4 acc[2][2][4][2];
#pragma unroll
    for (int a = 0; a < 2; ++a)
#pragma unroll
      for (int b = 0; b < 2; ++b)
#pragma unroll
        for (int m = 0; m < 4; ++m)
#pragma unroll
          for (int n = 0; n < 2; ++n) acc[a][b][m][n] = (f32x4){0.f, 0.f, 0.f, 0.f};
    bf16x8 At[4][2], B0[2][2], B1[2][2];
    const char* cA = cur.a;
    const char* cB = cur.b;
    PG8_WAIT_V(0);
    PG8_STAGE(PG8_SB(0, 0), cB, voffB); PG8_STAGE(PG8_SA(0, 0), cA, voffA);
    PG8_STAGE(PG8_SB(0, 1), cB + hstepB, voffB); PG8_STAGE(PG8_SA(0, 1), cA + hstepA, voffA);
    if (wr == 1) PG8_BAR;
    PG8_WAIT_V(4); PG8_BAR;
    PG8_STAGE(PG8_SB(1, 0), cB + kstep, voffB); PG8_STAGE(PG8_SA(1, 0), cA + kstep, voffA);
    PG8_STAGE(PG8_SB(1, 1), cB + hstepB + kstep, voffB);
    PG8_WAIT_V(6); PG8_BAR;
    for (;;) {
      const bool has_next = S.next(ui + 1, nxt);
      const char* nA = has_next ? nxt.a : cA;
      const char* nB = has_next ? nxt.b : cB;
      for (int t = 0; t < nt; t += 2) {
        const bool last = (t == nt - 2);
        const char* a1 = cA + (size_t)(t + 1) * kstep;
        const char* a2 = last ? nA : cA + (size_t)(t + 2) * kstep;
        const char* b2 = last ? nB : cB + (size_t)(t + 2) * kstep;
        const char* a3 = a2 + kstep;
        const char* b3 = b2 + kstep;
        PG8_LDB(B0, 0, 0); PG8_SCHED; PG8_LDA(At, 0, 0); PG8_STAGE(PG8_SA(1, 1), a1 + hstepA, voffA);
        PG8_WAIT_L(8); PG8_BAR; PG8_WAIT_L(0); PG8_MMA(0, 0, At, B0); PG8_BAR; PG8_SCHED;
        PG8_LDB(B1, 0, 1); PG8_STAGE(PG8_SB(0, 0), b2, voffB);
        PG8_BAR; PG8_WAIT_L(0); PG8_MMA(0, 1, At, B1); PG8_BAR;
        PG8_LDA(At, 0, 1); PG8_STAGE(PG8_SA(0, 0), a2, voffA);
        PG8_BAR; PG8_WAIT_L(0); PG8_MMA(1, 0, At, B0); PG8_BAR; PG8_SCHED;
        PG8_STAGE(PG8_SB(0, 1), b2 + hstepB, voffB);
        PG8_WAIT_V(6); PG8_BAR; PG8_MMA(1, 1, At, B1); PG8_BAR;
        PG8_LDB(B0, 1, 0); PG8_SCHED; PG8_LDA(At, 1, 0); PG8_STAGE(PG8_SA(0, 1), a2 + hstepA, voffA);
        PG8_WAIT_L(8); PG8_BAR; PG8_WAIT_L(0); PG8_MMA(0, 0, At, B0); PG8_BAR; PG8_SCHED;
        PG8_LDB(B1, 1, 1); PG8_STAGE(PG8_SB(1, 0), b3, voffB);
        PG8_BAR; PG8_WAIT_L(0); PG8_MMA(0, 1, At, B1); PG8_BAR;
        PG8_LDA(At, 1, 1); PG8_STAGE(PG8_SA(1, 0), a3, voffA);
        PG8_BAR; PG8_WAIT_L(0); PG8_MMA(1, 0, At, B0); PG8_BAR; PG8_SCHED;
        PG8_STAGE(PG8_SB(1, 1), b3 + hstepB, voffB);
        PG8_WAIT_V(6); PG8_BAR; PG8_MMA(1, 1, At, B1); PG8_BAR;
      }
      E(acc, cur, wr, wc, fr, fq);
      if (!has_next) break;
#pragma unroll
      for (int a = 0; a < 2; ++a)
#pragma unroll
        for (int b = 0; b < 2; ++b)
#pragma unroll
          for (int m = 0; m < 4; ++m)
#pragma unroll
            for (int n = 0; n < 2; ++n) acc[a][b][m][n] = (f32x4){0.f, 0.f, 0.f, 0.f};
      cur = nxt; cA = nA; cB = nB; ++ui;
    }
    PG8_WAIT_V(0);
    if (wr == 0) PG8_BAR;
    PG8_BAR;
  }
  __syncthreads();
#undef PG8_SA
#undef PG8_SB
#undef PG8_STAGE
#undef PG8_LDA
#undef PG8_LDB
#undef PG8_MMA
}

DEVI void sincos_acc(float ang, float& c, float& s) {
  const double TWO_PI = 6.283185307179586476925286766559;
  double a = (double)ang;
  double k = rint(a * (1.0 / TWO_PI));
  double r = a - k * TWO_PI;
  double r2 = r * r;
  double sn = 0.0, cs = 0.0;
  double ts = r, tc = 1.0;
#pragma unroll
  for (int n = 0; n < 12; ++n) {
    sn += ts;
    cs += tc;
    ts *= -r2 / (double)((2 * n + 2) * (2 * n + 3));
    tc *= -r2 / (double)((2 * n + 1) * (2 * n + 2));
  }
  c = (float)cs;
  s = (float)sn;
}

DEVI void phase0(const Params& p) {
  const int tid0 = TIDX, bid0 = BIDX;
  const long gtid = (long)bid0 * 512 + tid0, gsz = (long)gridDim.x * 512;
  {
    const float4* x4 = (const float4*)p.in[0];
    uint2* X2 = (uint2*)(p.ws + WS_X);
    for (long i = gtid; i < (long)T_ * D_ / 4; i += gsz) {
      float4 v = x4[i];
      X2[i] = make_uint2(pack2(v.x, v.y), pack2(v.z, v.w));
    }
    const float4* m4 = (const float4*)p.in[1];
    uint2* M2 = (uint2*)(p.ws + WS_MB);
    for (long i = gtid; i < 512L * 1024 / 4; i += gsz) {
      float4 v = m4[i];
      M2[i] = make_uint2(pack2(v.x, v.y), pack2(v.z, v.w));
    }
  }
  {
    const int* pos = (const int*)p.in[2];
    float* rd = (float*)(p.ws + WS_ROPED);
    float* ri = (float*)(p.ws + WS_ROPEI);
    for (long i = gtid; i < (long)T_ * 12; i += gsz) {
      const int t = (int)(i / 12), f = (int)(i % 12);
      const float ps = (float)pos[t];
      float c, s;
      if (f < 8) {
        sincos_acc(ps * INV8_[f], c, s);
        rd[t * 16 + f] = c;
        rd[t * 16 + 8 + f] = s;
      } else {
        sincos_acc(ps * INV4_[f - 8], c, s);
        ri[t * 8 + (f - 8)] = c;
        ri[t * 8 + 4 + (f - 8)] = s;
      }
    }
  }
  if (bid0 == 0 && tid0 < 64) ((unsigned*)(p.ws + WS_CTL))[tid0] = 0u;
}

DEVI int map_in(int nd) {
  if (nd < 1576) return nd;
  if (nd < 1600) return -1;
  if (nd < 2368) return nd - 24;
  if (nd < 2560) return -1;
  if (nd < 2944) return nd - 216;
  return -1;
}

DEVI void convert_weights(const Params& p, int l) {
  extern __shared__ __attribute__((aligned(16))) unsigned char smem[];
  float* lt = (float*)smem;
  u16* WT = (u16*)(p.ws + WS_WT);
  const int t = TIDX;
  for (int tile = BIDX; tile < 4096; tile += gridDim.x) {
    const float* src;
    u16* dst;
    int K, Nsrc, mode = 0, tl;
    if (tile < 768) { src = p.in[3] + (size_t)l * 1024 * 2728; dst = WT + WT_IN; K = 1024; Nsrc = 2728; mode = 1; tl = tile; }
    else if (tile < 1024) { src = p.in[6] + (size_t)l * 1024 * 1024; dst = WT + WT_OUT; K = 1024; Nsrc = 1024; tl = tile - 768; }
    else if (tile < 1280) { src = p.in[9] + (size_t)l * 1024 * 1024; dst = WT + WT_MQ; K = 1024; Nsrc = 1024; tl = tile - 1024; }
    else if (tile < 1792) { src = p.in[10] + (size_t)l * 1024 * 2048; dst = WT + WT_KV; K = 1024; Nsrc = 2048; tl = tile - 1280; }
    else if (tile < 2048) { src = p.in[11] + (size_t)l * 1024 * 1024; dst = WT + WT_MO; K = 1024; Nsrc = 1024; tl = tile - 1792; }
    else if (tile < 3072) { src = p.in[14] + (size_t)l * 1024 * 4096; dst = WT + WT_FF1; K = 1024; Nsrc = 4096; tl = tile - 2048; }
    else { src = p.in[15] + (size_t)l * 4096 * 1024; dst = WT + WT_FF2; K = 4096; Nsrc = 1024; tl = tile - 3072; }
    const int nkt = K / 64;
    const int nt = tl / nkt, kt = tl % nkt;
    {
      const int n = t & 63, k0 = t >> 6;
      const int nd = nt * 64 + n;
      const int ns = mode ? map_in(nd) : nd;
#pragma unroll
      for (int i = 0; i < 8; ++i) {
        const int k = k0 + 8 * i;
        lt[k * 65 + n] = (ns >= 0) ? src[(size_t)(kt * 64 + k) * Nsrc + ns] : 0.f;
      }
    }
    __syncthreads();
    {
      const int n2 = t >> 3, ks = (t & 7) * 8;
      uint4 o;
      o.x = pack2(lt[(ks + 0) * 65 + n2], lt[(ks + 1) * 65 + n2]);
      o.y = pack2(lt[(ks + 2) * 65 + n2], lt[(ks + 3) * 65 + n2]);
      o.z = pack2(lt[(ks + 4) * 65 + n2], lt[(ks + 5) * 65 + n2]);
      o.w = pack2(lt[(ks + 6) * 65 + n2], lt[(ks + 7) * 65 + n2]);
      *(uint4*)(dst + (size_t)(nt * 64 + n2) * K + kt * 64 + ks) = o;
    }
    __syncthreads();
  }
}

DEVI float wave_sum(float v) {
  v += __shfl_xor(v, 32);
  v += __shfl_xor(v, 16);
  v += __shfl_xor(v, 8);
  v += __shfl_xor(v, 4);
  v += __shfl_xor(v, 2);
  v += __shfl_xor(v, 1);
  return v;
}
DEVI void ln_phase(const Params& p, const float* g, const float* b, const bool write_f32) {
  const int tidl = TIDX;
  const int wave = tidl >> 6, lane = tidl & 63;
  float* R = p.out;
  u16* X = (u16*)(p.ws + WS_X);
  float4 gg[4], bb[4];
#pragma unroll
  for (int i = 0; i < 4; ++i) {
    gg[i] = ((const float4*)g)[lane + 64 * i];
    bb[i] = ((const float4*)b)[lane + 64 * i];
  }
  for (int row = BIDX * 8 + wave; row < T_; row += gridDim.x * 8) {
    float4* rp = (float4*)(R + (size_t)row * 1024);
    float4 v[4];
#pragma unroll
    for (int i = 0; i < 4; ++i) v[i] = rp[lane + 64 * i];
    float s = 0.f;
#pragma unroll
    for (int i = 0; i < 4; ++i) s += v[i].x + v[i].y + v[i].z + v[i].w;
    const float mu = wave_sum(s) * (1.f / 1024.f);
    float q = 0.f;
#pragma unroll
    for (int i = 0; i < 4; ++i) {
      v[i].x -= mu; v[i].y -= mu; v[i].z -= mu; v[i].w -= mu;
      q += v[i].x * v[i].x + v[i].y * v[i].y + v[i].z * v[i].z + v[i].w * v[i].w;
    }
    const float rs = rsqrtf(wave_sum(q) * (1.f / 1024.f) + 1e-5f);
    uint2* xp = (uint2*)(X + (size_t)row * 1024);
#pragma unroll
    for (int i = 0; i < 4; ++i) {
      float4 o;
      o.x = v[i].x * rs * gg[i].x + bb[i].x;
      o.y = v[i].y * rs * gg[i].y + bb[i].y;
      o.z = v[i].z * rs * gg[i].z + bb[i].z;
      o.w = v[i].w * rs * gg[i].w + bb[i].w;
      if (write_f32) rp[lane + 64 * i] = o;
      xp[lane + 64 * i] = make_uint2(pack2(o.x, o.y), pack2(o.z, o.w));
    }
  }
}

DEVI unsigned mono_key(float s) {
  unsigned u = __float_as_uint(s);
  return (u & 0x80000000u) ? ~u : (u | 0x80000000u);
}

DEVI void dsa_unit(const Params& p, const int u) {
  extern __shared__ __attribute__((aligned(16))) unsigned char smem[];
  const int tid = TIDX, lane = tid & 63, wave = __builtin_amdgcn_readfirstlane(tid >> 6);
  const int c = 255 - (u >> 3), b = (u >> 2) & 1, sub = u & 3;
  const int tok0 = b * S_ + c * 64 + sub * 16;
  const int N = (c + 1) * 64;
  const u16* proj = (const u16*)(p.ws + WS_Z);
  u16* Y = (u16*)(p.ws + WS_Y);
  float* cand_s = (float*)smem;
  u16* cand_i = (u16*)(smem + 49152);
  unsigned* h2 = (unsigned*)(smem + 73728);
  float* mem_s = (float*)(smem + 73728);
  unsigned* mem_i = (unsigned*)(smem + 73728 + 8192);
  unsigned* bm = (unsigned*)(smem + 90112);
  u16* sel = (u16*)(smem + 122880);
  int* candcnt = (int*)(smem + OFF_CNT);
  int* tbin = candcnt + 16;
  int* tb2a = candcnt + 32;
  int* base2 = candcnt + 48;
  int* mcnt = (int*)(smem + OFF_MISC);
  int* flag = mcnt + 16;
  float* iwl = (float*)(smem + OFF_IW);

  if (c < 4) {
    for (int i = tid; i < 16 * 256; i += 512) sel[i] = (u16)(i & 255);
    __syncthreads();
  } else {
   for (int rep_tk = 0; rep_tk < PROBE_TK; ++rep_tk) {
    if (tid < 128) iwl[tid] = bf2f(proj[(size_t)(tok0 + (tid >> 3)) * PW + C_IW + (tid & 7)]) * 0.17677669529663687f;
    __syncthreads();
    const int rho = lane & 31, hh = lane >> 5;
    bf16x8 af[4][2];
    float sg[4][16];
#pragma unroll
    for (int rt = 0; rt < 4; ++rt) {
      const int qi = 4 * rt + 2 * (rho >> 4) + ((rho >> 2) & 1);
      const int hd = (rho & 3) + 4 * ((rho >> 3) & 1);
      const float w = iwl[qi * 8 + hd];
#pragma unroll
      for (int s = 0; s < 2; ++s) {
        const uint4 raw = *(const uint4*)(proj + (size_t)(tok0 + qi) * PW + C_IQ + hd * 32 + 16 * s + 8 * hh);
        af[rt][s] = mk8(pack2(bflo(raw.x) * w, bfhi(raw.x) * w), pack2(bflo(raw.y) * w, bfhi(raw.y) * w),
                        pack2(bflo(raw.z) * w, bfhi(raw.z) * w), pack2(bflo(raw.w) * w, bfhi(raw.w) * w));
      }
#pragma unroll
      for (int i = 0; i < 16; ++i) {
        const float w2 = iwl[(4 * rt + 2 * (i >> 3) + hh) * 8 + (i & 7)];
        sg[rt][i] = (w2 > 0.f) ? 1.0f : -1.0f;
      }
    }
    bf16x8 al[2];
    {
      const int ii = (rho & 3) + 4 * (rho >> 3), gq = (rho >> 2) & 1;
      const int qi = 2 * (ii & 7) + gq, part = ii >> 3;
#pragma unroll
      for (int s = 0; s < 2; ++s) {
        float v[8];
#pragma unroll
        for (int j = 0; j < 8; ++j) v[j] = 0.f;
#pragma unroll
        for (int hd = 0; hd < 8; ++hd) {
          const float w = iwl[qi * 8 + hd];
          const uint4 raw = *(const uint4*)(proj + (size_t)(tok0 + qi) * PW + C_IQ + hd * 32 + 16 * s + 8 * hh);
          const unsigned r0 = pack2(bflo(raw.x) * w, bfhi(raw.x) * w), r1 = pack2(bflo(raw.y) * w, bfhi(raw.y) * w),
                         r2 = pack2(bflo(raw.z) * w, bfhi(raw.z) * w), r3 = pack2(bflo(raw.w) * w, bfhi(raw.w) * w);
          v[0] += bflo(r0); v[1] += bfhi(r0); v[2] += bflo(r1); v[3] += bfhi(r1);
          v[4] += bflo(r2); v[5] += bfhi(r2); v[6] += bflo(r3); v[7] += bfhi(r3);
        }
        unsigned hi[4];
#pragma unroll
        for (int j = 0; j < 4; ++j) hi[j] = pack2(v[2 * j], v[2 * j + 1]);
        if (part) {
#pragma unroll
          for (int j = 0; j < 4; ++j) hi[j] = pack2(v[2 * j] - bflo(hi[j]), v[2 * j + 1] - bfhi(hi[j]));
        }
        al[s] = mk8(hi[0], hi[1], hi[2], hi[3]);
      }
    }
    const int ntile = N >> 5;
    const u16* ikbase = (const u16*)(p.ws + WS_IKC) + (size_t)b * S_ * 32;
    const int ikoff = (lane & 31) * 32 + 8 * hh;
    for (int attempt = 0; attempt < 2; ++attempt) {
      const int ss = (attempt == 0 && N >= 4096) ? 8 : 1;
      const unsigned rank_t = (ss == 8) ? 64u : 256u;
      {
        uint4* h4 = (uint4*)smem;
        const uint4 z = make_uint4(0, 0, 0, 0);
        for (int i = tid; i < 131072 / 16; i += 512) h4[i] = z;
      }
      if (tid < 64) candcnt[tid] = 0;
      if (tid < 32) mcnt[tid] = 0;
      __syncthreads();
      float Lf[8];
#pragma unroll
      for (int i = 0; i < 8; ++i) Lf[i] = 0.f;
      for (int pass = 0; pass < 2; ++pass) {
        const int st = (pass == 0) ? ss : 1;
        if (pass == 1) {
#pragma unroll
          for (int i = 0; i < 8; ++i) {
            const unsigned k0 = (unsigned)tbin[2 * i + hh];
            Lf[i] = __uint_as_float((k0 & 0x80000000u) ? (k0 & 0x7fffffffu) : ~k0);
          }
        }
#define IK_LOAD(B0, B1, KT)                                        \
  do {                                                             \
    B0 = ld8(ikbase + (size_t)(KT) * 1024 + ikoff);                \
    B1 = ld8(ikbase + (size_t)(KT) * 1024 + ikoff + 16);           \
  } while (0)
#define SCORE2(RT, CB0, CB1, S0, S1)                                                                               \
  do {                                                                                                             \
    f32x16 acc = {};                                                                                               \
    acc = __builtin_amdgcn_mfma_f32_32x32x16_bf16(af[RT][0], CB0, acc, 0, 0, 0);                                   \
    acc = __builtin_amdgcn_mfma_f32_32x32x16_bf16(af[RT][1], CB1, acc, 0, 0, 0);                                   \
    S0 = la[2 * (RT)] + la[2 * (RT) + 8];                                                                          \
    S1 = la[2 * (RT) + 1] + la[2 * (RT) + 9];                                                                      \
    S0 = __builtin_fmaf(__builtin_fabsf(acc[0]), sg[RT][0], S0);     \
    S1 = __builtin_fmaf(__builtin_fabsf(acc[8]), sg[RT][8], S1);                                                   \
    _Pragma("unroll") for (int i = 1; i < 8; ++i)                                                                  \
        asm("v_fma_f32 %0, |%1|, %2, %0" : "+v"(S0) : "v"(acc[i]), "v"(sg[RT][i]));                                \
    _Pragma("unroll") for (int i = 9; i < 16; ++i)                                                                 \
        asm("v_fma_f32 %0, |%1|, %2, %0" : "+v"(S1) : "v"(acc[i]), "v"(sg[RT][i]));                                \
  } while (0)
#define HIST1(SC, QI)                                                                                              \
  do {                                                                                                             \
    const int bin = (int)(mono_key(SC) >> 20);                                                                     \
    atomicAdd((unsigned*)smem + (QI) * 2048 + (bin >> 1), 1u << ((bin & 1) * 16));                                 \
  } while (0)
#define TILE_HIST(CB0, CB1, KT)                                                                                    \
  do {                                                                                                             \
    f32x16 la = {};                                                                                                \
    la = __builtin_amdgcn_mfma_f32_32x32x16_bf16(al[0], CB0, la, 0, 0, 0);                                         \
    la = __builtin_amdgcn_mfma_f32_32x32x16_bf16(al[1], CB1, la, 0, 0, 0);                                         \
    _Pragma("unroll") for (int rt = 0; rt < 4; ++rt) {                                                             \
      float s0, s1;                                                                                                \
      SCORE2(rt, CB0, CB1, s0, s1);                                                                                \
      HIST1(s0, 4 * rt + hh);                                                                                      \
      HIST1(s1, 4 * rt + 2 + hh);                                                                                  \
    }                                                                                                              \
  } while (0)
#define TILE_COLLECT(CB0, CB1, KT)                                                                                 \
  do {                                                                                                             \
    const int key = (KT) * 32 + (lane & 31);                                                                       \
    f32x16 la = {};                                                                                                \
    la = __builtin_amdgcn_mfma_f32_32x32x16_bf16(al[0], CB0, la, 0, 0, 0);                                         \
    la = __builtin_amdgcn_mfma_f32_32x32x16_bf16(al[1], CB1, la, 0, 0, 0);                                         \
    _Pragma("unroll") for (int rp = 0; rp < 2; ++rp) {                                                             \
      float sa, sb, sc_, sd;                                                                                       \
      SCORE2(2 * rp, CB0, CB1, sa, sb);                                                                            \
      SCORE2(2 * rp + 1, CB0, CB1, sc_, sd);                                                                       \
      const int qa = 8 * rp + hh;                                                                                  \
      const bool pa = sa >= Lf[4 * rp], pb = sb >= Lf[4 * rp + 1], pc = sc_ >= Lf[4 * rp + 2], pd = sd >= Lf[4 * rp + 3]; \
      int oa = 0, ob = 0, oc = 0, od = 0;                                                                          \
      if (pa) oa = atomicAdd(&candcnt[qa], 1);                                                                     \
      if (pb) ob = atomicAdd(&candcnt[qa + 2], 1);                                                                 \
      if (pc) oc = atomicAdd(&candcnt[qa + 4], 1);                                                                 \
      if (pd) od = atomicAdd(&candcnt[qa + 6], 1);                                                                 \
      if (pa && oa < CAND_CAP) { cand_s[qa * CAND_CAP + oa] = sa; cand_i[qa * CAND_CAP + oa] = (u16)key; }         \
      if (pb && ob < CAND_CAP) { cand_s[(qa + 2) * CAND_CAP + ob] = sb; cand_i[(qa + 2) * CAND_CAP + ob] = (u16)key; } \
      if (pc && oc < CAND_CAP) { cand_s[(qa + 4) * CAND_CAP + oc] = sc_; cand_i[(qa + 4) * CAND_CAP + oc] = (u16)key; } \
      if (pd && od < CAND_CAP) { cand_s[(qa + 6) * CAND_CAP + od] = sd; cand_i[(qa + 6) * CAND_CAP + od] = (u16)key; } \
    }                                                                                                              \
  } while (0)
#define PIPE3(BODY)                                                                                                \
  do {                                                                                                             \
    int kt = wave * st;                                                                                            \
    const int step = 8 * st;                                                                                       \
    bf16x8 fa0 = {}, fa1 = {}, fb0 = {}, fb1 = {}, fc0 = {}, fc1 = {};                                             \
    const int ktl = ntile - 1;    \
    IK_LOAD(fa0, fa1, min(kt, ktl));                                                                               \
    IK_LOAD(fb0, fb1, min(kt + step, ktl));                                                                        \
    while (kt < ntile) {                                                                                           \
      IK_LOAD(fc0, fc1, min(kt + 2 * step, ktl));                                                                  \
      BODY(fa0, fa1, kt);                                                                                          \
      kt += step;                                                                                                  \
      if (kt >= ntile) break;                                                                                      \
      IK_LOAD(fa0, fa1, min(kt + 2 * step, ktl));                                                                  \
      BODY(fb0, fb1, kt);                                                                                          \
      kt += step;                                                                                                  \
      if (kt >= ntile) break;                                                                                      \
      IK_LOAD(fb0, fb1, min(kt + 2 * step, ktl));                                                                  \
      BODY(fc0, fc1, kt);                                                                                          \
      kt += step;                                                                                                  \
    }                                                                                                              \
  } while (0)
        if (pass == 0) PIPE3(TILE_HIST);
        else PIPE3(TILE_COLLECT);
#undef IK_LOAD
#undef SCORE2
#undef HIST1
#undef TILE_HIST
#undef TILE_COLLECT
#undef PIPE3
        __syncthreads();
        if (pass == 0) {
          const int qi = tid >> 5, seg = tid & 31;
          const unsigned* hq = (const unsigned*)smem + qi * 2048 + seg * 64;
          unsigned part = 0;
          for (int w = 0; w < 64; ++w) {
            const unsigned x = hq[(w + seg) & 63];
            part += (x & 0xffffu) + (x >> 16);
          }
          unsigned incl = part;
#pragma unroll
          for (int d = 1; d < 32; d <<= 1) {
            const unsigned o = __shfl_down(incl, d, 32);
            if (seg + d < 32) incl += o;
          }
          const unsigned above = incl - part;
          const unsigned long long segbal = __ballot((above < rank_t) && (incl >= rank_t));
          const int sh32 = (lane & 32);
          const unsigned segmask = (unsigned)(segbal >> sh32);
          const int sstar = segmask ? (__ffs(segmask) - 1) : 0;
          const unsigned above_s = __shfl(above, sh32 + sstar, 64);
          const unsigned* hs = (const unsigned*)smem + qi * 2048 + sstar * 64 + seg * 2;
          const unsigned x0 = hs[0], x1 = hs[1];
          const unsigned b0 = x0 & 0xffffu, b1 = x0 >> 16, b2 = x1 & 0xffffu, b3 = x1 >> 16;
          const unsigned p4 = b0 + b1 + b2 + b3;
          unsigned inc4 = p4;
#pragma unroll
          for (int d = 1; d < 32; d <<= 1) {
            const unsigned o = __shfl_down(inc4, d, 32);
            if (seg + d < 32) inc4 += o;
          }
          const unsigned ab4 = above_s + inc4 - p4;
          int mytb = -1;
          unsigned mykey = 0u;
          if (segmask && ab4 < rank_t && ab4 + p4 >= rank_t) {
            unsigned cum = ab4, cb_ = 1u;
            int bsel;
            if (cum + b3 >= rank_t) { bsel = 3; cb_ = b3; }
            else { cum += b3;
              if (cum + b2 >= rank_t) { bsel = 2; cb_ = b2; }
              else { cum += b2;
                if (cum + b1 >= rank_t) { bsel = 1; cb_ = b1; }
                else { cum += b1; bsel = 0; cb_ = b0; } } }
            mytb = sstar * 128 + seg * 4 + bsel;
            unsigned sub = 0u;
            if (ss == 8) {
              const float ft = (float)(rank_t - cum) / (float)cb_;
              sub = (unsigned)fminf((1.f - ft) * 1048576.f, 1048575.f);
            }
            mykey = (((unsigned)mytb) << 20) + sub;
          }
          __syncthreads();
          {
            uint4* bz = (uint4*)(smem + 73728);
            for (int i = tid; i < 3072; i += 512) bz[i] = make_uint4(0, 0, 0, 0);
          }
          if (mytb >= 0) tbin[qi] = (int)mykey;
          __syncthreads();
        }
      }
      if (tid < 16) {
        const int cc = candcnt[tid];
        if (cc < 256 || cc > CAND_CAP) atomicOr((unsigned*)flag, 1u);
      }
      __syncthreads();
      const int bad = *(volatile int*)flag;
      __syncthreads();
      if (!bad) break;
    }
#pragma unroll 1
    for (int e = 0; e < 2; ++e) {
      const int qi = 2 * wave + e;
      const int C = min(candcnt[qi], CAND_CAP);
      unsigned* hq = h2 + qi * 256;
      unsigned prefix = 0u, kneed = 256u;
      const bool few = (C < 256);
      unsigned ck[12], cid[12];
#pragma unroll
      for (int j = 0; j < 12; ++j) {
        const int i = lane + 64 * j;
        const bool in = i < C;
        ck[j] = in ? mono_key(cand_s[qi * CAND_CAP + (in ? i : 0)]) : 0u;
        cid[j] = in ? (unsigned)cand_i[qi * CAND_CAP + (in ? i : 0)] : 0xffffffffu;
      }
#pragma unroll 1
      for (int d = 3; d >= 0; --d) {
        const int shift = 8 * d;
        *(uint4*)(hq + lane * 4) = make_uint4(0, 0, 0, 0);
        __builtin_amdgcn_wave_barrier();
#pragma unroll
        for (int j = 0; j < 12; ++j) {
          const bool match = (cid[j] != 0xffffffffu) && ((d == 3) || ((ck[j] >> (shift + 8)) == (prefix >> (shift + 8))));
          if (match) atomicAdd(&hq[(ck[j] >> shift) & 255u], 1u);
        }
        __builtin_amdgcn_wave_barrier();
        const uint4 c4 = *(const uint4*)(hq + lane * 4);
        const unsigned part = c4.x + c4.y + c4.z + c4.w;
        unsigned incl = part;
#pragma unroll
        for (int dd = 1; dd < 64; dd <<= 1) {
          const unsigned o = __shfl_down(incl, dd, 64);
          if (lane + dd < 64) incl += o;
        }
        const unsigned above = incl - part;
        const bool mine = (above < kneed) && (incl >= kneed);
        unsigned dg = 0u, cum = above;
        if (mine) {
          if (cum + c4.w >= kneed) dg = lane * 4 + 3;
          else { cum += c4.w;
            if (cum + c4.z >= kneed) dg = lane * 4 + 2;
            else { cum += c4.z;
              if (cum + c4.y >= kneed) dg = lane * 4 + 1;
              else { cum += c4.y; dg = lane * 4; } } }
        }
        const unsigned long long bal = __ballot(mine);
        const int src = (bal != 0ull) ? (__ffsll((long long)bal) - 1) : 0;
        dg = __shfl(dg, src, 64);
        cum = __shfl(cum, src, 64);
        if (!few) { prefix |= dg << shift; kneed -= cum; }
        __builtin_amdgcn_wave_barrier();
      }
#pragma unroll
      for (int j = 0; j < 12; ++j) {
        const unsigned id = cid[j];
        if (id != 0xffffffffu) {
          if (few || ck[j] > prefix) atomicOr(&bm[qi * 512 + (id >> 5)], 1u << (id & 31));
          else if (ck[j] == prefix) {
            const int pos = atomicAdd(&mcnt[qi], 1);
            if (pos < 128) hq[pos] = id;
          }
        }
      }
      __builtin_amdgcn_wave_barrier();
      const int M = min(*(volatile int*)&mcnt[qi], 128);
      const int need = (int)kneed;
      for (int i = lane; i < M; i += 64) {
        const unsigned id = hq[i];
        int rank = 0;
        for (int f = 0; f < M; ++f) rank += (hq[f] < id) ? 1 : 0;
        if (rank < need) atomicOr(&bm[qi * 512 + (id >> 5)], 1u << (id & 31));
      }
      __builtin_amdgcn_wave_barrier();
      const unsigned* bq = bm + qi * 512 + lane * 8;
      const uint4 w0 = *(const uint4*)bq, w1 = *(const uint4*)(bq + 4);
      const unsigned ww[8] = {w0.x, w0.y, w0.z, w0.w, w1.x, w1.y, w1.z, w1.w};
      int cnt = 0;
#pragma unroll
      for (int w = 0; w < 8; ++w) cnt += __popc(ww[w]);
      int inc2 = cnt;
#pragma unroll
      for (int dd = 1; dd < 64; dd <<= 1) {
        const int o = __shfl_up(inc2, dd, 64);
        if (lane >= dd) inc2 += o;
      }
      int pos = inc2 - cnt;
#pragma unroll
      for (int w = 0; w < 8; ++w) {
        unsigned x = ww[w];
        while (x) {
          const int bit = __ffs(x) - 1;
          x &= x - 1;
          if (pos < 256) sel[qi * 256 + pos] = (u16)((lane * 8 + w) * 32 + bit);
          ++pos;
        }
      }
      if (lane == 63) {
        for (int q2 = pos; q2 < 256; ++q2) sel[qi * 256 + q2] = 0;
      }
    }
    __syncthreads();
   }
  }

  {
    const int n = (N < 256) ? N : 256;
    const int nt16 = n >> 4;
    const int hc = lane & 15, g4 = lane >> 4;
    u16* Vs = (u16*)(smem + wave * 9216);
    const float sc2 = 0.125f * LOG2E_;
    for (int e2 = 0; e2 < 2 * PROBE_AT; ++e2) {
      const int e = e2 & 1;
      const int qq = wave * 2 + e;
      const size_t tok = (size_t)tok0 + qq;
      bf16x8 qf[2];
#pragma unroll
      for (int s = 0; s < 2; ++s) {
        bf16x8 z = {};
        qf[s] = (hc < 6) ? ld8(proj + tok * PW + C_DQ + hc * 64 + 32 * s + 8 * g4) : z;
      }
      f32x4 st[16];
#pragma unroll
      for (int kt = 0; kt < 16; ++kt) {
        if (kt < nt16) {
          const int key = sel[qq * 256 + kt * 16 + hc] & 16383;
          const u16* kp = (const u16*)(p.ws + WS_DKC) + (size_t)(b * S_ + key) * 64 + 8 * g4;
          const bf16x8 a0 = ld8(kp), a1 = ld8(kp + 32);
          f32x4 a = {};
          a = __builtin_amdgcn_mfma_f32_16x16x32_bf16(a0, qf[0], a, 0, 0, 0);
          a = __builtin_amdgcn_mfma_f32_16x16x32_bf16(a1, qf[1], a, 0, 0, 0);
          st[kt] = a;
        } else {
          const float ninf = -__builtin_inff();
          st[kt] = f32x4{ninf, ninf, ninf, ninf};
        }
      }
      float mx = -__builtin_inff();
#pragma unroll
      for (int kt = 0; kt < 16; ++kt)
#pragma unroll
        for (int i = 0; i < 4; ++i) mx = fmaxf(mx, st[kt][i]);
      mx = fmaxf(mx, __shfl_xor(mx, 16));
      mx = fmaxf(mx, __shfl_xor(mx, 32));
      float ls = 0.f;
#pragma unroll
      for (int kt = 0; kt < 16; ++kt)
#pragma unroll
        for (int i = 0; i < 4; ++i) {
          const float pv = __builtin_amdgcn_exp2f((st[kt][i] - mx) * sc2);
          st[kt][i] = pv;
          ls += pv;
        }
      ls += __shfl_xor(ls, 16);
      ls += __shfl_xor(ls, 32);
      f32x4 o[4] = {};
      const u16* dvc = (const u16*)(p.ws + WS_DVC) + (size_t)b * S_ * 64 + 8 * (lane & 7);
      uint4 vr0, vr1, vr2, vr3, vr4, vr5, vr6, vr7;
#define VGATHER(VR, IT, CH) VR = *(const uint4*)(dvc + (size_t)(sel[qq * 256 + (CH) * 64 + (IT) * 8 + (lane >> 3)] & 16383) * 64)
#define VPARK(VR, IT) *(uint4*)(Vs + ((IT) * 8 + (lane >> 3)) * 72 + 8 * (lane & 7)) = VR
      VGATHER(vr0, 0, 0); VGATHER(vr1, 1, 0); VGATHER(vr2, 2, 0); VGATHER(vr3, 3, 0);
      VGATHER(vr4, 4, 0); VGATHER(vr5, 5, 0); VGATHER(vr6, 6, 0); VGATHER(vr7, 7, 0);
      const int traddr = ((4 * g4 + ((lane & 15) >> 2)) * 72 + 4 * (lane & 3)) * 2;
#pragma unroll
      for (int ch = 0; ch < 4; ++ch) {
        if (ch * 64 < n) {
          VPARK(vr0, 0); VPARK(vr1, 1); VPARK(vr2, 2); VPARK(vr3, 3); VPARK(vr4, 4); VPARK(vr5, 5); VPARK(vr6, 6); VPARK(vr7, 7);
          if (ch < 3 && (ch + 1) * 64 < n) {
            VGATHER(vr0, 0, ch + 1); VGATHER(vr1, 1, ch + 1); VGATHER(vr2, 2, ch + 1); VGATHER(vr3, 3, ch + 1);
            VGATHER(vr4, 4, ch + 1); VGATHER(vr5, 5, ch + 1); VGATHER(vr6, 6, ch + 1); VGATHER(vr7, 7, ch + 1);
          }
          asm volatile("s_waitcnt lgkmcnt(0)" ::: "memory");
#pragma unroll
          for (int tt = 0; tt < 2; ++tt) {
            const int t2 = (ch * 2 + tt) * 2;
            const bf16x8 pb = mk8(pack2(st[t2][0], st[t2][1]), pack2(st[t2][2], st[t2][3]),
                                  pack2(st[t2 + 1][0], st[t2 + 1][1]), pack2(st[t2 + 1][2], st[t2 + 1][3]));
#pragma unroll
            for (int dt = 0; dt < 4; ++dt) {
              const LAS unsigned char* ta = (const LAS unsigned char*)smem + wave * 9216 + traddr + (32 * tt) * 144 + 32 * dt;
              const s4_t lo = __builtin_amdgcn_ds_read_tr16_b64_v4i16((LAS s4_t*)ta);
              const s4_t hi = __builtin_amdgcn_ds_read_tr16_b64_v4i16((LAS s4_t*)(ta + 16 * 144));
              bf16x8 va;
              va[0] = lo[0]; va[1] = lo[1]; va[2] = lo[2]; va[3] = lo[3];
              va[4] = hi[0]; va[5] = hi[1]; va[6] = hi[2]; va[7] = hi[3];
              o[dt] = __builtin_amdgcn_mfma_f32_16x16x32_bf16(va, pb, o[dt], 0, 0, 0);
            }
          }
          asm volatile("s_waitcnt lgkmcnt(0)" ::: "memory");
        }
      }
#undef VGATHER
#undef VPARK
      const float inv = 1.f / ls;
      if (hc < 6) {
#pragma unroll
        for (int dt = 0; dt < 4; ++dt) {
          uint2 w2 = make_uint2(pack2(o[dt][0] * inv, o[dt][1] * inv), pack2(o[dt][2] * inv, o[dt][3] * inv));
          *(uint2*)(Y + tok * 1024 + 256 + hc * 64 + 16 * dt + 4 * g4) = w2;
        }
      }
    }
  }
  __syncthreads();
}

DEVI void band_unit(const Params& p, const int U) {
  extern __shared__ __attribute__((aligned(16))) unsigned char smem[];
  const int tid = TIDX, lane = tid & 63, wave = tid >> 6;
  const int wu = U * 8 + wave;
  const int qh = wu & 1, h = (wu >> 1) % 6, bc = wu / 12, c = bc & 255, b = bc >> 8;
  const int r = lane & 31, g = lane >> 5;
  const u16* proj = (const u16*)(p.ws + WS_Z);
  const u16* Vt = (const u16*)(p.ws + WS_VT);
  u16* Y = (u16*)(p.ws + WS_Y);
  const float* rb = (const float*)(smem + OFF_RB) + h * 192;
  const size_t tokq = (size_t)b * S_ + c * 64 + qh * 32 + r;
  bf16x8 qf[4];
#pragma unroll
  for (int s = 0; s < 4; ++s) qf[s] = ld8(proj + tokq * PW + C_CQ + h * 64 + 16 * s + 8 * g);
  const int c0 = (c >= 8) ? (c - 8) : 0;
  const int kt0 = c0 * 2, kt1 = (c + 1) * 2;
  const int pr = (r & 16) | ((r & 4) << 1) | ((r & 8) >> 1) | (r & 3);
  const int qpos = c * 64 + qh * 32 + r;
  const float SC2 = 0.125f * LOG2E_;
  f32x16 o0 = {}, o1 = {};
  float m = -1e30f, ls = 0.f;
  const u16* kbase = proj + (size_t)(b * S_ + pr) * PW + C_CK + h * 64 + 8 * g;
  const u16* vbase = Vt + (size_t)(h * 64 + r) * T_ + (size_t)b * S_ + 8 * g;
#define BAND_LOAD(K0, K1, K2, K3, V00, V01, V10, V11, KT)                         \
  do {                                                                           \
    const u16* kp = kbase + (size_t)(KT) * 32 * PW;                               \
    const u16* vp = vbase + (size_t)(KT) * 32;                                    \
    K0 = ld8(kp); K1 = ld8(kp + 16); K2 = ld8(kp + 32); K3 = ld8(kp + 48);       \
    V00 = ld8(vp); V01 = ld8(vp + 16);                                           \
    V10 = ld8(vp + (size_t)32 * T_); V11 = ld8(vp + (size_t)32 * T_ + 16);       \
  } while (0)
#define BAND_TILE(K0, K1, K2, K3, V00, V01, V10, V11, KT)                                                          \
  do {                                                                                                             \
    f32x16 s = {};                                                                                                 \
    s = __builtin_amdgcn_mfma_f32_32x32x16_bf16(K0, qf[0], s, 0, 0, 0);                                            \
    s = __builtin_amdgcn_mfma_f32_32x32x16_bf16(K1, qf[1], s, 0, 0, 0);                                            \
    s = __builtin_amdgcn_mfma_f32_32x32x16_bf16(K2, qf[2], s, 0, 0, 0);                                            \
    s = __builtin_amdgcn_mfma_f32_32x32x16_bf16(K3, qf[3], s, 0, 0, 0);                                            \
    float tm = -1e30f;                                                                                             \
    const int kb = (KT) * 32 + 8 * g;                                                                              \
    _Pragma("unroll") for (int i = 0; i < 16; ++i) {                                                               \
      int rel = qpos - (kb + 16 * (i >> 3) + (i & 7));                                                             \
      rel = min(max(rel, -63), 128) + 63;                                                                          \
      const float v = s[i] * SC2 + rb[rel];                                                                        \
      s[i] = v;                                                                                                    \
      tm = fmaxf(tm, v);                                                                                           \
    }                                                                                                              \
    tm = fmaxf(tm, __shfl_xor(tm, 32));                                                                            \
    const float mn = fmaxf(m, tm);                                                                                 \
    const float al_ = __builtin_amdgcn_exp2f(m - mn);                                                              \
    m = mn;                                                                                                        \
    float psum = 0.f;                                                                                              \
    _Pragma("unroll") for (int i = 0; i < 16; ++i) {                                                               \
      const float pv = __builtin_amdgcn_exp2f(s[i] - mn);                                                          \
      s[i] = pv;                                                                                                   \
      psum += pv;                                                                                                  \
    }                                                                                                              \
    ls = ls * al_ + psum;                                                                                          \
    _Pragma("unroll") for (int i = 0; i < 16; ++i) {                                                               \
      o0[i] *= al_;                                                                                                \
      o1[i] *= al_;                                                                                                \
    }                                                                                                              \
    const bf16x8 pb0 = mk8(pack2(s[0], s[1]), pack2(s[2], s[3]), pack2(s[4], s[5]), pack2(s[6], s[7]));            \
    const bf16x8 pb1 = mk8(pack2(s[8], s[9]), pack2(s[10], s[11]), pack2(s[12], s[13]), pack2(s[14], s[15]));      \
    o0 = __builtin_amdgcn_mfma_f32_32x32x16_bf16(V00, pb0, o0, 0, 0, 0);                                           \
    o0 = __builtin_amdgcn_mfma_f32_32x32x16_bf16(V01, pb1, o0, 0, 0, 0);                                           \
    o1 = __builtin_amdgcn_mfma_f32_32x32x16_bf16(V10, pb0, o1, 0, 0, 0);                                           \
    o1 = __builtin_amdgcn_mfma_f32_32x32x16_bf16(V11, pb1, o1, 0, 0, 0);                                           \
  } while (0)
  {
    bf16x8 ak0, ak1, ak2, ak3, av00, av01, av10, av11, bk0, bk1, bk2, bk3, bv00, bv01, bv10, bv11;
    BAND_LOAD(ak0, ak1, ak2, ak3, av00, av01, av10, av11, kt0);
    for (int kt = kt0; kt < kt1; kt += 2) {
      BAND_LOAD(bk0, bk1, bk2, bk3, bv00, bv01, bv10, bv11, kt + 1);
      BAND_TILE(ak0, ak1, ak2, ak3, av00, av01, av10, av11, kt);
      BAND_LOAD(ak0, ak1, ak2, ak3, av00, av01, av10, av11, min(kt + 2, kt1 - 1));
      BAND_TILE(bk0, bk1, bk2, bk3, bv00, bv01, bv10, bv11, kt + 1);
    }
  }
#undef BAND_LOAD
#undef BAND_TILE
  ls += __shfl_xor(ls, 32);
  const float inv = 1.f / ls;
  u16* yp = Y + tokq * 1024 + 640 + h * 64 + 4 * g;
#pragma unroll
  for (int i4 = 0; i4 < 4; ++i4) {
    *(uint2*)(yp + 8 * i4) = make_uint2(pack2(o0[4 * i4] * inv, o0[4 * i4 + 1] * inv), pack2(o0[4 * i4 + 2] * inv, o0[4 * i4 + 3] * inv));
    *(uint2*)(yp + 32 + 8 * i4) = make_uint2(pack2(o1[4 * i4] * inv, o1[4 * i4 + 1] * inv), pack2(o1[4 * i4 + 2] * inv, o1[4 * i4 + 3] * inv));
  }
}

DEVI void conv_unit(const Params& p, const int l, const int U) {
  const u16* proj = (const u16*)(p.ws + WS_Z);
  u16* Y = (u16*)(p.ws + WS_Y);
  const float* cw = p.in[4] + (size_t)l * 3 * 256;
#pragma unroll 1
  for (int it = 0; it < 8; ++it) {
    const int item = TIDX + 512 * it;
    const int tok = U * 128 + (item >> 5), cg8 = (item & 31) * 8;
    const int s = tok & (S_ - 1);
    const uint4 cb = *(const uint4*)(proj + (size_t)tok * PW + C_CB + cg8);
    float acc[8];
#pragma unroll
    for (int e = 0; e < 8; ++e) acc[e] = 0.f;
#pragma unroll
    for (int j = 0; j < 3; ++j) {
      const int dt = 2 - j;
      if (s - dt >= 0) {
        const uint4 cc = *(const uint4*)(proj + (size_t)(tok - dt) * PW + C_CC + cg8);
        const uint4 ch = *(const uint4*)(proj + (size_t)(tok - dt) * PW + C_CH + cg8);
        const float4 w0 = *(const float4*)(cw + j * 256 + cg8);
        const float4 w1 = *(const float4*)(cw + j * 256 + cg8 + 4);
        acc[0] += w0.x * bflo(cc.x) * bflo(ch.x);
        acc[1] += w0.y * bfhi(cc.x) * bfhi(ch.x);
        acc[2] += w0.z * bflo(cc.y) * bflo(ch.y);
        acc[3] += w0.w * bfhi(cc.y) * bfhi(ch.y);
        acc[4] += w1.x * bflo(cc.z) * bflo(ch.z);
        acc[5] += w1.y * bfhi(cc.z) * bfhi(ch.z);
        acc[6] += w1.z * bflo(cc.w) * bflo(ch.w);
        acc[7] += w1.w * bfhi(cc.w) * bfhi(ch.w);
      }
    }
    uint4 o;
    o.x = pack2(bflo(cb.x) * acc[0], bfhi(cb.x) * acc[1]);
    o.y = pack2(bflo(cb.y) * acc[2], bfhi(cb.y) * acc[3]);
    o.z = pack2(bflo(cb.z) * acc[4], bfhi(cb.z) * acc[5]);
    o.w = pack2(bflo(cb.w) * acc[6], bfhi(cb.w) * acc[7]);
    *(uint4*)(Y + (size_t)tok * 1024 + cg8) = o;
  }
}

DEVI void memkv_unit(const Params& p, const int u) {
  const u16* WT = (const u16*)(p.ws + WS_WT);
  const u16* Mb = (const u16*)(p.ws + WS_MB);
  Sched S{};
  S.nM = 1; S.nN = 1; S.G = 1; S.c = 0;
  if (u < 8) {
    const int pm = u >> 2, pn = u & 3;
    S.A = (const char*)(Mb + (size_t)pm * 256 * 1024);
    S.B = (const char*)(WT + WT_KV + (size_t)pn * 256 * 1024);
    EpiStore16<0> E{(u16*)(p.ws + WS_KM) + (size_t)pm * 256 * 1024 + pn * 256, 1024};
    gemm_phase(1024, 1024, 1024, S, E);
  } else {
    const int v = u - 8, pm = v >> 1, pn = v & 1;
    S.A = (const char*)(WT + WT_KV + (size_t)(1024 + pm * 256) * 1024);
    S.B = (const char*)(Mb + (size_t)pn * 256 * 1024);
    EpiStore16<0> E{(u16*)(p.ws + WS_VTM) + (size_t)pm * 256 * 512 + pn * 256, 512};
    gemm_phase(1024, 1024, 1024, S, E);
  }
}

constexpr int NU_KV = 16, NU_DSA = 2048, NU_BAND = 768, NU_CONV = 256;
DEVI void phase_mixer(const Params& p, const int l) {
  extern __shared__ __attribute__((aligned(16))) unsigned char smem[];
  const int tid = TIDX;
  float* rb = (float*)(smem + OFF_RB);
  for (int i = tid; i < 6 * 192; i += 512) rb[i] = p.in[5][(size_t)l * 6 * 192 + i] * LOG2E_;
  volatile int* cur = (volatile int*)(smem + OFF_XB + 16);
  unsigned* ctr = (unsigned*)(p.ws + WS_BAR) + 16 + l;
  for (;;) {
    __syncthreads();
    if (tid == 0) *cur = (int)__hip_atomic_fetch_add(ctr, 1u, __ATOMIC_RELAXED, __HIP_MEMORY_SCOPE_AGENT);
    __syncthreads();
    const int u = *cur;
    if (u >= NU_KV + NU_DSA + NU_BAND + NU_CONV) break;
    if (u < NU_KV) memkv_unit(p, u);
    else if (u < NU_KV + NU_DSA) dsa_unit(p, u - NU_KV);
    else if (u < NU_KV + NU_DSA + NU_BAND) { for (int rb_ = 0; rb_ < PROBE_BD; ++rb_) band_unit(p, u - NU_KV - NU_DSA); }
    else conv_unit(p, l, u - NU_KV - NU_DSA - NU_BAND);
  }
}

DEVI Sched mk_sched(const void* A, const void* B, size_t aStepM, size_t bStepN, int nM, int nN) {
  Sched S{};
  S.A = (const char*)A; S.B = (const char*)B;
  S.aStepM = aStepM; S.aStepN = 0; S.bStepN = bStepN; S.bStepB = 0;
  S.nM = nM; S.nN = nN; S.G = (int)gridDim.x; S.c = BIDX;
  return S;
}
DEVI void phase_inproj(const Params& p) {
  const u16* X = (const u16*)(p.ws + WS_X);
  const u16* WT = (const u16*)(p.ws + WS_WT) + WT_IN;
  {
    const Sched S = mk_sched(X, WT, 256 * 1024 * 2, 256 * 1024 * 2, 128, 10);
    EpiProj E{(u16*)(p.ws + WS_Z), (const float*)(p.ws + WS_ROPED), (const float*)(p.ws + WS_ROPEI), (u16*)(p.ws + WS_IKC),
              (u16*)(p.ws + WS_DKC), (u16*)(p.ws + WS_DVC)};
    gemm_phase(1024, 1024, 1024, S, E);
  }
  {
    const Sched S = mk_sched(WT + (size_t)2560 * 1024, X, 256 * 1024 * 2, 256 * 1024 * 2, 2, 128);
    EpiStore16<0> E{(u16*)(p.ws + WS_VT), T_};
    gemm_phase(1024, 1024, 1024, S, E);
  }
}
DEVI void phase_gemm_res(const Params& p, const int which, const bool first) {
  const u16* A = (const u16*)(p.ws + (which == 0 ? WS_Y : (which == 1 ? WS_O : WS_H)));
  const u16* W = (const u16*)(p.ws + WS_WT) + (which == 0 ? WT_OUT : (which == 1 ? WT_MO : WT_FF2));
  const int K = (which == 2) ? 4096 : 1024;
  const Sched S = mk_sched(A, W, (size_t)256 * K * 2, (size_t)256 * K * 2, 128, 4);
  EpiRes E{p.out, (const u16*)(p.ws + WS_X), first ? p.in[0] : (const float*)nullptr};
  gemm_phase(K, K, K, S, E);
}
DEVI void phase_gemm_q(const Params& p) {
  const Sched S = mk_sched(p.ws + WS_X, (const u16*)(p.ws + WS_WT) + WT_MQ, 256 * 1024 * 2, 256 * 1024 * 2, 128, 4);
  EpiStore16<0> E{(u16*)(p.ws + WS_Q), 1024};
  gemm_phase(1024, 1024, 1024, S, E);
}
DEVI void phase_gemm_s(const Params& p) {
  Sched S = mk_sched(p.ws + WS_Q, p.ws + WS_KM, 256 * 1024 * 2, 256 * 2, 128, 4);
  S.aStepN = 256 * 2;
  S.bStepB = 256 * 1024 * 2;
  EpiSoftmax E{(u16*)(p.ws + WS_P)};
  gemm_phase(1024, 1024, 256, S, E);
}
DEVI void phase_gemm_pv(const Params& p) {
  Sched S = mk_sched(p.ws + WS_P, p.ws + WS_VTM, 256 * 1024 * 2, 256 * 512 * 2, 128, 4);
  S.aStepN = 256 * 2;
  S.bStepB = 256 * 2;
  EpiStore16<0> E{(u16*)(p.ws + WS_O), 1024};
  gemm_phase(1024, 512, 256, S, E);
}
DEVI void phase_gemm_ff1(const Params& p) {
  const Sched S = mk_sched(p.ws + WS_X, (const u16*)(p.ws + WS_WT) + WT_FF1, 256 * 1024 * 2, 256 * 1024 * 2, 128, 16);
  EpiStore16<1> E{(u16*)(p.ws + WS_H), 4096};
  gemm_phase(1024, 1024, 1024, S, E);
}

#define XB_TMO      128
#define XB_XCNT(j)  (256  + 64 * (j))
#define XB_XSUB(j)  (1280 + 64 * (j))
#define XB_XGEN(j)  (2304 + 64 * (j))
#define XB_TOP      3328
#define XB_TOPGEN   3392
#define XCD_BAR_WORDS 3456
#define XB_SPIN_CAP (1u << 18)
DEVI unsigned xb_ld(unsigned* p) { return __hip_atomic_load(p, __ATOMIC_RELAXED, __HIP_MEMORY_SCOPE_AGENT); }
DEVI unsigned xb_add(unsigned* p, unsigned v) { return __hip_atomic_fetch_add(p, v, __ATOMIC_RELAXED, __HIP_MEMORY_SCOPE_AGENT); }
DEVI unsigned xb_xcc_id() { return (unsigned)__builtin_amdgcn_s_getreg((3 << 11) | 20) & 0xFu; }
#define XB_SPIN(cond, bar) do { unsigned _sp = 0; while (cond) { __builtin_amdgcn_s_sleep(1); \
    if ((++_sp & 255u) == 0u) { if (xb_ld(&(bar)[XB_TMO])) break; if (_sp > XB_SPIN_CAP) { atomicAdd(&(bar)[XB_TMO], 1u); break; } } } } while (0)
struct XcdBarrier { unsigned* bar; unsigned x; volatile LAS unsigned* st; };
DEVI XcdBarrier xcd_barrier_post(unsigned* bar, volatile LAS unsigned* st) {
  XcdBarrier b; b.bar = bar; b.x = xb_xcc_id(); b.st = st;
  if (threadIdx.x == 0) (void)xb_add(&bar[XB_XCNT(b.x)], 1u);
  return b;
}
DEVI void xcd_barrier_complete(unsigned* bar, unsigned x, unsigned& nloc, unsigned& nx) {
  const unsigned G = gridDim.x * gridDim.y * gridDim.z;
  unsigned sum, cnt, mine, sp = 0u;
  for (;;) {
    sum = 0u; cnt = 0u; mine = 0u;
#pragma unroll
    for (unsigned j = 0; j < 16; ++j) { const unsigned c = xb_ld(&bar[XB_XCNT(j)]); sum += c; cnt += (c > 0u) ? 1u : 0u; mine = (j == x) ? c : mine; }
    if (sum == G) break;
    __builtin_amdgcn_s_sleep(1);
    if ((++sp & 255u) == 0u) { if (xb_ld(&bar[XB_TMO])) break; if (sp > XB_SPIN_CAP) { atomicAdd(&bar[XB_TMO], 1u); break; } }
  }
  nloc = mine > 0u ? mine : 1u; nx = cnt > 0u ? cnt : 1u;
}
DEVI void xcd_barrier(const XcdBarrier& b) {
  asm volatile("s_waitcnt vmcnt(0)" ::: "memory");
  __syncthreads();
  if (threadIdx.x == 0) {
    unsigned* bar = b.bar;
    __builtin_amdgcn_s_waitcnt(0);
    unsigned nloc = b.st[0], nx = b.st[1];
    if (nloc == 0u) { xcd_barrier_complete(bar, b.x, nloc, nx); b.st[0] = nloc; b.st[1] = nx; }
    const unsigned old = xb_add(&bar[XB_XSUB(b.x)], 1u);
    const unsigned gen = old / nloc;
    if (old + 1u == (gen + 1u) * nloc) {
      __builtin_amdgcn_fence(__ATOMIC_RELEASE, "agent");
      asm volatile("s_waitcnt vmcnt(0)" ::: "memory");
      const unsigned og = xb_add(&bar[XB_TOP], 1u);
      const unsigned tg = og / nx;
      if (og + 1u == (tg + 1u) * nx) xb_add(&bar[XB_TOPGEN], 1u);
      else XB_SPIN(xb_ld(&bar[XB_TOPGEN]) == tg, bar);
      __builtin_amdgcn_fence(__ATOMIC_ACQUIRE, "agent");
      xb_add(&bar[XB_XGEN(b.x)], 1u);
      asm volatile("s_waitcnt vmcnt(0)" ::: "memory");
    } else {
      XB_SPIN(xb_ld(&bar[XB_XGEN(b.x)]) == gen, bar);
      __builtin_amdgcn_fence(__ATOMIC_ACQUIRE, "agent");
      asm volatile("s_waitcnt vmcnt(0)" ::: "memory");
    }
  }
  __syncthreads();
}

DEVI void grid_seam(cg::grid_group& grid) {
  asm volatile("s_waitcnt vmcnt(0) lgkmcnt(0)" ::: "memory");
  __builtin_amdgcn_fence(__ATOMIC_RELEASE, "agent");
  asm volatile("s_waitcnt vmcnt(0)" ::: "memory");
  grid.sync();
  __builtin_amdgcn_fence(__ATOMIC_ACQUIRE, "agent");
  asm volatile("s_waitcnt vmcnt(0)" ::: "memory");
  __builtin_amdgcn_fence(__ATOMIC_RELEASE, "agent");
  asm volatile("s_waitcnt vmcnt(0)" ::: "memory");
  grid.sync();
  __builtin_amdgcn_fence(__ATOMIC_ACQUIRE, "agent");
  asm volatile("s_waitcnt vmcnt(0)" ::: "memory");
}
#define PHASE(stmt)                  \
  do {                               \
    Params q = p;                    \
    const int _z = opaque_s(0);      \
    q.ws = p.ws + _z;                \
    q.out = p.out + _z;              \
    stmt;                            \
  } while (0)
__global__ void __launch_bounds__(512, 2) mega(Params p) {
  cg::grid_group grid = cg::this_grid();
  extern __shared__ __attribute__((aligned(16))) unsigned char smem[];
  volatile LAS unsigned* xst = (volatile LAS unsigned*)((LAS unsigned char*)smem + OFF_XB);
  if (threadIdx.x < 4) xst[threadIdx.x] = 0u;
  __syncthreads();
  const XcdBarrier xb = xcd_barrier_post((unsigned*)(p.ws + WS_BAR), xst);
  PHASE(phase0(q));
  PHASE(convert_weights(q, 0));
  grid_seam(grid);
#pragma unroll 1
  for (int l = 0; l < NL_; ++l) {
    PHASE(phase_inproj(q));
    xcd_barrier(xb);
    PHASE(phase_mixer(q, l));
    xcd_barrier(xb);
    PHASE(phase_gemm_res(q, 0, l == 0));
    xcd_barrier(xb);
    PHASE(ln_phase(q, q.in[7] + l * 1024, q.in[8] + l * 1024, false));
    xcd_barrier(xb);
    PHASE(phase_gemm_q(q));
    xcd_barrier(xb);
    PHASE(phase_gemm_s(q));
    xcd_barrier(xb);
    PHASE(phase_gemm_pv(q));
    xcd_barrier(xb);
    PHASE(phase_gemm_res(q, 1, false));
    xcd_barrier(xb);
    PHASE(ln_phase(q, q.in[12] + l * 1024, q.in[13] + l * 1024, false));
    xcd_barrier(xb);
    PHASE(phase_gemm_ff1(q));
    xcd_barrier(xb);
    PHASE(phase_gemm_res(q, 2, false));
    xcd_barrier(xb);
    PHASE(ln_phase(q, q.in[16] + l * 1024, q.in[17] + l * 1024, l == NL_ - 1));
    if (l + 1 < NL_) PHASE(convert_weights(q, l + 1));
    xcd_barrier(xb);
  }
}

extern "C" void kernel_launch(void* const* d_in, const int* in_sizes, int n_in, void* d_out, int out_size, void* d_ws,
                              size_t ws_size, hipStream_t stream) {
  static int grid_blocks = 0;
  if (grid_blocks == 0) {
    if (n_in != 18 || ws_size < WS_END) {
      fprintf(stderr, "kernel_launch: unexpected n_in %d or ws_size %zu (need %zu)\n", n_in, ws_size, (size_t)WS_END);
      grid_blocks = -1;
      return;
    }
    int dev = 0, cus = 0, per_cu = 0;
    hipGetDevice(&dev);
    hipDeviceGetAttribute(&cus, hipDeviceAttributeMultiprocessorCount, dev);
    if (hipFuncSetAttribute((const void*)mega, hipFuncAttributeMaxDynamicSharedMemorySize, LDS_BYTES) != hipSuccess)
      fprintf(stderr, "kernel_launch: hipFuncSetAttribute failed\n");
    if (hipOccupancyMaxActiveBlocksPerMultiprocessor(&per_cu, (const void*)mega, 512, LDS_BYTES) != hipSuccess || per_cu < 1)
      per_cu = 1;
    (void)hipGetLastError();
    grid_blocks = cus * per_cu;
  }
  if (grid_blocks < 0) return;
  if (hipMemsetAsync((char*)d_ws + WS_BAR, 0, XCD_BAR_WORDS * sizeof(unsigned), stream) != hipSuccess)
    fprintf(stderr, "kernel_launch: hipMemsetAsync of the barrier words failed\n");
  Params p{};
  for (int i = 0; i < 18; ++i) p.in[i] = (const float*)d_in[i];
  p.out = (float*)d_out;
  p.ws = (unsigned char*)d_ws;
  void* args[] = {&p};
  hipError_t e = hipLaunchCooperativeKernel((const void*)mega, dim3(grid_blocks), dim3(512), args, LDS_BYTES, stream);
  if (e != hipSuccess) fprintf(stderr, "cooperative launch failed: %s (grid %d)\n", hipGetErrorString(e), grid_blocks);
}
```

```cpp
#include <hip/hip_runtime.h>
#include <hip/hip_cooperative_groups.h>
#include <cstdio>
#include <cmath>
namespace cg = cooperative_groups;

#define DEVI __device__ __forceinline__
typedef unsigned short u16;
using bf16x8 = __attribute__((ext_vector_type(8))) short;
using f32x4 = __attribute__((ext_vector_type(4))) float;
using f32x16 = __attribute__((ext_vector_type(16))) float;
typedef __bf16 bf2_t __attribute__((ext_vector_type(2)));
typedef float fl2_t __attribute__((ext_vector_type(2)));
typedef _Float16 h2_t __attribute__((ext_vector_type(2)));
typedef short s4_t __attribute__((ext_vector_type(4)));

constexpr int T_ = 32768, S_ = 16384, D_ = 1024, NL_ = 4, PW = 2560;
constexpr int C_CB = 0, C_CC = 256, C_CH = 512, C_DQ = 768, C_DK = 1152, C_DV = 1216, C_IQ = 1280, C_IK = 1536,
              C_IW = 1568, C_CQ = 1600, C_CK = 1984;
constexpr float ALPHA_ = 1.6817928305074290f;
constexpr float LOG2E_ = 1.4426950408889634f;
constexpr size_t MiB = 1u << 20;
constexpr size_t WS_BAR = 4096;
constexpr size_t WS_CTL = 0, WS_X = 1 * MiB, WS_WT = WS_X + 64 * MiB, WS_MB = WS_WT + 32 * MiB, WS_KM = WS_MB + MiB,
                 WS_VTM = WS_KM + MiB, WS_ROPED = WS_VTM + MiB, WS_ROPEI = WS_ROPED + 2 * MiB, WS_IKC = WS_ROPEI + MiB,
                 WS_DKC = WS_IKC + 2 * MiB, WS_DVC = WS_DKC + 4 * MiB, WS_Z = WS_DVC + 4 * MiB,
                 WS_VT = WS_Z + 160 * MiB, WS_Y = WS_Z + 192 * MiB, WS_Q = WS_Z, WS_P = WS_Z + 64 * MiB,
                 WS_O = WS_Z + 128 * MiB, WS_H = WS_Z, WS_END = WS_Z + 256 * MiB;
constexpr size_t WT_IN = 0, WT_OUT = 3072 * 1024, WT_MQ = WT_OUT + 1024 * 1024, WT_KV = WT_MQ + 1024 * 1024,
                 WT_MO = WT_KV + 2048 * 1024, WT_FF1 = WT_MO + 1024 * 1024, WT_FF2 = WT_FF1 + 4096 * 1024;
constexpr int LDS_BYTES = 147456;
constexpr int OFF_RB = 131072, OFF_CNT = OFF_RB + 4608, OFF_IW = OFF_CNT + 256, OFF_MISC = OFF_IW + 512,
              OFF_RED = OFF_MISC + 256, OFF_XB = OFF_RED + 8192;
constexpr int CAND_CAP = 768;
#ifndef PROBE_TK
#define PROBE_TK 1
#endif
#ifndef PROBE_AT
#define PROBE_AT 1
#endif
#ifndef PROBE_BD
#define PROBE_BD 1
#endif

struct Params {
  const float* in[18];
  float* out;
  unsigned char* ws;
};
__constant__ const float INV8_[8] = {1.0f, 0.19392274f, 0.03760603f, 0.0072926646f, 0.0014142136f, 0.0002742482f, 5.3182957e-05f, 1.0313385e-05f};
__constant__ const float INV4_[4] = {1.0f, 0.03760603f, 0.0014142136f, 5.3182957e-05f};

DEVI int opaque_v(int x) { asm volatile("" : "+v"(x)); return x; }
DEVI int opaque_s(int x) { asm volatile("" : "+s"(x)); return x; }
template <class Tp> DEVI Tp* opaque_p(Tp* x) { asm volatile("" : "+s"(x)); return x; }
#define TIDX opaque_v((int)threadIdx.x)
#define BIDX opaque_s((int)blockIdx.x)
DEVI unsigned pack2(float a, float b) {
  fl2_t x = {a, b};
  bf2_t y = __builtin_convertvector(x, bf2_t);
  return __builtin_bit_cast(unsigned, y);
}
DEVI u16 f2bf(float a) { return (u16)(pack2(a, 0.f) & 0xffffu); }
DEVI float bf2f(u16 h) { return __uint_as_float(((unsigned)h) << 16); }
DEVI float bflo(unsigned w) { return __uint_as_float(w << 16); }
DEVI float bfhi(unsigned w) { return __uint_as_float(w & 0xffff0000u); }
DEVI bf16x8 ld8(const u16* p) { return __builtin_bit_cast(bf16x8, *(const uint4*)p); }
DEVI bf16x8 mk8(unsigned a, unsigned b, unsigned c, unsigned d) {
  uint4 v = make_uint4(a, b, c, d);
  return __builtin_bit_cast(bf16x8, v);
}

#define LAS __attribute__((address_space(3)))
typedef unsigned u32x4 __attribute__((ext_vector_type(4)));
constexpr int BK = 64, HALF = 128, HTB = HALF * BK * 2;
DEVI int lds_byte(int r, int c) {
  const int st = (r >> 4) * 2 + (c >> 5), rr = r & 15, cc = c & 31, ob = rr * 64 + cc * 2;
  return st * 1024 + (ob ^ (((ob >> 9) & 1) << 5));
}
DEVI void stage_rc(int b, int& R, int& C) {
  const int st = b / 1024, sb = b % 1024, swz = sb ^ (((sb >> 9) & 1) << 5);
  R = (st >> 1) * 16 + swz / 64;
  C = (st & 1) * 32 + (swz % 64) / 2;
}
DEVI int perm32(int rho) {
  const int n = rho >> 4, i = rho & 15;
  return 8 * (i >> 2) + 4 * n + (i & 3);
}
DEVI void tile_coord(int v, int nM, int nN, int& pm, int& pn) {
  const int nwg = nM * nN;
  const int q = nwg / 8, r = nwg % 8, xcd = v % 8, off = v / 8;
  const int w = (xcd < r ? xcd * (q + 1) : r * (q + 1) + (xcd - r) * q) + off;
  const int nig = 8 * nN, gid = w / nig, fm = gid * 8, gsz = min(nM - fm, 8);
  pm = fm + ((w % nig) % gsz);
  pn = (w % nig) / gsz;
}
struct GUnit { const char* a; const char* b; int pm, pn; };
struct Sched {
  const char* A; const char* B;
  size_t aStepM, aStepN, bStepN, bStepB;
  int nM, nN, G, c;
  DEVI bool next(int i, GUnit& u) const {
    const int L = i * G + c;
    if (L >= nM * nN) return false;
    int pm, pn;
    tile_coord(L, nM, nN, pm, pn);
    u.pm = pm; u.pn = pn;
    u.a = A + (size_t)pm * aStepM + (size_t)pn * aStepN;
    u.b = B + (size_t)pn * bStepN + (size_t)(pm >> 6) * bStepB;
    return true;
  }
};

template <int ACT>
struct EpiStore16 {
  static constexpr bool PERM = true;
  u16* C; int ldc;
  DEVI void operator()(f32x4 (&acc)[2][2][4][2], const GUnit& u, int wr, int wc, int fr, int fq) const {
    const int row0 = u.pm * 256 + wr * 64 + fr, col0 = u.pn * 256 + wc * 32 + 8 * fq;
#pragma unroll
    for (int ai = 0; ai < 2; ++ai)
#pragma unroll
      for (int m = 0; m < 4; ++m) {
        u16* rowp = C + (size_t)(row0 + ai * HALF + m * 16) * ldc + col0;
#pragma unroll
        for (int bj = 0; bj < 2; ++bj) {
          f32x4 v0 = acc[ai][bj][m][0], v1 = acc[ai][bj][m][1];
          if (ACT == 1) {
#pragma unroll
            for (int j = 0; j < 4; ++j) {
              const float a = fmaxf(v0[j], 0.f), b = fmaxf(v1[j], 0.f);
              v0[j] = a * a;
              v1[j] = b * b;
            }
          }
          u32x4 w;
          w.x = pack2(v0[0], v0[1]); w.y = pack2(v0[2], v0[3]); w.z = pack2(v1[0], v1[1]); w.w = pack2(v1[2], v1[3]);
          *(u32x4*)(rowp + bj * HALF) = w;
        }
      }
  }
};
struct EpiProj {
  static constexpr bool PERM = true;
  u16* C; const float* ropeD; const float* ropeI; u16* IKc; u16* DKc; u16* DVc;
  DEVI void operator()(f32x4 (&acc)[2][2][4][2], const GUnit& u, int wr, int wc, int fr, int fq) const {
    const int row0 = u.pm * 256 + wr * 64 + fr, col0 = u.pn * 256 + wc * 32 + 8 * fq;
#pragma unroll
    for (int ai = 0; ai < 2; ++ai)
#pragma unroll
      for (int m = 0; m < 4; ++m) {
        const int row = row0 + ai * HALF + m * 16;
        u16* rowp = C + (size_t)row * PW + col0;
#pragma unroll
        for (int bj = 0; bj < 2; ++bj) {
          f32x4 v0 = acc[ai][bj][m][0], v1 = acc[ai][bj][m][1];
          const int gg = u.pn * 256 + bj * HALF + wc * 32;
          if (gg >= C_DQ && gg < C_DV && (gg & 63) == 0) {
            const f32x4 c0 = *(const f32x4*)(ropeD + (size_t)row * 16), c1 = *(const f32x4*)(ropeD + (size_t)row * 16 + 4);
            const f32x4 s0 = *(const f32x4*)(ropeD + (size_t)row * 16 + 8), s1 = *(const f32x4*)(ropeD + (size_t)row * 16 + 12);
#pragma unroll
            for (int j = 0; j < 4; ++j) {
              const float p0 = __shfl_xor(v0[j], 16), p1 = __shfl_xor(v1[j], 16);
              const float a0 = (fq == 0) ? (v0[j] * c0[j] - p0 * s0[j]) : (v0[j] * c0[j] + p0 * s0[j]);
              const float a1 = (fq == 0) ? (v1[j] * c1[j] - p1 * s1[j]) : (v1[j] * c1[j] + p1 * s1[j]);
              v0[j] = (fq < 2) ? a0 : v0[j];
              v1[j] = (fq < 2) ? a1 : v1[j];
            }
          } else if (gg >= C_IQ && gg < C_IW) {
            const f32x4 cs = *(const f32x4*)(ropeI + (size_t)row * 8), sn = *(const f32x4*)(ropeI + (size_t)row * 8 + 4);
#pragma unroll
            for (int j = 0; j < 4; ++j) {
              const float x1 = v0[j], x2 = v1[j];
              v0[j] = (fq == 0) ? (x1 * cs[j] - x2 * sn[j]) : x1;
              v1[j] = (fq == 0) ? (x2 * cs[j] + x1 * sn[j]) : x2;
            }
          }
          u32x4 w;
          w.x = pack2(v0[0], v0[1]); w.y = pack2(v0[2], v0[3]); w.z = pack2(v1[0], v1[1]); w.w = pack2(v1[2], v1[3]);
          u16* dst = rowp + bj * HALF;
          if (gg == C_IK) dst = IKc + (size_t)row * 32 + 8 * fq;
          else if (gg >= C_DK && gg < C_DV) dst = DKc + (size_t)row * 64 + (gg - C_DK) + 8 * fq;
          else if (gg >= C_DV && gg < C_IQ) dst = DVc + (size_t)row * 64 + (gg - C_DV) + 8 * fq;
          *(u32x4*)dst = w;
        }
      }
  }
};
struct EpiRes {
  static constexpr bool PERM = false;
  float* R; const u16* Xres; const float* xin;
  DEVI void operator()(f32x4 (&acc)[2][2][4][2], const GUnit& u, int wr, int wc, int fr, int fq) const {
    const int row0 = u.pm * 256 + wr * 64 + fr, col0 = u.pn * 256 + wc * 32 + 4 * fq;
#pragma unroll
    for (int ai = 0; ai < 2; ++ai)
#pragma unroll
      for (int m = 0; m < 4; ++m) {
        const size_t ro = (size_t)(row0 + ai * HALF + m * 16) * 1024 + col0;
#pragma unroll
        for (int bj = 0; bj < 2; ++bj)
#pragma unroll
          for (int n = 0; n < 2; ++n) {
            const size_t o = ro + bj * HALF + n * 16;
            f32x4 old;
            if (xin) old = *(const f32x4*)(xin + o);
            else {
              const uint2 xr = *(const uint2*)(Xres + o);
              old = (f32x4){bflo(xr.x), bfhi(xr.x), bflo(xr.y), bfhi(xr.y)};
            }
            *(f32x4*)(R + o) = old * ALPHA_ + acc[ai][bj][m][n];
          }
      }
  }
};
struct EpiSoftmax {
  static constexpr bool PERM = true;
  u16* C;
  DEVI void operator()(f32x4 (&acc)[2][2][4][2], const GUnit& u, int wr, int wc, int fr, int fq) const {
    extern __shared__ __attribute__((aligned(16))) unsigned char smem[];
    float* red = (float*)(smem + OFF_RED);
    const float sc2 = 0.0625f * LOG2E_;
#pragma unroll
    for (int ai = 0; ai < 2; ++ai)
#pragma unroll
      for (int m = 0; m < 4; ++m) {
        float mx = -__builtin_inff();
#pragma unroll
        for (int bj = 0; bj < 2; ++bj)
#pragma unroll
          for (int n = 0; n < 2; ++n)
#pragma unroll
            for (int j = 0; j < 4; ++j) mx = fmaxf(mx, acc[ai][bj][m][n][j]);
        mx = fmaxf(mx, __shfl_xor(mx, 16));
        mx = fmaxf(mx, __shfl_xor(mx, 32));
        float sum = 0.f;
#pragma unroll
        for (int bj = 0; bj < 2; ++bj)
#pragma unroll
          for (int n = 0; n < 2; ++n)
#pragma unroll
            for (int j = 0; j < 4; ++j) sum += __builtin_amdgcn_exp2f((acc[ai][bj][m][n][j] - mx) * sc2);
        sum += __shfl_xor(sum, 16);
        sum += __shfl_xor(sum, 32);
        if (fq == 0) *(float2*)(red + ((ai * HALF + wr * 64 + m * 16 + fr) * 4 + wc) * 2) = make_float2(mx, sum);
        __builtin_amdgcn_sched_barrier(0);
      }
    __syncthreads();
    u16* cbase = C + (size_t)(u.pm * 256 + wr * 64 + fr) * 1024 + u.pn * 256 + wc * 32 + 8 * fq;
#pragma unroll
    for (int ai = 0; ai < 2; ++ai)
#pragma unroll
      for (int m = 0; m < 4; ++m) {
        const int rl = ai * HALF + wr * 64 + m * 16 + fr;
        const f32x4 ra = *(const f32x4*)(red + rl * 8), rb = *(const f32x4*)(red + rl * 8 + 4);
        const float mx = fmaxf(fmaxf(ra[0], ra[2]), fmaxf(rb[0], rb[2]));
        const float L = ra[1] * __builtin_amdgcn_exp2f((ra[0] - mx) * sc2) + ra[3] * __builtin_amdgcn_exp2f((ra[2] - mx) * sc2) +
                        rb[1] * __builtin_amdgcn_exp2f((rb[0] - mx) * sc2) + rb[3] * __builtin_amdgcn_exp2f((rb[2] - mx) * sc2);
        const float inv = 1.f / L;
        u16* rowp = cbase + (size_t)(ai * HALF + m * 16) * 1024;
#pragma unroll
        for (int bj = 0; bj < 2; ++bj) {
          f32x4 v0 = acc[ai][bj][m][0], v1 = acc[ai][bj][m][1];
#pragma unroll
          for (int j = 0; j < 4; ++j) {
            v0[j] = __builtin_amdgcn_exp2f((v0[j] - mx) * sc2) * inv;
            v1[j] = __builtin_amdgcn_exp2f((v1[j] - mx) * sc2) * inv;
          }
          u32x4 w;
          w.x = pack2(v0[0], v0[1]); w.y = pack2(v0[2], v0[3]); w.z = pack2(v1[0], v1[1]); w.w = pack2(v1[2], v1[3]);
          *(u32x4*)(rowp + bj * HALF) = w;
        }
        __builtin_amdgcn_sched_barrier(0);
      }
    __syncthreads();
  }
};

template <class Epi>
DEVI void gemm_phase(const int lda, const int ldb, const int K, const Sched& S, const Epi& E) {
  extern __shared__ __attribute__((aligned(16))) unsigned char smem[];
  LAS unsigned char* lds = (LAS unsigned char*)smem;
  const int tid = TIDX, wid = __builtin_amdgcn_readfirstlane(tid >> 6), lane = tid & 63, wr = wid >> 2, wc = wid & 3,
            fr = lane & 15, fq = lane >> 4;
  const int nt = opaque_s(K) / BK;
  unsigned voffA[2], voffB[2];
#pragma unroll
  for (int i = 0; i < 2; ++i) {
    int R, C;
    stage_rc(tid * 16 + i * 8192, R, C);
    const int Rb = Epi::PERM ? ((R & ~31) + perm32(R & 31)) : R;
    voffA[i] = (unsigned)(R * lda + C) * 2u;
    voffB[i] = (unsigned)(Rb * ldb + C) * 2u;
  }
  const size_t kstep = (size_t)(BK * 2);
  const size_t hstepA = (size_t)HALF * lda * 2, hstepB = (size_t)HALF * ldb * 2;
  const unsigned ldsw = (unsigned)wid * 1024u;
  const int aoff = lds_byte(wr * 64 + fr, fq * 8), boff = lds_byte(wc * 32 + fr, fq * 8);
#define PG8_SA(b, h) (((b) * 2 + (h)) * HTB)
#define PG8_SB(b, h) ((4 + (b) * 2 + (h)) * HTB)
#define PG8_STAGE(bufoff, gbase, voff)                                                                                \
  do {                                                                                                                \
    _Pragma("unroll") for (int _i = 0; _i < 2; ++_i) __builtin_amdgcn_global_load_lds(                                \
        (const unsigned*)((const char*)(gbase) + (voff)[_i]), (LAS unsigned*)(lds + (bufoff) + ldsw + _i * 8192), 16, 0, 0); \
  } while (0)
#define PG8_LDA(dst, b, h)                                                                                            \
  do {                                                                                                                \
    _Pragma("unroll") for (int m = 0; m < 4; ++m) _Pragma("unroll") for (int k = 0; k < 2; ++k) dst[m][k] =           \
        *(const LAS bf16x8*)(lds + PG8_SA(b, h) + aoff + m * 2048 + k * 1024);                                        \
  } while (0)
#define PG8_LDB(dst, b, h)                                                                                            \
  do {                                                                                                                \
    _Pragma("unroll") for (int n = 0; n < 2; ++n) _Pragma("unroll") for (int k = 0; k < 2; ++k) dst[n][k] =           \
        *(const LAS bf16x8*)(lds + PG8_SB(b, h) + boff + n * 2048 + k * 1024);                                        \
  } while (0)
#define PG8_MMA(ai, bj, At, Bt)                                                                                       \
  do {                                                                                                                \
    __builtin_amdgcn_s_setprio(1);                                                                                    \
    _Pragma("unroll") for (int m = 0; m < 4; ++m) _Pragma("unroll") for (int n = 0; n < 2; ++n)                       \
        _Pragma("unroll") for (int k = 0; k < 2; ++k) acc[ai][bj][m][n] =                                             \
            __builtin_amdgcn_mfma_f32_16x16x32_bf16(Bt[n][k], At[m][k], acc[ai][bj][m][n], 0, 0, 0);                  \
    __builtin_amdgcn_s_setprio(0);                                                                                    \
  } while (0)
#define PG8_WAIT_V(n) asm volatile("s_waitcnt vmcnt(" #n ")" ::: "memory")
#define PG8_WAIT_L(n) asm volatile("s_waitcnt lgkmcnt(" #n ")" ::: "memory")
#define PG8_BAR __builtin_amdgcn_s_barrier()
#define PG8_SCHED __builtin_amdgcn_sched_barrier(0)
  GUnit cur, nxt;
  int ui = 0;
  if (S.next(0, cur)) {
    f32x4 acc[2][2][4][2];
#pragma unroll
    for (int a = 0; a < 2; ++a)
#pragma unroll
      for (int b = 0; b < 2; ++b)
#pragma unroll
        for (int m = 0; m < 4; ++m)
#pragma unroll
          for (int n = 0; n < 2; ++n) acc[a][b][m][n] = (f32x4){0.f, 0.f, 0.f, 0.f};
    bf16x8 At[4][2], B0[2][2], B1[2][2];
    const char* cA = cur.a;
    const char* cB = cur.b;
    PG8_WAIT_V(0);
    PG8_STAGE(PG8_SB(0, 0), cB, voffB); PG8_STAGE(PG8_SA(0, 0), cA, voffA);
    PG8_STAGE(PG8_SB(0, 1), cB + hstepB, voffB); PG8_STAGE(PG8_SA(0, 1), cA + hstepA, voffA);
    if (wr == 1) PG8_BAR;
    PG8_WAIT_V(4); PG8_BAR;
    PG8_STAGE(PG8_SB(1, 0), cB + kstep, voffB); PG8_STAGE(PG8_SA(1, 0), cA + kstep, voffA);
    PG8_STAGE(PG8_SB(1, 1), cB + hstepB + kstep, voffB);
    PG8_WAIT_V(6); PG8_BAR;
    for (;;) {
      const bool has_next = S.next(ui + 1, nxt);
      const char* nA = has_next ? nxt.a : cA;
      const char* nB = has_next ? nxt.b : cB;
      for (int t = 0; t < nt; t += 2) {
        const bool last = (t == nt - 2);
        const char* a1 = cA + (size_t)(t + 1) * kstep;
        const char* a2 = last ? nA : cA + (size_t)(t + 2) * kstep;
        const char* b2 = last ? nB : cB + (size_t)(t + 2) * kstep;
        const char* a3 = a2 + kstep;
        const char* b3 = b2 + kstep;
        PG8_LDB(B0, 0, 0); PG8_SCHED; PG8_LDA(At, 0, 0); PG8_STAGE(PG8_SA(1, 1), a1 + hstepA, voffA);
        PG8_WAIT_L(8); PG8_BAR; PG8_WAIT_L(0); PG8_MMA(0, 0, At, B0); PG8_BAR; PG8_SCHED;
        PG8_LDB(B1, 0, 1); PG8_STAGE(PG8_SB(0, 0), b2, voffB);
        PG8_BAR; PG8_WAIT_L(0); PG8_MMA(0, 1, At, B1); PG8_BAR;
        PG8_LDA(At, 0, 1); PG8_STAGE(PG8_SA(0, 0), a2, voffA);
        PG8_BAR; PG8_WAIT_L(0); PG8_MMA(1, 0, At, B0); PG8_BAR; PG8_SCHED;
        PG8_STAGE(PG8_SB(0, 1), b2 + hstepB, voffB);
        PG8_WAIT_V(6); PG8_BAR; PG8_MMA(1, 1, At, B1); PG8_BAR;
        PG8_LDB(B0, 1, 0); PG8_SCHED; PG8_LDA(At, 1, 0); PG8_STAGE(PG8_SA(0, 1), a2 + hstepA, voffA);
        PG8_WAIT_L(8); PG8_BAR; PG8_WAIT_L(0); PG8_MMA(0, 0, At, B0); PG8_BAR; PG8_SCHED;
        PG8_LDB(B1, 1, 1); PG8_STAGE(PG8_SB(1, 0), b3, voffB);
        PG8_BAR; PG8_WAIT_L(0); PG8_MMA(0, 1, At, B1); PG8_BAR;
        PG8_LDA(At, 1, 1); PG8_STAGE(PG8_SA(1, 0), a3, voffA);
        PG8_BAR; PG8_WAIT_L(0); PG8_MMA(1, 0, At, B0); PG8_BAR; PG8_SCHED;
        PG8_STAGE(PG8_SB(1, 1), b3 + hstepB, voffB);
        PG8_WAIT_V(6); PG8_BAR; PG8_MMA(1, 1, At, B1); PG8_BAR;
      }
      E(acc, cur, wr, wc, fr, fq);
      if (!has_next) break;
#pragma unroll
      for (int a = 0; a < 2; ++a)
#pragma unroll
        for (int b = 0; b < 2; ++b)
#pragma unroll
          for (int m = 0; m < 4; ++m)
#pragma unroll
            for (int n = 0; n < 2; ++n) acc[a][b][m][n] = (f32x4){0.f, 0.f, 0.f, 0.f};
      cur = nxt; cA = nA; cB = nB; ++ui;
    }
    PG8_WAIT_V(0);
    if (wr == 0) PG8_BAR;
    PG8_BAR;
  }
  __syncthreads();
#undef PG8_SA
#undef PG8_SB
#undef PG8_STAGE
#undef PG8_LDA
#undef PG8_LDB
#undef PG8_MMA
}

DEVI void sincos_acc(float ang, float& c, float& s) {
  const double TWO_PI = 6.283185307179586476925286766559;
  double a = (double)ang;
  double k = rint(a * (1.0 / TWO_PI));
  double r = a - k * TWO_PI;
  double r2 = r * r;
  double sn = 0.0, cs = 0.0;
  double ts = r, tc = 1.0;
#pragma unroll
  for (int n = 0; n < 12; ++n) {
    sn += ts;
    cs += tc;
    ts *= -r2 / (double)((2 * n + 2) * (2 * n + 3));
    tc *= -r2 / (double)((2 * n + 1) * (2 * n + 2));
  }
  c = (float)cs;
  s = (float)sn;
}

DEVI void phase0(const Params& p) {
  const int tid0 = TIDX, bid0 = BIDX;
  const long gtid = (long)bid0 * 512 + tid0, gsz = (long)gridDim.x * 512;
  {
    const float4* x4 = (const float4*)p.in[0];
    uint2* X2 = (uint2*)(p.ws + WS_X);
    for (long i = gtid; i < (long)T_ * D_ / 4; i += gsz) {
      float4 v = x4[i];
      X2[i] = make_uint2(pack2(v.x, v.y), pack2(v.z, v.w));
    }
    const float4* m4 = (const float4*)p.in[1];
    uint2* M2 = (uint2*)(p.ws + WS_MB);
    for (long i = gtid; i < 512L * 1024 / 4; i += gsz) {
      float4 v = m4[i];
      M2[i] = make_uint2(pack2(v.x, v.y), pack2(v.z, v.w));
    }
  }
  {
    const int* pos = (const int*)p.in[2];
    float* rd = (float*)(p.ws + WS_ROPED);
    float* ri = (float*)(p.ws + WS_ROPEI);
    for (long i = gtid; i < (long)T_ * 12; i += gsz) {
      const int t = (int)(i / 12), f = (int)(i % 12);
      const float ps = (float)pos[t];
      float c, s;
      if (f < 8) {
        sincos_acc(ps * INV8_[f], c, s);
        rd[t * 16 + f] = c;
        rd[t * 16 + 8 + f] = s;
      } else {
        sincos_acc(ps * INV4_[f - 8], c, s);
        ri[t * 8 + (f - 8)] = c;
        ri[t * 8 + 4 + (f - 8)] = s;
      }
    }
  }
  if (bid0 == 0 && tid0 < 64) ((unsigned*)(p.ws + WS_CTL))[tid0] = 0u;
}

DEVI int map_in(int nd) {
  if (nd < 1576) return nd;
  if (nd < 1600) return -1;
  if (nd < 2368) return nd - 24;
  if (nd < 2560) return -1;
  if (nd < 2944) return nd - 216;
  return -1;
}

DEVI void convert_weights(const Params& p, int l) {
  extern __shared__ __attribute__((aligned(16))) unsigned char smem[];
  float* lt = (float*)smem;
  u16* WT = (u16*)(p.ws + WS_WT);
  const int t = TIDX;
  for (int tile = BIDX; tile < 4096; tile += gridDim.x) {
    const float* src;
    u16* dst;
    int K, Nsrc, mode = 0, tl;
    if (tile < 768) { src = p.in[3] + (size_t)l * 1024 * 2728; dst = WT + WT_IN; K = 1024; Nsrc = 2728; mode = 1; tl = tile; }
    else if (tile < 1024) { src = p.in[6] + (size_t)l * 1024 * 1024; dst = WT + WT_OUT; K = 1024; Nsrc = 1024; tl = tile - 768; }
    else if (tile < 1280) { src = p.in[9] + (size_t)l * 1024 * 1024; dst = WT + WT_MQ; K = 1024; Nsrc = 1024; tl = tile - 1024; }
    else if (tile < 1792) { src = p.in[10] + (size_t)l * 1024 * 2048; dst = WT + WT_KV; K = 1024; Nsrc = 2048; tl = tile - 1280; }
    else if (tile < 2048) { src = p.in[11] + (size_t)l * 1024 * 1024; dst = WT + WT_MO; K = 1024; Nsrc = 1024; tl = tile - 1792; }
    else if (tile < 3072) { src = p.in[14] + (size_t)l * 1024 * 4096; dst = WT + WT_FF1; K = 1024; Nsrc = 4096; tl = tile - 2048; }
    else { src = p.in[15] + (size_t)l * 4096 * 1024; dst = WT + WT_FF2; K = 4096; Nsrc = 1024; tl = tile - 3072; }
    const int nkt = K / 64;
    const int nt = tl / nkt, kt = tl % nkt;
    {
      const int n = t & 63, k0 = t >> 6;
      const int nd = nt * 64 + n;
      const int ns = mode ? map_in(nd) : nd;
#pragma unroll
      for (int i = 0; i < 8; ++i) {
        const int k = k0 + 8 * i;
        lt[k * 65 + n] = (ns >= 0) ? src[(size_t)(kt * 64 + k) * Nsrc + ns] : 0.f;
      }
    }
    __syncthreads();
    {
      const int n2 = t >> 3, ks = (t & 7) * 8;
      uint4 o;
      o.x = pack2(lt[(ks + 0) * 65 + n2], lt[(ks + 1) * 65 + n2]);
      o.y = pack2(lt[(ks + 2) * 65 + n2], lt[(ks + 3) * 65 + n2]);
      o.z = pack2(lt[(ks + 4) * 65 + n2], lt[(ks + 5) * 65 + n2]);
      o.w = pack2(lt[(ks + 6) * 65 + n2], lt[(ks + 7) * 65 + n2]);
      *(uint4*)(dst + (size_t)(nt * 64 + n2) * K + kt * 64 + ks) = o;
    }
    __syncthreads();
  }
}

DEVI float wave_sum(float v) {
  v += __shfl_xor(v, 32);
  v += __shfl_xor(v, 16);
  v += __shfl_xor(v, 8);
  v += __shfl_xor(v, 4);
  v += __shfl_xor(v, 2);
  v += __shfl_xor(v, 1);
  return v;
}
DEVI void ln_phase(const Params& p, const float* g, const float* b, const bool write_f32) {
  const int tidl = TIDX;
  const int wave = tidl >> 6, lane = tidl & 63;
  float* R = p.out;
  u16* X = (u16*)(p.ws + WS_X);
  float4 gg[4], bb[4];
#pragma unroll
  for (int i = 0; i < 4; ++i) {
    gg[i] = ((const float4*)g)[lane + 64 * i];
    bb[i] = ((const float4*)b)[lane + 64 * i];
  }
  for (int row = BIDX * 8 + wave; row < T_; row += gridDim.x * 8) {
    float4* rp = (float4*)(R + (size_t)row * 1024);
    float4 v[4];
#pragma unroll
    for (int i = 0; i < 4; ++i) v[i] = rp[lane + 64 * i];
    float s = 0.f;
#pragma unroll
    for (int i = 0; i < 4; ++i) s += v[i].x + v[i].y + v[i].z + v[i].w;
    const float mu = wave_sum(s) * (1.f / 1024.f);
    float q = 0.f;
#pragma unroll
    for (int i = 0; i < 4; ++i) {
      v[i].x -= mu; v[i].y -= mu; v[i].z -= mu; v[i].w -= mu;
      q += v[i].x * v[i].x + v[i].y * v[i].y + v[i].z * v[i].z + v[i].w * v[i].w;
    }
    const float rs = rsqrtf(wave_sum(q) * (1.f / 1024.f) + 1e-5f);
    uint2* xp = (uint2*)(X + (size_t)row * 1024);
#pragma unroll
    for (int i = 0; i < 4; ++i) {
      float4 o;
      o.x = v[i].x * rs * gg[i].x + bb[i].x;
      o.y = v[i].y * rs * gg[i].y + bb[i].y;
      o.z = v[i].z * rs * gg[i].z + bb[i].z;
      o.w = v[i].w * rs * gg[i].w + bb[i].w;
      if (write_f32) rp[lane + 64 * i] = o;
      xp[lane + 64 * i] = make_uint2(pack2(o.x, o.y), pack2(o.z, o.w));
    }
  }
}

DEVI unsigned mono_key(float s) {
  unsigned u = __float_as_uint(s);
  return (u & 0x80000000u) ? ~u : (u | 0x80000000u);
}

DEVI void dsa_unit(const Params& p, const int u) {
  extern __shared__ __attribute__((aligned(16))) unsigned char smem[];
  const int tid = TIDX, lane = tid & 63, wave = __builtin_amdgcn_readfirstlane(tid >> 6);
  const int c = 255 - (u >> 3), b = (u >> 2) & 1, sub = u & 3;
  const int tok0 = b * S_ + c * 64 + sub * 16;
  const int N = (c + 1) * 64;
  const u16* proj = (const u16*)(p.ws + WS_Z);
  u16* Y = (u16*)(p.ws + WS_Y);
  float* cand_s = (float*)smem;
  u16* cand_i = (u16*)(smem + 49152);
  unsigned* h2 = (unsigned*)(smem + 73728);
  float* mem_s = (float*)(smem + 73728);
  unsigned* mem_i = (unsigned*)(smem + 73728 + 8192);
  unsigned* bm = (unsigned*)(smem + 90112);
  u16* sel = (u16*)(smem + 122880);
  int* candcnt = (int*)(smem + OFF_CNT);
  int* tbin = candcnt + 16;
  int* tb2a = candcnt + 32;
  int* base2 = candcnt + 48;
  int* mcnt = (int*)(smem + OFF_MISC);
  int* flag = mcnt + 16;
  float* iwl = (float*)(smem + OFF_IW);

  if (c < 4) {
    for (int i = tid; i < 16 * 256; i += 512) sel[i] = (u16)(i & 255);
    __syncthreads();
  } else {
   for (int rep_tk = 0; rep_tk < PROBE_TK; ++rep_tk) {
    if (tid < 128) iwl[tid] = bf2f(proj[(size_t)(tok0 + (tid >> 3)) * PW + C_IW + (tid & 7)]) * 0.17677669529663687f;
    __syncthreads();
    const int rho = lane & 31, hh = lane >> 5;
    bf16x8 af[4][2];
    float sg[4][16];
#pragma unroll
    for (int rt = 0; rt < 4; ++rt) {
      const int qi = 4 * rt + 2 * (rho >> 4) + ((rho >> 2) & 1);
      const int hd = (rho & 3) + 4 * ((rho >> 3) & 1);
      const float w = iwl[qi * 8 + hd];
#pragma unroll
      for (int s = 0; s < 2; ++s) {
        const uint4 raw = *(const uint4*)(proj + (size_t)(tok0 + qi) * PW + C_IQ + hd * 32 + 16 * s + 8 * hh);
        af[rt][s] = mk8(pack2(bflo(raw.x) * w, bfhi(raw.x) * w), pack2(bflo(raw.y) * w, bfhi(raw.y) * w),
                        pack2(bflo(raw.z) * w, bfhi(raw.z) * w), pack2(bflo(raw.w) * w, bfhi(raw.w) * w));
      }
#pragma unroll
      for (int i = 0; i < 16; ++i) {
        const float w2 = iwl[(4 * rt + 2 * (i >> 3) + hh) * 8 + (i & 7)];
        sg[rt][i] = (w2 > 0.f) ? 1.0f : -1.0f;
      }
    }
    bf16x8 al[2];
    {
      const int ii = (rho & 3) + 4 * (rho >> 3), gq = (rho >> 2) & 1;
      const int qi = 2 * (ii & 7) + gq, part = ii >> 3;
#pragma unroll
      for (int s = 0; s < 2; ++s) {
        float v[8];
#pragma unroll
        for (int j = 0; j < 8; ++j) v[j] = 0.f;
#pragma unroll
        for (int hd = 0; hd < 8; ++hd) {
          const float w = iwl[qi * 8 + hd];
          const uint4 raw = *(const uint4*)(proj + (size_t)(tok0 + qi) * PW + C_IQ + hd * 32 + 16 * s + 8 * hh);
          const unsigned r0 = pack2(bflo(raw.x) * w, bfhi(raw.x) * w), r1 = pack2(bflo(raw.y) * w, bfhi(raw.y) * w),
                         r2 = pack2(bflo(raw.z) * w, bfhi(raw.z) * w), r3 = pack2(bflo(raw.w) * w, bfhi(raw.w) * w);
          v[0] += bflo(r0); v[1] += bfhi(r0); v[2] += bflo(r1); v[3] += bfhi(r1);
          v[4] += bflo(r2); v[5] += bfhi(r2); v[6] += bflo(r3); v[7] += bfhi(r3);
        }
        unsigned hi[4];
#pragma unroll
        for (int j = 0; j < 4; ++j) hi[j] = pack2(v[2 * j], v[2 * j + 1]);
        if (part) {
#pragma unroll
          for (int j = 0; j < 4; ++j) hi[j] = pack2(v[2 * j] - bflo(hi[j]), v[2 * j + 1] - bfhi(hi[j]));
        }
        al[s] = mk8(hi[0], hi[1], hi[2], hi[3]);
      }
    }
    const int ntile = N >> 5;
    const u16* ikbase = (const u16*)(p.ws + WS_IKC) + (size_t)b * S_ * 32;
    const int ikoff = (lane & 31) * 32 + 8 * hh;
    for (int attempt = 0; attempt < 2; ++attempt) {
      const int ss = (attempt == 0 && N >= 4096) ? 8 : 1;
      const unsigned rank_t = (ss == 8) ? 64u : 256u;
      {
        uint4* h4 = (uint4*)smem;
        const uint4 z = make_uint4(0, 0, 0, 0);
        for (int i = tid; i < 131072 / 16; i += 512) h4[i] = z;
      }
      if (tid < 64) candcnt[tid] = 0;
      if (tid < 32) mcnt[tid] = 0;
      __syncthreads();
      float Lf[8];
#pragma unroll
      for (int i = 0; i < 8; ++i) Lf[i] = 0.f;
      for (int pass = 0; pass < 2; ++pass) {
        const int st = (pass == 0) ? ss : 1;
        if (pass == 1) {
#pragma unroll
          for (int i = 0; i < 8; ++i) {
            const unsigned k0 = (unsigned)tbin[2 * i + hh];
            Lf[i] = __uint_as_float((k0 & 0x80000000u) ? (k0 & 0x7fffffffu) : ~k0);
          }
        }
#define IK_LOAD(B0, B1, KT)                                        \
  do {                                                             \
    B0 = ld8(ikbase + (size_t)(KT) * 1024 + ikoff);                \
    B1 = ld8(ikbase + (size_t)(KT) * 1024 + ikoff + 16);           \
  } while (0)
#define SCORE2(RT, CB0, CB1, S0, S1)                                                                               \
  do {                                                                                                             \
    f32x16 acc = {};                                                                                               \
    acc = __builtin_amdgcn_mfma_f32_32x32x16_bf16(af[RT][0], CB0, acc, 0, 0, 0);                                   \
    acc = __builtin_amdgcn_mfma_f32_32x32x16_bf16(af[RT][1], CB1, acc, 0, 0, 0);                                   \
    S0 = la[2 * (RT)] + la[2 * (RT) + 8];                                                                          \
    S1 = la[2 * (RT) + 1] + la[2 * (RT) + 9];                                                                      \
    S0 = __builtin_fmaf(__builtin_fabsf(acc[0]), sg[RT][0], S0);     \
    S1 = __builtin_fmaf(__builtin_fabsf(acc[8]), sg[RT][8], S1);                                                   \
    _Pragma("unroll") for (int i = 1; i < 8; ++i)                                                                  \
        asm("v_fma_f32 %0, |%1|, %2, %0" : "+v"(S0) : "v"(acc[i]), "v"(sg[RT][i]));                                \
    _Pragma("unroll") for (int i = 9; i < 16; ++i)                                                                 \
        asm("v_fma_f32 %0, |%1|, %2, %0" : "+v"(S1) : "v"(acc[i]), "v"(sg[RT][i]));                                \
  } while (0)
#define HIST1(SC, QI)                                                                                              \
  do {                                                                                                             \
    const int bin = (int)(mono_key(SC) >> 20);                                                                     \
    atomicAdd((unsigned*)smem + (QI) * 2048 + (bin >> 1), 1u << ((bin & 1) * 16));                                 \
  } while (0)
#define TILE_HIST(CB0, CB1, KT)                                                                                    \
  do {                                                                                                             \
    f32x16 la = {};                                                                                                \
    la = __builtin_amdgcn_mfma_f32_32x32x16_bf16(al[0], CB0, la, 0, 0, 0);                                         \
    la = __builtin_amdgcn_mfma_f32_32x32x16_bf16(al[1], CB1, la, 0, 0, 0);                                         \
    _Pragma("unroll") for (int rt = 0; rt < 4; ++rt) {                                                             \
      float s0, s1;                                                                                                \
      SCORE2(rt, CB0, CB1, s0, s1);                                                                                \
      HIST1(s0, 4 * rt + hh);                                                                                      \
      HIST1(s1, 4 * rt + 2 + hh);                                                                                  \
    }                                                                                                              \
  } while (0)
#define TILE_COLLECT(CB0, CB1, KT)                                                                                 \
  do {                                                                                                             \
    const int key = (KT) * 32 + (lane & 31);                                                                       \
    f32x16 la = {};                                                                                                \
    la = __builtin_amdgcn_mfma_f32_32x32x16_bf16(al[0], CB0, la, 0, 0, 0);                                         \
    la = __builtin_amdgcn_mfma_f32_32x32x16_bf16(al[1], CB1, la, 0, 0, 0);                                         \
    _Pragma("unroll") for (int rp = 0; rp < 2; ++rp) {                                                             \
      float sa, sb, sc_, sd;                                                                                       \
      SCORE2(2 * rp, CB0, CB1, sa, sb);                                                                            \
      SCORE2(2 * rp + 1, CB0, CB1, sc_, sd);                                                                       \
      const int qa = 8 * rp + hh;                                                                                  \
      const bool pa = sa >= Lf[4 * rp], pb = sb >= Lf[4 * rp + 1], pc = sc_ >= Lf[4 * rp + 2], pd = sd >= Lf[4 * rp + 3]; \
      int oa = 0, ob = 0, oc = 0, od = 0;                                                                          \
      if (pa) oa = atomicAdd(&candcnt[qa], 1);                                                                     \
      if (pb) ob = atomicAdd(&candcnt[qa + 2], 1);                                                                 \
      if (pc) oc = atomicAdd(&candcnt[qa + 4], 1);                                                                 \
      if (pd) od = atomicAdd(&candcnt[qa + 6], 1);                                                                 \
      if (pa && oa < CAND_CAP) { cand_s[qa * CAND_CAP + oa] = sa; cand_i[qa * CAND_CAP + oa] = (u16)key; }         \
      if (pb && ob < CAND_CAP) { cand_s[(qa + 2) * CAND_CAP + ob] = sb; cand_i[(qa + 2) * CAND_CAP + ob] = (u16)key; } \
      if (pc && oc < CAND_CAP) { cand_s[(qa + 4) * CAND_CAP + oc] = sc_; cand_i[(qa + 4) * CAND_CAP + oc] = (u16)key; } \
      if (pd && od < CAND_CAP) { cand_s[(qa + 6) * CAND_CAP + od] = sd; cand_i[(qa + 6) * CAND_CAP + od] = (u16)key; } \
    }                                                                                                              \
  } while (0)
#define PIPE3(BODY)                                                                                                \
  do {                                                                                                             \
    int kt = wave * st;                                                                                            \
    const int step = 8 * st;                                                                                       \
    bf16x8 fa0 = {}, fa1 = {}, fb0 = {}, fb1 = {}, fc0 = {}, fc1 = {};                                             \
    const int ktl = ntile - 1;    \
    IK_LOAD(fa0, fa1, min(kt, ktl));                                                                               \
    IK_LOAD(fb0, fb1, min(kt + step, ktl));                                                                        \
    while (kt < ntile) {                                                                                           \
      IK_LOAD(fc0, fc1, min(kt + 2 * step, ktl));                                                                  \
      BODY(fa0, fa1, kt);                                                                                          \
      kt += step;                                                                                                  \
      if (kt >= ntile) break;                                                                                      \
      IK_LOAD(fa0, fa1, min(kt + 2 * step, ktl));                                                                  \
      BODY(fb0, fb1, kt);                                                                                          \
      kt += step;                                                                                                  \
      if (kt >= ntile) break;                                                                                      \
      IK_LOAD(fb0, fb1, min(kt + 2 * step, ktl));                                                                  \
      BODY(fc0, fc1, kt);                                                                                          \
      kt += step;                                                                                                  \
    }                                                                                                              \
  } while (0)
        if (pass == 0) PIPE3(TILE_HIST);
        else PIPE3(TILE_COLLECT);
#undef IK_LOAD
#undef SCORE2
#undef HIST1
#undef TILE_HIST
#undef TILE_COLLECT
#undef PIPE3
        __syncthreads();
        if (pass == 0) {
          const int qi = tid >> 5, seg = tid & 31;
          const unsigned* hq = (const unsigned*)smem + qi * 2048 + seg * 64;
          unsigned part = 0;
          for (int w = 0; w < 64; ++w) {
            const unsigned x = hq[(w + seg) & 63];
            part += (x & 0xffffu) + (x >> 16);
          }
          unsigned incl = part;
#pragma unroll
          for (int d = 1; d < 32; d <<= 1) {
            const unsigned o = __shfl_down(incl, d, 32);
            if (seg + d < 32) incl += o;
          }
          const unsigned above = incl - part;
          const unsigned long long segbal = __ballot((above < rank_t) && (incl >= rank_t));
          const int sh32 = (lane & 32);
          const unsigned segmask = (unsigned)(segbal >> sh32);
          const int sstar = segmask ? (__ffs(segmask) - 1) : 0;
          const unsigned above_s = __shfl(above, sh32 + sstar, 64);
          const unsigned* hs = (const unsigned*)smem + qi * 2048 + sstar * 64 + seg * 2;
          const unsigned x0 = hs[0], x1 = hs[1];
          const unsigned b0 = x0 & 0xffffu, b1 = x0 >> 16, b2 = x1 & 0xffffu, b3 = x1 >> 16;
          const unsigned p4 = b0 + b1 + b2 + b3;
          unsigned inc4 = p4;
#pragma unroll
          for (int d = 1; d < 32; d <<= 1) {
            const unsigned o = __shfl_down(inc4, d, 32);
            if (seg + d < 32) inc4 += o;
          }
          const unsigned ab4 = above_s + inc4 - p4;
          int mytb = -1;
          unsigned mykey = 0u;
          if (segmask && ab4 < rank_t && ab4 + p4 >= rank_t) {
            unsigned cum = ab4, cb_ = 1u;
            int bsel;
            if (cum + b3 >= rank_t) { bsel = 3; cb_ = b3; }
            else { cum += b3;
              if (cum + b2 >= rank_t) { bsel = 2; cb_ = b2; }
              else { cum += b2;
                if (cum + b1 >= rank_t) { bsel = 1; cb_ = b1; }
                else { cum += b1; bsel = 0; cb_ = b0; } } }
            mytb = sstar * 128 + seg * 4 + bsel;
            unsigned sub = 0u;
            if (ss == 8) {
              const float ft = (float)(rank_t - cum) / (float)cb_;
              sub = (unsigned)fminf((1.f - ft) * 1048576.f, 1048575.f);
            }
            mykey = (((unsigned)mytb) << 20) + sub;
          }
          __syncthreads();
          {
            uint4* bz = (uint4*)(smem + 73728);
            for (int i = tid; i < 3072; i += 512) bz[i] = make_uint4(0, 0, 0, 0);
          }
          if (mytb >= 0) tbin[qi] = (int)mykey;
          __syncthreads();
        }
      }
      if (tid < 16) {
        const int cc = candcnt[tid];
        if (cc < 256 || cc > CAND_CAP) atomicOr((unsigned*)flag, 1u);
      }
      __syncthreads();
      const int bad = *(volatile int*)flag;
      __syncthreads();
      if (!bad) break;
    }
#pragma unroll 1
    for (int e = 0; e < 2; ++e) {
      const int qi = 2 * wave + e;
      const int C = min(candcnt[qi], CAND_CAP);
      unsigned* hq = h2 + qi * 256;
      unsigned prefix = 0u, kneed = 256u;
      const bool few = (C < 256);
      unsigned ck[12], cid[12];
#pragma unroll
      for (int j = 0; j < 12; ++j) {
        const int i = lane + 64 * j;
        const bool in = i < C;
        ck[j] = in ? mono_key(cand_s[qi * CAND_CAP + (in ? i : 0)]) : 0u;
        cid[j] = in ? (unsigned)cand_i[qi * CAND_CAP + (in ? i : 0)] : 0xffffffffu;
      }
#pragma unroll 1
      for (int d = 3; d >= 0; --d) {
        const int shift = 8 * d;
        *(uint4*)(hq + lane * 4) = make_uint4(0, 0, 0, 0);
        __builtin_amdgcn_wave_barrier();
#pragma unroll
        for (int j = 0; j < 12; ++j) {
          const bool match = (cid[j] != 0xffffffffu) && ((d == 3) || ((ck[j] >> (shift + 8)) == (prefix >> (shift + 8))));
          if (match) atomicAdd(&hq[(ck[j] >> shift) & 255u], 1u);
        }
        __builtin_amdgcn_wave_barrier();
        const uint4 c4 = *(const uint4*)(hq + lane * 4);
        const unsigned part = c4.x + c4.y + c4.z + c4.w;
        unsigned incl = part;
#pragma unroll
        for (int dd = 1; dd < 64; dd <<= 1) {
          const unsigned o = __shfl_down(incl, dd, 64);
          if (lane + dd < 64) incl += o;
        }
        const unsigned above = incl - part;
        const bool mine = (above < kneed) && (incl >= kneed);
        unsigned dg = 0u, cum = above;
        if (mine) {
          if (cum + c4.w >= kneed) dg = lane * 4 + 3;
          else { cum += c4.w;
            if (cum + c4.z >= kneed) dg = lane * 4 + 2;
            else { cum += c4.z;
              if (cum + c4.y >= kneed) dg = lane * 4 + 1;
              else { cum += c4.y; dg = lane * 4; } } }
        }
        const unsigned long long bal = __ballot(mine);
        const int src = (bal != 0ull) ? (__ffsll((long long)bal) - 1) : 0;
        dg = __shfl(dg, src, 64);
        cum = __shfl(cum, src, 64);
        if (!few) { prefix |= dg << shift; kneed -= cum; }
        __builtin_amdgcn_wave_barrier();
      }
#pragma unroll
      for (int j = 0; j < 12; ++j) {
        const unsigned id = cid[j];
        if (id != 0xffffffffu) {
          if (few || ck[j] > prefix) atomicOr(&bm[qi * 512 + (id >> 5)], 1u << (id & 31));
          else if (ck[j] == prefix) {
            const int pos = atomicAdd(&mcnt[qi], 1);
            if (pos < 128) hq[pos] = id;
          }
        }
      }
      __builtin_amdgcn_wave_barrier();
      const int M = min(*(volatile int*)&mcnt[qi], 128);
      const int need = (int)kneed;
      for (int i = lane; i < M; i += 64) {
        const unsigned id = hq[i];
        int rank = 0;
        for (int f = 0; f < M; ++f) rank += (hq[f] < id) ? 1 : 0;
        if (rank < need) atomicOr(&bm[qi * 512 + (id >> 5)], 1u << (id & 31));
      }
      __builtin_amdgcn_wave_barrier();
      const unsigned* bq = bm + qi * 512 + lane * 8;
      const uint4 w0 = *(const uint4*)bq, w1 = *(const uint4*)(bq + 4);
      const unsigned ww[8] = {w0.x, w0.y, w0.z, w0.w, w1.x, w1.y, w1.z, w1.w};
      int cnt = 0;
#pragma unroll
      for (int w = 0; w < 8; ++w) cnt += __popc(ww[w]);
      int inc2 = cnt;
#pragma unroll
      for (int dd = 1; dd < 64; dd <<= 1) {
        const int o = __shfl_up(inc2, dd, 64);
        if (lane >= dd) inc2 += o;
      }
      int pos = inc2 - cnt;
#pragma unroll
      for (int w = 0; w < 8; ++w) {
        unsigned x = ww[w];
        while (x) {
          const int bit = __ffs(x) - 1;
          x &= x - 1;
          if (pos < 256) sel[qi * 256 + pos] = (u16)((lane * 8 + w) * 32 + bit);
          ++pos;
        }
      }
      if (lane == 63) {
        for (int q2 = pos; q2 < 256; ++q2) sel[qi * 256 + q2] = 0;
      }
    }
    __syncthreads();
   }
  }

  {
    const int n = (N < 256) ? N : 256;
    const int nt16 = n >> 4;
    const int hc = lane & 15, g4 = lane >> 4;
    u16* Vs = (u16*)(smem + wave * 9216);
    const float sc2 = 0.125f * LOG2E_;
    for (int e2 = 0; e2 < 2 * PROBE_AT; ++e2) {
      const int e = e2 & 1;
      const int qq = wave * 2 + e;
      const size_t tok = (size_t)tok0 + qq;
      bf16x8 qf[2];
#pragma unroll
      for (int s = 0; s < 2; ++s) {
        bf16x8 z = {};
        qf[s] = (hc < 6) ? ld8(proj + tok * PW + C_DQ + hc * 64 + 32 * s + 8 * g4) : z;
      }
      f32x4 st[16];
      {
        const u16* dkc = (const u16*)(p.ws + WS_DKC) + (size_t)b * S_ * 64 + 8 * g4;
        const float ninf = -__builtin_inff();
#pragma unroll
        for (int hb = 0; hb < 2; ++hb) {
          if (hb * 8 < nt16) {
            bf16x8 ka0, ka1, ka2, ka3, ka4, ka5, ka6, ka7, kb0, kb1, kb2, kb3, kb4, kb5, kb6, kb7;
#define KGATHER(A, B, T)                                                                         \
  do {                                                                                           \
    const int tt_ = hb * 8 + (T);                                                                \
    const int key = (tt_ < nt16) ? (sel[qq * 256 + tt_ * 16 + hc] & 16383) : 0;                  \
    const u16* kp = dkc + (size_t)key * 64;                                                      \
    A = ld8(kp);                                                                                 \
    B = ld8(kp + 32);                                                                            \
  } while (0)
#define KMMA(A, B, T)                                                                            \
  do {                                                                                           \
    const int tt_ = hb * 8 + (T);                                                                \
    f32x4 a = {};                                                                                \
    a = __builtin_amdgcn_mfma_f32_16x16x32_bf16(A, qf[0], a, 0, 0, 0);                           \
    a = __builtin_amdgcn_mfma_f32_16x16x32_bf16(B, qf[1], a, 0, 0, 0);                           \
    st[tt_] = (tt_ < nt16) ? a : (f32x4){ninf, ninf, ninf, ninf};                                \
  } while (0)
            KGATHER(ka0, kb0, 0); KGATHER(ka1, kb1, 1); KGATHER(ka2, kb2, 2); KGATHER(ka3, kb3, 3);
            KGATHER(ka4, kb4, 4); KGATHER(ka5, kb5, 5); KGATHER(ka6, kb6, 6); KGATHER(ka7, kb7, 7);
            KMMA(ka0, kb0, 0); KMMA(ka1, kb1, 1); KMMA(ka2, kb2, 2); KMMA(ka3, kb3, 3);
            KMMA(ka4, kb4, 4); KMMA(ka5, kb5, 5); KMMA(ka6, kb6, 6); KMMA(ka7, kb7, 7);
#undef KGATHER
#undef KMMA
          } else {
#pragma unroll
            for (int t = 0; t < 8; ++t) st[hb * 8 + t] = (f32x4){ninf, ninf, ninf, ninf};
          }
        }
      }
      float mx = -__builtin_inff();
#pragma unroll
      for (int kt = 0; kt < 16; ++kt)
#pragma unroll
        for (int i = 0; i < 4; ++i) mx = fmaxf(mx, st[kt][i]);
      mx = fmaxf(mx, __shfl_xor(mx, 16));
      mx = fmaxf(mx, __shfl_xor(mx, 32));
      float ls = 0.f;
#pragma unroll
      for (int kt = 0; kt < 16; ++kt)
#pragma unroll
        for (int i = 0; i < 4; ++i) {
          const float pv = __builtin_amdgcn_exp2f((st[kt][i] - mx) * sc2);
          st[kt][i] = pv;
          ls += pv;
        }
      ls += __shfl_xor(ls, 16);
      ls += __shfl_xor(ls, 32);
      f32x4 o[4] = {};
      const u16* dvc = (const u16*)(p.ws + WS_DVC) + (size_t)b * S_ * 64 + 8 * (lane & 7);
      uint4 vr0, vr1, vr2, vr3, vr4, vr5, vr6, vr7;
#define VGATHER(VR, IT, CH) VR = *(const uint4*)(dvc + (size_t)(sel[qq * 256 + (CH) * 64 + (IT) * 8 + (lane >> 3)] & 16383) * 64)
#define VPARK(VR, IT) *(uint4*)(Vs + ((IT) * 8 + (lane >> 3)) * 72 + 8 * (lane & 7)) = VR
      VGATHER(vr0, 0, 0); VGATHER(vr1, 1, 0); VGATHER(vr2, 2, 0); VGATHER(vr3, 3, 0);
      VGATHER(vr4, 4, 0); VGATHER(vr5, 5, 0); VGATHER(vr6, 6, 0); VGATHER(vr7, 7, 0);
      const int traddr = ((4 * g4 + ((lane & 15) >> 2)) * 72 + 4 * (lane & 3)) * 2;
#pragma unroll
      for (int ch = 0; ch < 4; ++ch) {
        if (ch * 64 < n) {
          VPARK(vr0, 0); VPARK(vr1, 1); VPARK(vr2, 2); VPARK(vr3, 3); VPARK(vr4, 4); VPARK(vr5, 5); VPARK(vr6, 6); VPARK(vr7, 7);
          if (ch < 3 && (ch + 1) * 64 < n) {
            VGATHER(vr0, 0, ch + 1); VGATHER(vr1, 1, ch + 1); VGATHER(vr2, 2, ch + 1); VGATHER(vr3, 3, ch + 1);
            VGATHER(vr4, 4, ch + 1); VGATHER(vr5, 5, ch + 1); VGATHER(vr6, 6, ch + 1); VGATHER(vr7, 7, ch + 1);
          }
          asm volatile("s_waitcnt lgkmcnt(0)" ::: "memory");
#pragma unroll
          for (int tt = 0; tt < 2; ++tt) {
            const int t2 = (ch * 2 + tt) * 2;
            const bf16x8 pb = mk8(pack2(st[t2][0], st[t2][1]), pack2(st[t2][2], st[t2][3]),
                                  pack2(st[t2 + 1][0], st[t2 + 1][1]), pack2(st[t2 + 1][2], st[t2 + 1][3]));
#pragma unroll
            for (int dt = 0; dt < 4; ++dt) {
              const LAS unsigned char* ta = (const LAS unsigned char*)smem + wave * 9216 + traddr + (32 * tt) * 144 + 32 * dt;
              const s4_t lo = __builtin_amdgcn_ds_read_tr16_b64_v4i16((LAS s4_t*)ta);
              const s4_t hi = __builtin_amdgcn_ds_read_tr16_b64_v4i16((LAS s4_t*)(ta + 16 * 144));
              bf16x8 va;
              va[0] = lo[0]; va[1] = lo[1]; va[2] = lo[2]; va[3] = lo[3];
              va[4] = hi[0]; va[5] = hi[1]; va[6] = hi[2]; va[7] = hi[3];
              o[dt] = __builtin_amdgcn_mfma_f32_16x16x32_bf16(va, pb, o[dt], 0, 0, 0);
            }
          }
          asm volatile("s_waitcnt lgkmcnt(0)" ::: "memory");
        }
      }
#undef VGATHER
#undef VPARK
      const float inv = 1.f / ls;
      if (hc < 6) {
#pragma unroll
        for (int dt = 0; dt < 4; ++dt) {
          uint2 w2 = make_uint2(pack2(o[dt][0] * inv, o[dt][1] * inv), pack2(o[dt][2] * inv, o[dt][3] * inv));
          *(uint2*)(Y + tok * 1024 + 256 + hc * 64 + 16 * dt + 4 * g4) = w2;
        }
      }
    }
  }
  __syncthreads();
}

DEVI void band_unit(const Params& p, const int U) {
  extern __shared__ __attribute__((aligned(16))) unsigned char smem[];
  const int tid = TIDX, lane = tid & 63, wave = tid >> 6;
  const int wu = U * 8 + wave;
  const int qh = wu & 1, h = (wu >> 1) % 6, bc = wu / 12, c = bc & 255, b = bc >> 8;
  const int r = lane & 31, g = lane >> 5;
  const u16* proj = (const u16*)(p.ws + WS_Z);
  const u16* Vt = (const u16*)(p.ws + WS_VT);
  u16* Y = (u16*)(p.ws + WS_Y);
  const float* rb = (const float*)(smem + OFF_RB) + h * 192;
  const size_t tokq = (size_t)b * S_ + c * 64 + qh * 32 + r;
  bf16x8 qf[4];
#pragma unroll
  for (int s = 0; s < 4; ++s) qf[s] = ld8(proj + tokq * PW + C_CQ + h * 64 + 16 * s + 8 * g);
  const int c0 = (c >= 8) ? (c - 8) : 0;
  const int kt0 = c0 * 2, kt1 = (c + 1) * 2;
  const int pr = (r & 16) | ((r & 4) << 1) | ((r & 8) >> 1) | (r & 3);
  const int qpos = c * 64 + qh * 32 + r;
  const float SC2 = 0.125f * LOG2E_;
  f32x16 o0 = {}, o1 = {};
  float m = -1e30f, ls = 0.f;
  const u16* kbase = proj + (size_t)(b * S_ + pr) * PW + C_CK + h * 64 + 8 * g;
  const u16* vbase = Vt + (size_t)(h * 64 + r) * T_ + (size_t)b * S_ + 8 * g;
#define BAND_LOAD(K0, K1, K2, K3, V00, V01, V10, V11, KT)                         \
  do {                                                                           \
    const u16* kp = kbase + (size_t)(KT) * 32 * PW;                               \
    const u16* vp = vbase + (size_t)(KT) * 32;                                    \
    K0 = ld8(kp); K1 = ld8(kp + 16); K2 = ld8(kp + 32); K3 = ld8(kp + 48);       \
    V00 = ld8(vp); V01 = ld8(vp + 16);                                           \
    V10 = ld8(vp + (size_t)32 * T_); V11 = ld8(vp + (size_t)32 * T_ + 16);       \
  } while (0)
#define BAND_TILE(K0, K1, K2, K3, V00, V01, V10, V11, KT)                                                          \
  do {                                                                                                             \
    f32x16 s = {};                                                                                                 \
    s = __builtin_amdgcn_mfma_f32_32x32x16_bf16(K0, qf[0], s, 0, 0, 0);                                            \
    s = __builtin_amdgcn_mfma_f32_32x32x16_bf16(K1, qf[1], s, 0, 0, 0);                                            \
    s = __builtin_amdgcn_mfma_f32_32x32x16_bf16(K2, qf[2], s, 0, 0, 0);                                            \
    s = __builtin_amdgcn_mfma_f32_32x32x16_bf16(K3, qf[3], s, 0, 0, 0);                                            \
    float tm = -1e30f;                                                                                             \
    const int kb = (KT) * 32 + 8 * g;                                                                              \
    _Pragma("unroll") for (int i = 0; i < 16; ++i) {                                                               \
      int rel = qpos - (kb + 16 * (i >> 3) + (i & 7));                                                             \
      rel = min(max(rel, -63), 128) + 63;                                                                          \
      const float v = s[i] * SC2 + rb[rel];                                                                        \
      s[i] = v;                                                                                                    \
      tm = fmaxf(tm, v);                                                                                           \
    }                                                                                                              \
    tm = fmaxf(tm, __shfl_xor(tm, 32));                                                                            \
    const float mn = fmaxf(m, tm);                                                                                 \
    const float al_ = __builtin_amdgcn_exp2f(m - mn);                                                              \
    m = mn;                                                                                                        \
    float psum = 0.f;                                                                                              \
    _Pragma("unroll") for (int i = 0; i < 16; ++i) {                                                               \
      const float pv = __builtin_amdgcn_exp2f(s[i] - mn);                                                          \
      s[i] = pv;                                                                                                   \
      psum += pv;                                                                                                  \
    }                                                                                                              \
    ls = ls * al_ + psum;                                                                                          \
    _Pragma("unroll") for (int i = 0; i < 16; ++i) {                                                               \
      o0[i] *= al_;                                                                                                \
      o1[i] *= al_;                                                                                                \
    }                                                                                                              \
    const bf16x8 pb0 = mk8(pack2(s[0], s[1]), pack2(s[2], s[3]), pack2(s[4], s[5]), pack2(s[6], s[7]));            \
    const bf16x8 pb1 = mk8(pack2(s[8], s[9]), pack2(s[10], s[11]), pack2(s[12], s[13]), pack2(s[14], s[15]));      \
    o0 = __builtin_amdgcn_mfma_f32_32x32x16_bf16(V00, pb0, o0, 0, 0, 0);                                           \
    o0 = __builtin_amdgcn_mfma_f32_32x32x16_bf16(V01, pb1, o0, 0, 0, 0);                                           \
    o1 = __builtin_amdgcn_mfma_f32_32x32x16_bf16(V10, pb0, o1, 0, 0, 0);                                           \
    o1 = __builtin_amdgcn_mfma_f32_32x32x16_bf16(V11, pb1, o1, 0, 0, 0);                                           \
  } while (0)
  {
    bf16x8 ak0, ak1, ak2, ak3, av00, av01, av10, av11, bk0, bk1, bk2, bk3, bv00, bv01, bv10, bv11;
    BAND_LOAD(ak0, ak1, ak2, ak3, av00, av01, av10, av11, kt0);
    for (int kt = kt0; kt < kt1; kt += 2) {
      BAND_LOAD(bk0, bk1, bk2, bk3, bv00, bv01, bv10, bv11, kt + 1);
      BAND_TILE(ak0, ak1, ak2, ak3, av00, av01, av10, av11, kt);
      BAND_LOAD(ak0, ak1, ak2, ak3, av00, av01, av10, av11, min(kt + 2, kt1 - 1));
      BAND_TILE(bk0, bk1, bk2, bk3, bv00, bv01, bv10, bv11, kt + 1);
    }
  }
#undef BAND_LOAD
#undef BAND_TILE
  ls += __shfl_xor(ls, 32);
  const float inv = 1.f / ls;
  u16* yp = Y + tokq * 1024 + 640 + h * 64 + 4 * g;
#pragma unroll
  for (int i4 = 0; i4 < 4; ++i4) {
    *(uint2*)(yp + 8 * i4) = make_uint2(pack2(o0[4 * i4] * inv, o0[4 * i4 + 1] * inv), pack2(o0[4 * i4 + 2] * inv, o0[4 * i4 + 3] * inv));
    *(uint2*)(yp + 32 + 8 * i4) = make_uint2(pack2(o1[4 * i4] * inv, o1[4 * i4 + 1] * inv), pack2(o1[4 * i4 + 2] * inv, o1[4 * i4 + 3] * inv));
  }
}

DEVI void conv_unit(const Params& p, const int l, const int U) {
  const u16* proj = (const u16*)(p.ws + WS_Z);
  u16* Y = (u16*)(p.ws + WS_Y);
  const float* cw = p.in[4] + (size_t)l * 3 * 256;
#pragma unroll 1
  for (int it = 0; it < 8; ++it) {
    const int item = TIDX + 512 * it;
    const int tok = U * 128 + (item >> 5), cg8 = (item & 31) * 8;
    const int s = tok & (S_ - 1);
    const uint4 cb = *(const uint4*)(proj + (size_t)tok * PW + C_CB + cg8);
    float acc[8];
#pragma unroll
    for (int e = 0; e < 8; ++e) acc[e] = 0.f;
#pragma unroll
    for (int j = 0; j < 3; ++j) {
      const int dt = 2 - j;
      if (s - dt >= 0) {
        const uint4 cc = *(const uint4*)(proj + (size_t)(tok - dt) * PW + C_CC + cg8);
        const uint4 ch = *(const uint4*)(proj + (size_t)(tok - dt) * PW + C_CH + cg8);
        const float4 w0 = *(const float4*)(cw + j * 256 + cg8);
        const float4 w1 = *(const float4*)(cw + j * 256 + cg8 + 4);
        acc[0] += w0.x * bflo(cc.x) * bflo(ch.x);
        acc[1] += w0.y * bfhi(cc.x) * bfhi(ch.x);
        acc[2] += w0.z * bflo(cc.y) * bflo(ch.y);
        acc[3] += w0.w * bfhi(cc.y) * bfhi(ch.y);
        acc[4] += w1.x * bflo(cc.z) * bflo(ch.z);
        acc[5] += w1.y * bfhi(cc.z) * bfhi(ch.z);
        acc[6] += w1.z * bflo(cc.w) * bflo(ch.w);
        acc[7] += w1.w * bfhi(cc.w) * bfhi(ch.w);
      }
    }
    uint4 o;
    o.x = pack2(bflo(cb.x) * acc[0], bfhi(cb.x) * acc[1]);
    o.y = pack2(bflo(cb.y) * acc[2], bfhi(cb.y) * acc[3]);
    o.z = pack2(bflo(cb.z) * acc[4], bfhi(cb.z) * acc[5]);
    o.w = pack2(bflo(cb.w) * acc[6], bfhi(cb.w) * acc[7]);
    *(uint4*)(Y + (size_t)tok * 1024 + cg8) = o;
  }
}

DEVI void memkv_unit(const Params& p, const int u) {
  const u16* WT = (const u16*)(p.ws + WS_WT);
  const u16* Mb = (const u16*)(p.ws + WS_MB);
  Sched S{};
  S.nM = 1; S.nN = 1; S.G = 1; S.c = 0;
  if (u < 8) {
    const int pm = u >> 2, pn = u & 3;
    S.A = (const char*)(Mb + (size_t)pm * 256 * 1024);
    S.B = (const char*)(WT + WT_KV + (size_t)pn * 256 * 1024);
    EpiStore16<0> E{(u16*)(p.ws + WS_KM) + (size_t)pm * 256 * 1024 + pn * 256, 1024};
    gemm_phase(1024, 1024, 1024, S, E);
  } else {
    const int v = u - 8, pm = v >> 1, pn = v & 1;
    S.A = (const char*)(WT + WT_KV + (size_t)(1024 + pm * 256) * 1024);
    S.B = (const char*)(Mb + (size_t)pn * 256 * 1024);
    EpiStore16<0> E{(u16*)(p.ws + WS_VTM) + (size_t)pm * 256 * 512 + pn * 256, 512};
    gemm_phase(1024, 1024, 1024, S, E);
  }
}

constexpr int NU_KV = 16, NU_DSA = 2048, NU_BAND = 768, NU_CONV = 256;
DEVI void phase_mixer(const Params& p, const int l) {
  extern __shared__ __attribute__((aligned(16))) unsigned char smem[];
  const int tid = TIDX;
  float* rb = (float*)(smem + OFF_RB);
  for (int i = tid; i < 6 * 192; i += 512) rb[i] = p.in[5][(size_t)l * 6 * 192 + i] * LOG2E_;
  volatile int* cur = (volatile int*)(smem + OFF_XB + 16);
  unsigned* ctr = (unsigned*)(p.ws + WS_BAR) + 16 + l;
  for (;;) {
    __syncthreads();
    if (tid == 0) *cur = (int)__hip_atomic_fetch_add(ctr, 1u, __ATOMIC_RELAXED, __HIP_MEMORY_SCOPE_AGENT);
    __syncthreads();
    const int u = *cur;
    if (u >= NU_KV + NU_DSA + NU_BAND + NU_CONV) break;
    if (u < NU_KV) memkv_unit(p, u);
    else if (u < NU_KV + NU_DSA) dsa_unit(p, u - NU_KV);
    else if (u < NU_KV + NU_DSA + NU_BAND) { for (int rb_ = 0; rb_ < PROBE_BD; ++rb_) band_unit(p, u - NU_KV - NU_DSA); }
    else conv_unit(p, l, u - NU_KV - NU_DSA - NU_BAND);
  }
}

DEVI Sched mk_sched(const void* A, const void* B, size_t aStepM, size_t bStepN, int nM, int nN) {
  Sched S{};
  S.A = (const char*)A; S.B = (const char*)B;
  S.aStepM = aStepM; S.aStepN = 0; S.bStepN = bStepN; S.bStepB = 0;
  S.nM = nM; S.nN = nN; S.G = (int)gridDim.x; S.c = BIDX;
  return S;
}
DEVI void phase_inproj(const Params& p) {
  const u16* X = (const u16*)(p.ws + WS_X);
  const u16* WT = (const u16*)(p.ws + WS_WT) + WT_IN;
  {
    const Sched S = mk_sched(X, WT, 256 * 1024 * 2, 256 * 1024 * 2, 128, 10);
    EpiProj E{(u16*)(p.ws + WS_Z), (const float*)(p.ws + WS_ROPED), (const float*)(p.ws + WS_ROPEI), (u16*)(p.ws + WS_IKC),
              (u16*)(p.ws + WS_DKC), (u16*)(p.ws + WS_DVC)};
    gemm_phase(1024, 1024, 1024, S, E);
  }
  {
    const Sched S = mk_sched(WT + (size_t)2560 * 1024, X, 256 * 1024 * 2, 256 * 1024 * 2, 2, 128);
    EpiStore16<0> E{(u16*)(p.ws + WS_VT), T_};
    gemm_phase(1024, 1024, 1024, S, E);
  }
}
DEVI void phase_gemm_res(const Params& p, const int which, const bool first) {
  const u16* A = (const u16*)(p.ws + (which == 0 ? WS_Y : (which == 1 ? WS_O : WS_H)));
  const u16* W = (const u16*)(p.ws + WS_WT) + (which == 0 ? WT_OUT : (which == 1 ? WT_MO : WT_FF2));
  const int K = (which == 2) ? 4096 : 1024;
  const Sched S = mk_sched(A, W, (size_t)256 * K * 2, (size_t)256 * K * 2, 128, 4);
  EpiRes E{p.out, (const u16*)(p.ws + WS_X), first ? p.in[0] : (const float*)nullptr};
  gemm_phase(K, K, K, S, E);
}
DEVI void phase_gemm_q(const Params& p) {
  const Sched S = mk_sched(p.ws + WS_X, (const u16*)(p.ws + WS_WT) + WT_MQ, 256 * 1024 * 2, 256 * 1024 * 2, 128, 4);
  EpiStore16<0> E{(u16*)(p.ws + WS_Q), 1024};
  gemm_phase(1024, 1024, 1024, S, E);
}
DEVI void phase_gemm_s(const Params& p) {
  Sched S = mk_sched(p.ws + WS_Q, p.ws + WS_KM, 256 * 1024 * 2, 256 * 2, 128, 4);
  S.aStepN = 256 * 2;
  S.bStepB = 256 * 1024 * 2;
  EpiSoftmax E{(u16*)(p.ws + WS_P)};
  gemm_phase(1024, 1024, 256, S, E);
}
DEVI void phase_gemm_pv(const Params& p) {
  Sched S = mk_sched(p.ws + WS_P, p.ws + WS_VTM, 256 * 1024 * 2, 256 * 512 * 2, 128, 4);
  S.aStepN = 256 * 2;
  S.bStepB = 256 * 2;
  EpiStore16<0> E{(u16*)(p.ws + WS_O), 1024};
  gemm_phase(1024, 512, 256, S, E);
}
DEVI void phase_gemm_ff1(const Params& p) {
  const Sched S = mk_sched(p.ws + WS_X, (const u16*)(p.ws + WS_WT) + WT_FF1, 256 * 1024 * 2, 256 * 1024 * 2, 128, 16);
  EpiStore16<1> E{(u16*)(p.ws + WS_H), 4096};
  gemm_phase(1024, 1024, 1024, S, E);
}

#define XB_TMO      128
#define XB_XCNT(j)  (256  + 64 * (j))
#define XB_XSUB(j)  (1280 + 64 * (j))
#define XB_XGEN(j)  (2304 + 64 * (j))
#define XB_TOP      3328
#define XB_TOPGEN   3392
#define XCD_BAR_WORDS 3456
#define XB_SPIN_CAP (1u << 18)
DEVI unsigned xb_ld(unsigned* p) { return __hip_atomic_load(p, __ATOMIC_RELAXED, __HIP_MEMORY_SCOPE_AGENT); }
DEVI unsigned xb_add(unsigned* p, unsigned v) { return __hip_atomic_fetch_add(p, v, __ATOMIC_RELAXED, __HIP_MEMORY_SCOPE_AGENT); }
DEVI unsigned xb_xcc_id() { return (unsigned)__builtin_amdgcn_s_getreg((3 << 11) | 20) & 0xFu; }
#define XB_SPIN(cond, bar) do { unsigned _sp = 0; while (cond) { __builtin_amdgcn_s_sleep(1); \
    if ((++_sp & 255u) == 0u) { if (xb_ld(&(bar)[XB_TMO])) break; if (_sp > XB_SPIN_CAP) { atomicAdd(&(bar)[XB_TMO], 1u); break; } } } } while (0)
struct XcdBarrier { unsigned* bar; unsigned x; volatile LAS unsigned* st; };
DEVI XcdBarrier xcd_barrier_post(unsigned* bar, volatile LAS unsigned* st) {
  XcdBarrier b; b.bar = bar; b.x = xb_xcc_id(); b.st = st;
  if (threadIdx.x == 0) (void)xb_add(&bar[XB_XCNT(b.x)], 1u);
  return b;
}
DEVI void xcd_barrier_complete(unsigned* bar, unsigned x, unsigned& nloc, unsigned& nx) {
  const unsigned G = gridDim.x * gridDim.y * gridDim.z;
  unsigned sum, cnt, mine, sp = 0u;
  for (;;) {
    sum = 0u; cnt = 0u; mine = 0u;
#pragma unroll
    for (unsigned j = 0; j < 16; ++j) { const unsigned c = xb_ld(&bar[XB_XCNT(j)]); sum += c; cnt += (c > 0u) ? 1u : 0u; mine = (j == x) ? c : mine; }
    if (sum == G) break;
    __builtin_amdgcn_s_sleep(1);
    if ((++sp & 255u) == 0u) { if (xb_ld(&bar[XB_TMO])) break; if (sp > XB_SPIN_CAP) { atomicAdd(&bar[XB_TMO], 1u); break; } }
  }
  nloc = mine > 0u ? mine : 1u; nx = cnt > 0u ? cnt : 1u;
}
DEVI void xcd_barrier(const XcdBarrier& b) {
  asm volatile("s_waitcnt vmcnt(0)" ::: "memory");
  __syncthreads();
  if (threadIdx.x == 0) {
    unsigned* bar = b.bar;
    __builtin_amdgcn_s_waitcnt(0);
    unsigned nloc = b.st[0], nx = b.st[1];
    if (nloc == 0u) { xcd_barrier_complete(bar, b.x, nloc, nx); b.st[0] = nloc; b.st[1] = nx; }
    const unsigned old = xb_add(&bar[XB_XSUB(b.x)], 1u);
    const unsigned gen = old / nloc;
    if (old + 1u == (gen + 1u) * nloc) {
      __builtin_amdgcn_fence(__ATOMIC_RELEASE, "agent");
      asm volatile("s_waitcnt vmcnt(0)" ::: "memory");
      const unsigned og = xb_add(&bar[XB_TOP], 1u);
      const unsigned tg = og / nx;
      if (og + 1u == (tg + 1u) * nx) xb_add(&bar[XB_TOPGEN], 1u);
      else XB_SPIN(xb_ld(&bar[XB_TOPGEN]) == tg, bar);
      __builtin_amdgcn_fence(__ATOMIC_ACQUIRE, "agent");
      xb_add(&bar[XB_XGEN(b.x)], 1u);
      asm volatile("s_waitcnt vmcnt(0)" ::: "memory");
    } else {
      XB_SPIN(xb_ld(&bar[XB_XGEN(b.x)]) == gen, bar);
      __builtin_amdgcn_fence(__ATOMIC_ACQUIRE, "agent");
      asm volatile("s_waitcnt vmcnt(0)" ::: "memory");
    }
  }
  __syncthreads();
}

DEVI void grid_seam(cg::grid_group& grid) {
  asm volatile("s_waitcnt vmcnt(0) lgkmcnt(0)" ::: "memory");
  __builtin_amdgcn_fence(__ATOMIC_RELEASE, "agent");
  asm volatile("s_waitcnt vmcnt(0)" ::: "memory");
  grid.sync();
  __builtin_amdgcn_fence(__ATOMIC_ACQUIRE, "agent");
  asm volatile("s_waitcnt vmcnt(0)" ::: "memory");
  __builtin_amdgcn_fence(__ATOMIC_RELEASE, "agent");
  asm volatile("s_waitcnt vmcnt(0)" ::: "memory");
  grid.sync();
  __builtin_amdgcn_fence(__ATOMIC_ACQUIRE, "agent");
  asm volatile("s_waitcnt vmcnt(0)" ::: "memory");
}
#define PHASE(stmt)                  \
  do {                               \
    Params q = p;                    \
    const int _z = opaque_s(0);      \
    q.ws = p.ws + _z;                \
    q.out = p.out + _z;              \
    stmt;                            \
  } while (0)
__global__ void __launch_bounds__(512, 2) mega(Params p) {
  cg::grid_group grid = cg::this_grid();
  extern __shared__ __attribute__((aligned(16))) unsigned char smem[];
  volatile LAS unsigned* xst = (volatile LAS unsigned*)((LAS unsigned char*)smem + OFF_XB);
  if (threadIdx.x < 4) xst[threadIdx.x] = 0u;
  __syncthreads();
  const XcdBarrier xb = xcd_barrier_post((unsigned*)(p.ws + WS_BAR), xst);
  PHASE(phase0(q));
  PHASE(convert_weights(q, 0));
  grid_seam(grid);
#pragma unroll 1
  for (int l = 0; l < NL_; ++l) {
    PHASE(phase_inproj(q));
    xcd_barrier(xb);
    PHASE(phase_mixer(q, l));
    xcd_barrier(xb);
    PHASE(phase_gemm_res(q, 0, l == 0));
    xcd_barrier(xb);
    PHASE(ln_phase(q, q.in[7] + l * 1024, q.in[8] + l * 1024, false));
    xcd_barrier(xb);
    PHASE(phase_gemm_q(q));
    xcd_barrier(xb);
    PHASE(phase_gemm_s(q));
    xcd_barrier(xb);
    PHASE(phase_gemm_pv(q));
    xcd_barrier(xb);
    PHASE(phase_gemm_res(q, 1, false));
    xcd_barrier(xb);
    PHASE(ln_phase(q, q.in[12] + l * 1024, q.in[13] + l * 1024, false));
    xcd_barrier(xb);
    PHASE(phase_gemm_ff1(q));
    xcd_barrier(xb);
    PHASE(phase_gemm_res(q, 2, false));
    xcd_barrier(xb);
    PHASE(ln_phase(q, q.in[16] + l * 1024, q.in[17] + l * 1024, l == NL_ - 1));
    if (l + 1 < NL_) PHASE(convert_weights(q, l + 1));
    xcd_barrier(xb);
  }
}

extern "C" void kernel_launch(void* const* d_in, const int* in_sizes, int n_in, void* d_out, int out_size, void* d_ws,
                              size_t ws_size, hipStream_t stream) {
  static int grid_blocks = 0;
  if (grid_blocks == 0) {
    if (n_in != 18 || ws_size < WS_END) {
      fprintf(stderr, "kernel_launch: unexpected n_in %d or ws_size %zu (need %zu)\n", n_in, ws_size, (size_t)WS_END);
      grid_blocks = -1;
      return;
    }
    int dev = 0, cus = 0, per_cu = 0;
    hipGetDevice(&dev);
    hipDeviceGetAttribute(&cus, hipDeviceAttributeMultiprocessorCount, dev);
    if (hipFuncSetAttribute((const void*)mega, hipFuncAttributeMaxDynamicSharedMemorySize, LDS_BYTES) != hipSuccess)
      fprintf(stderr, "kernel_launch: hipFuncSetAttribute failed\n");
    if (hipOccupancyMaxActiveBlocksPerMultiprocessor(&per_cu, (const void*)mega, 512, LDS_BYTES) != hipSuccess || per_cu < 1)
      per_cu = 1;
    (void)hipGetLastError();
    grid_blocks = cus * per_cu;
  }
  if (grid_blocks < 0) return;
  if (hipMemsetAsync((char*)d_ws + WS_BAR, 0, XCD_BAR_WORDS * sizeof(unsigned), stream) != hipSuccess)
    fprintf(stderr, "kernel_launch: hipMemsetAsync of the barrier words failed\n");
  Params p{};
  for (int i = 0; i < 18; ++i) p.in[i] = (const float*)d_in[i];
  p.out = (float*)d_out;
  p.ws = (unsigned char*)d_ws;
  void* args[] = {&p};
  hipError_t e = hipLaunchCooperativeKernel((const void*)mega, dim3(grid_blocks), dim3(512), args, LDS_BYTES, stream);
  if (e != hipSuccess) fprintf(stderr, "cooperative launch failed: %s (grid %d)\n", hipGetErrorString(e), grid_blocks);
}
```
